# Optimizing an MI355X kernel written in HIP

```python
import math
import jax, jax.numpy as jnp
from jax import lax
import numpy as np

D_MODEL = 1024
BATCH = 8
SEQ = 4096
DEPTH = 1

H_A = 8
DK_A = 64
DV_A = 64
W_A = H_A * DV_A
CONV_K = 4
CHUNK = 64
H_B = 8
DH_B = 64
W_B = H_B * DH_B
HI = 8
DI = 64
TOPK_MAX = 256
Q_BLOCK = 128
ROT_DIM = DH_B // 4
ROPE_THETA = 500000.0
D_FF = 2816
PLE_DIM = 256
EPS = 1e-6

MIX_SIZES = (W_A, W_A, W_A, W_A, H_A, H_A,
             W_B, W_B, W_B, HI * DI, DI, HI,
             D_MODEL, D_MODEL)
MIX_COLS = sum(MIX_SIZES)

kernel_name = "hybrid_gdn_dsa_macaron_layer"


def rmsnorm(x, g):
    x32 = x.astype(jnp.float32)
    y = x32 * lax.rsqrt(jnp.mean(x32 * x32, axis=-1, keepdims=True) + EPS)
    return (y * g.astype(jnp.float32)).astype(x.dtype)


def l2norm(x):
    x32 = x.astype(jnp.float32)
    return x32 * lax.rsqrt(jnp.sum(x32 * x32, axis=-1, keepdims=True) + EPS)


def swiglu(u, w_in, w_out):
    gate, up = jnp.split(u @ w_in, 2, axis=-1)
    return (jax.nn.silu(gate) * up) @ w_out


def rope_tables(seq_len):
    pos = jnp.arange(seq_len, dtype=jnp.float32)
    inv = ROPE_THETA ** (-jnp.arange(0, ROT_DIM, 2, dtype=jnp.float32) / ROT_DIM)
    ang = pos[:, None] * inv[None, :]
    return jnp.cos(ang), jnp.sin(ang)


def partial_rope(x, cos, sin):
    c = cos[None, :, None, :].astype(x.dtype)
    s = sin[None, :, None, :].astype(x.dtype)
    half = ROT_DIM // 2
    x1, x2, xp = x[..., :half], x[..., half:ROT_DIM], x[..., ROT_DIM:]
    return jnp.concatenate([x1 * c - x2 * s, x2 * c + x1 * s, xp], axis=-1)


def causal_conv(x, w):
    k = w.shape[0]
    return lax.conv_general_dilated(
        x, w[:, None, :], window_strides=(1,), padding=[(k - 1, 0)],
        dimension_numbers=("NWC", "WIO", "NWC"), feature_group_count=x.shape[-1])


def gated_delta_rule(q, k, v, g, beta):
    B, S, H, DK = q.shape
    DV = v.shape[-1]
    N, C = S // CHUNK, CHUNK

    def chunks(t):
        return t.reshape(B, N, C, H, -1).transpose(0, 3, 1, 2, 4)

    q, k, v = chunks(q), chunks(k), chunks(v)
    g = g.reshape(B, N, C, H).transpose(0, 3, 1, 2)
    beta = beta.reshape(B, N, C, H).transpose(0, 3, 1, 2)
    gc = jnp.cumsum(g, axis=-1)
    idx = jnp.arange(C)
    incl = idx[:, None] >= idx[None, :]
    strict = idx[:, None] > idx[None, :]
    decay = jnp.exp(jnp.where(incl, gc[..., :, None] - gc[..., None, :], -jnp.inf))
    kk = jnp.einsum("bhnid,bhnjd->bhnij", k, k)
    a_mat = jnp.where(strict, beta[..., :, None] * kk * decay, 0.0) + jnp.eye(C, dtype=jnp.float32)
    rhs = jnp.concatenate([v * beta[..., None], k * (beta * jnp.exp(gc))[..., None]], axis=-1)
    sol = lax.linalg.triangular_solve(a_mat, rhs, left_side=True, lower=True, unit_diagonal=True)
    u_val, w_dec = sol[..., :DV], sol[..., DV:]
    qk = jnp.einsum("bhnid,bhnjd->bhnij", q, k) * decay
    q_dec = q * jnp.exp(gc)[..., None]
    k_dec = k * jnp.exp(gc[..., -1:] - gc)[..., None]
    g_tot = jnp.exp(gc[..., -1])

    def step(state, inp):
        u_c, w_c, qk_c, qd_c, kd_c, gt_c = inp
        v_new = u_c - jnp.einsum("bhcd,bhde->bhce", w_c, state)
        o = jnp.einsum("bhcd,bhde->bhce", qd_c, state) + jnp.einsum("bhij,bhje->bhie", qk_c, v_new)
        state = state * gt_c[..., None, None] + jnp.einsum("bhcd,bhce->bhde", kd_c, v_new)
        return state, o

    xs = tuple(jnp.moveaxis(t, 2, 0) for t in (u_val, w_dec, qk, q_dec, k_dec, g_tot))
    s0 = jnp.zeros((B, H, DK, DV), jnp.float32)
    _, o = lax.scan(step, s0, xs)
    return o.transpose(1, 0, 3, 2, 4).reshape(B, S, H, DV)


def dsa_attention(q, k, v, q_idx, k_idx, w_idx):
    B, S, H, Dh = q.shape
    n_blk = S // Q_BLOCK
    top = min(TOPK_MAX, S // 4)
    key_pos = jnp.arange(S)
    gather = jax.vmap(lambda t, i: t[i])

    def to_blocks(t):
        return jnp.moveaxis(t.reshape(B, n_blk, Q_BLOCK, *t.shape[2:]), 1, 0)

    def one_block(args):
        qb, qib, wb, start = args
        qpos = start + jnp.arange(Q_BLOCK)
        causal = key_pos[None, :] <= qpos[:, None]
        dots = jnp.einsum("bqhd,bsd->bqhs", qib, k_idx).astype(jnp.float32) * (DI ** -0.5)
        score = jnp.einsum("bqh,bqhs->bqs", wb.astype(jnp.float32) * (HI ** -0.5), jax.nn.relu(dots))
        score = jnp.where(causal[None], score, -jnp.inf)
        _, sel = lax.top_k(score, top)
        valid = sel <= qpos[None, :, None]
        k_sel = gather(k, sel)
        v_sel = gather(v, sel)
        att = jnp.einsum("bqhd,bqkhd->bhqk", qb, k_sel).astype(jnp.float32) * (Dh ** -0.5)
        att = jnp.where(valid[:, None], att, -jnp.inf)
        prob = jax.nn.softmax(att, axis=-1).astype(v.dtype)
        return jnp.einsum("bhqk,bqkhd->bqhd", prob, v_sel)

    starts = jnp.arange(n_blk) * Q_BLOCK
    out = lax.map(one_block, (to_blocks(q), to_blocks(q_idx), to_blocks(w_idx), starts))
    return jnp.moveaxis(out, 0, 1).reshape(B, S, H, Dh)


def token_mixer(u, w_in, conv_w, a_log, dt_bias, dn_norm_g, idx_k_norm_g,
                w_br_a, w_br_b, w_out, cos, sin):
    B, S, _ = u.shape
    offsets = np.cumsum(np.array(MIX_SIZES))[:-1].tolist()
    (q_a, k_a, v_a, z_a, a_a, b_a, q_b, k_b, v_b, q_i, k_i, w_i, g_a, g_b) = jnp.split(
        u @ w_in, offsets, axis=-1)

    qkv = jax.nn.silu(causal_conv(jnp.concatenate([q_a, k_a, v_a], axis=-1), conv_w))
    q_a, k_a, v_a = jnp.split(qkv, 3, axis=-1)
    qa = l2norm(q_a.reshape(B, S, H_A, DK_A)) * (DK_A ** -0.5)
    ka = l2norm(k_a.reshape(B, S, H_A, DK_A))
    va = v_a.reshape(B, S, H_A, DV_A).astype(jnp.float32)
    g = -jnp.exp(a_log.astype(jnp.float32)) * jax.nn.softplus(
        a_a.astype(jnp.float32) + dt_bias.astype(jnp.float32))
    beta = jax.nn.sigmoid(b_a.astype(jnp.float32))
    o_a = gated_delta_rule(qa, ka, va, g, beta).astype(u.dtype)
    o_a = rmsnorm(o_a, dn_norm_g) * jax.nn.silu(z_a.reshape(B, S, H_A, DV_A))
    y_a = o_a.reshape(B, S, W_A) @ w_br_a

    qb = partial_rope(q_b.reshape(B, S, H_B, DH_B), cos, sin)
    kb = partial_rope(k_b.reshape(B, S, H_B, DH_B), cos, sin)
    vb = v_b.reshape(B, S, H_B, DH_B)
    qi = partial_rope(q_i.reshape(B, S, HI, DI), cos, sin)
    ki = partial_rope(rmsnorm(k_i, idx_k_norm_g)[:, :, None, :], cos, sin)[:, :, 0, :]
    o_b = dsa_attention(qb, kb, vb, qi, ki, w_i)
    y_b = o_b.reshape(B, S, W_B) @ w_br_b

    merged = jax.nn.sigmoid(g_a) * y_a + jax.nn.sigmoid(g_b) * y_b
    return merged @ w_out


def setup_inputs(seed: int = 0) -> dict:
    key = jax.random.key(seed)
    ks = iter(jax.random.split(key, 40))
    f32 = jnp.float32
    L, D = DEPTH, D_MODEL

    def nrm(shape, fan_in):
        return jax.random.normal(next(ks), shape, f32) * (fan_in ** -0.5)

    def gain(shape):
        return 1.0 + 0.02 * jax.random.normal(next(ks), shape, f32)

    x = jax.random.normal(next(ks), (BATCH, SEQ, D), f32)
    p = jax.random.normal(next(ks), (DEPTH, BATCH, SEQ, PLE_DIM), f32)
    a_log = jnp.log(jax.random.uniform(next(ks), (L, H_A), f32, 1.0, 16.0))
    dt = jnp.exp(jax.random.uniform(next(ks), (L, H_A), f32, math.log(0.001), math.log(0.1)))
    dt_bias = dt + jnp.log(-jnp.expm1(-dt))
    return {
        "x": x,
        "p": p,
        "ffn1_norm_pre": gain((L, D)),
        "ffn1_norm_post": gain((L, D)),
        "ffn1_w_in": nrm((L, D, 2 * D_FF), D),
        "ffn1_w_out": nrm((L, D_FF, D), D_FF),
        "mix_norm_pre": gain((L, D)),
        "mix_norm_post": gain((L, D)),
        "mix_w_in": nrm((L, D, MIX_COLS), D),
        "conv_w": nrm((L, CONV_K, 3 * W_A), CONV_K),
        "a_log": a_log,
        "dt_bias": dt_bias,
        "dn_norm_g": gain((L, DV_A)),
        "idx_k_norm_g": gain((L, DI)),
        "w_br_a": nrm((L, W_A, D), W_A),
        "w_br_b": nrm((L, W_B, D), W_B),
        "mix_w_out": nrm((L, D, D), D),
        "ffn2_norm_pre": gain((L, D)),
        "ffn2_norm_post": gain((L, D)),
        "ffn2_w_in": nrm((L, D, 2 * D_FF), D),
        "ffn2_w_out": nrm((L, D_FF, D), D_FF),
        "ple_norm_pre": gain((L, D)),
        "ple_norm_post": gain((L, D)),
        "ple_w_gate": nrm((L, D, D), D),
        "ple_w_proj": nrm((L, PLE_DIM, D), PLE_DIM),
    }


def reference(x, p, ffn1_norm_pre, ffn1_norm_post, ffn1_w_in, ffn1_w_out,
              mix_norm_pre, mix_norm_post, mix_w_in, conv_w, a_log, dt_bias,
              dn_norm_g, idx_k_norm_g, w_br_a, w_br_b, mix_w_out,
              ffn2_norm_pre, ffn2_norm_post, ffn2_w_in, ffn2_w_out,
              ple_norm_pre, ple_norm_post, ple_w_gate, ple_w_proj):
    cos, sin = rope_tables(x.shape[1])
    h = x
    for i in range(DEPTH):
        h = h + 0.5 * rmsnorm(swiglu(rmsnorm(h, ffn1_norm_pre[i]), ffn1_w_in[i], ffn1_w_out[i]),
                              ffn1_norm_post[i])
        mix = token_mixer(rmsnorm(h, mix_norm_pre[i]), mix_w_in[i], conv_w[i], a_log[i], dt_bias[i],
                          dn_norm_g[i], idx_k_norm_g[i], w_br_a[i], w_br_b[i], mix_w_out[i], cos, sin)
        h = h + rmsnorm(mix, mix_norm_post[i])
        h = h + 0.5 * rmsnorm(swiglu(rmsnorm(h, ffn2_norm_pre[i]), ffn2_w_in[i], ffn2_w_out[i]),
                              ffn2_norm_post[i])
        gate = jax.nn.sigmoid(rmsnorm(h, ple_norm_pre[i]) @ ple_w_gate[i])
        h = h + rmsnorm(gate * (p[i] @ ple_w_proj[i]), ple_norm_post[i])
    return h
```

```cpp
#include <hip/hip_runtime.h>
#include <hip/hip_cooperative_groups.h>
#include <cstdio>
#include <cstdint>
namespace cg = cooperative_groups;

#ifndef MK_PER_PHASE
#define MK_PER_PHASE 0
#endif

constexpr int T = 32768, D = 1024, FF = 2816, SEQ = 4096, NBATCH = 8, PLE = 256;
constexpr int NMIX = 6400;
constexpr float EPS = 1e-6f;
constexpr int NWAVES = 8, NTHREADS = 512;
constexpr int LDS_BYTES = 155648;

typedef _Float16 h16;
typedef _Float16 h16x8 __attribute__((ext_vector_type(8)));
typedef _Float16 h16x4 __attribute__((ext_vector_type(4)));
typedef short s16x8 __attribute__((ext_vector_type(8)));
typedef float f32x4 __attribute__((ext_vector_type(4)));
typedef unsigned u32x4 __attribute__((ext_vector_type(4)));
typedef unsigned u32x2 __attribute__((ext_vector_type(2)));
#define LAS __attribute__((address_space(3)))

constexpr size_t MiB = 1u << 20;
constexpr size_t WS_ROPE = 1 * MiB;
constexpr size_t WS_W1 = 2 * MiB;
constexpr size_t WS_W2 = WS_W1 + 11 * MiB;
constexpr size_t WS_WM = WS_W2 + 11 * MiB / 2;
constexpr size_t WS_WBA = WS_WM + 25 * MiB / 2;
constexpr size_t WS_WBB = WS_WBA + 1 * MiB;
constexpr size_t WS_WO = WS_WBB + 1 * MiB;
constexpr size_t WS_W3 = WS_WO + 2 * MiB;
constexpr size_t WS_W4 = WS_W3 + 11 * MiB;
constexpr size_t WS_WG = WS_W4 + 11 * MiB / 2;
constexpr size_t WS_WP = WS_WG + 2 * MiB;
constexpr size_t WS_P16 = 54 * MiB;
constexpr size_t WS_XN = 70 * MiB;
constexpr size_t WS_H16 = 134 * MiB;
constexpr size_t WS_ARENA = 198 * MiB;
constexpr size_t WS_HID = WS_ARENA;
constexpr size_t WS_TMP = WS_ARENA;
constexpr size_t WS_QKVA = WS_ARENA;
constexpr size_t WS_ZS = WS_QKVA + 96 * MiB;
constexpr size_t WS_QKVB = WS_ZS + 32 * MiB;
constexpr size_t WS_QI = WS_QKVB + 96 * MiB;
constexpr size_t WS_MISC = WS_QI + 32 * MiB;
constexpr size_t WS_MASK = WS_MISC + 12 * MiB;
constexpr size_t WS_HALO = WS_MASK + 16 * MiB;
constexpr size_t WS_KI = WS_HALO + 5 * MiB;
constexpr size_t WS_END = WS_KI + 4 * MiB;
static_assert(WS_WP + MiB / 2 <= WS_P16 && WS_END <= 512 * MiB && WS_HID + (size_t)T * FF * 2 <= 512 * MiB, "ws map");

__device__ __forceinline__ float sigmoidf_(float x) { return 1.0f / (1.0f + __expf(-x)); }
__device__ __forceinline__ float siluf_(float x) { return x / (1.0f + __expf(-x)); }
__device__ __forceinline__ u32x4 pack8(f32x4 a, f32x4 b) {
    h16x8 h = {(h16)a[0], (h16)a[1], (h16)a[2], (h16)a[3], (h16)b[0], (h16)b[1], (h16)b[2], (h16)b[3]};
    return __builtin_bit_cast(u32x4, h);
}
__device__ __forceinline__ u32x2 pack4(f32x4 a) {
    h16x4 h = {(h16)a[0], (h16)a[1], (h16)a[2], (h16)a[3]};
    return __builtin_bit_cast(u32x2, h);
}
__device__ __forceinline__ void unpack8(u32x4 w, float (&f)[8]) {
    h16x8 h = __builtin_bit_cast(h16x8, w);
#pragma unroll
    for (int i = 0; i < 8; ++i) f[i] = (float)h[i];
}
__device__ __forceinline__ float wave_sum(float v) {
#pragma unroll
    for (int o = 1; o < 64; o <<= 1) v += __shfl_xor(v, o);
    return v;
}
__device__ __forceinline__ int wave_sum_i(int v) {
#pragma unroll
    for (int o = 1; o < 64; o <<= 1) v += __shfl_xor(v, o);
    return v;
}
#define LDS_WAIT() asm volatile("s_waitcnt lgkmcnt(0)" ::: "memory")

namespace pg8 {
constexpr int BM = 256, BK = 64, HALF = 128, HTB = HALF * BK * 2, STAGE_BYTES = 8 * HTB, NXCD = 8, WGM = 8;
__host__ __device__ __forceinline__ int lds_byte(int r, int c) { const int st = (r >> 4) * 2 + (c >> 5), rr = r & 15, cc = c & 31, ob = rr * 64 + cc * 2; return st * 1024 + (ob ^ (((ob >> 9) & 1) << 5)); }
__host__ __device__ __forceinline__ void stage_rc(int b, int& R, int& C) { const int st = b / 1024, sb = b % 1024, swz = sb ^ (((sb >> 9) & 1) << 5); R = (st >> 1) * 16 + swz / 64; C = (st & 1) * 32 + (swz % 64) / 2; }
__host__ __device__ __forceinline__ int perm32(int rho) { const int n = rho >> 4, i = rho & 15; return 8 * (i >> 2) + 4 * n + (i & 3); }
struct Unit { int pm, pn; };
struct Gemm { const h16* A; const h16* Bt; int M, N, K, lda; };
struct StaticOrder {
    int nM, nN, nwg, G, c;
    __device__ void init(int M, int N, int G_, int c_) { nM = M / BM; nN = N / BM; nwg = nM * nN; G = G_; c = c_; }
    __device__ bool next(int i, Unit& u) const {
        const long L = (long)i * G + c; if (L >= nwg) return false;
        int wgid = (int)L; { const int q = nwg / NXCD, r = nwg % NXCD, xcd = wgid % NXCD, off = wgid / NXCD; wgid = (xcd < r ? xcd * (q + 1) : r * (q + 1) + (xcd - r) * q) + off; }
        const int nig = WGM * nN, gid = wgid / nig, fm = gid * WGM, gsz = (nM - fm) < WGM ? (nM - fm) : WGM;
        u.pm = fm + ((wgid % nig) % gsz); u.pn = (wgid % nig) / gsz; return true;
    }
};

enum { EPI_SWIGLU = 0, EPI_F32 = 1, EPI_MIX = 2, EPI_BRA = 3, EPI_BRB = 4, EPI_PLEG = 5, EPI_PLEP = 6 };
struct Epi {
    int mode;
    h16* o16; float* o32; int ldo;
    const h16* g16;
    h16 *qkva, *zs, *qkvb, *qi, *gates, *halo; float* misc; const float *rope, *a_log, *dt_bias;
    __device__ __forceinline__ void operator()(const f32x4 (&acc)[2][2][4][2], const Unit& u, int wr, int wc, int fr, int fq) const {
        const int cb = wc * 32 + 8 * fq;
        const int row0 = u.pm * BM + wr * 64 + fr;
        if (mode == EPI_SWIGLU) {
#pragma unroll
            for (int ai = 0; ai < 2; ++ai)
#pragma unroll
                for (int m = 0; m < 4; ++m) {
                    const int row = row0 + ai * HALF + m * 16;
                    f32x4 r0, r1;
#pragma unroll
                    for (int i = 0; i < 4; ++i) { r0[i] = siluf_(acc[ai][0][m][0][i]) * acc[ai][1][m][0][i]; r1[i] = siluf_(acc[ai][0][m][1][i]) * acc[ai][1][m][1][i]; }
                    *(u32x4*)(o16 + (size_t)row * ldo + u.pn * 128 + cb) = pack8(r0, r1);
                }
        } else if (mode == EPI_F32) {
#pragma unroll
            for (int ai = 0; ai < 2; ++ai)
#pragma unroll
                for (int m = 0; m < 4; ++m) {
                    const int row = row0 + ai * HALF + m * 16;
#pragma unroll
                    for (int bj = 0; bj < 2; ++bj) { float* p = o32 + (size_t)row * ldo + u.pn * BM + bj * HALF + cb; *(f32x4*)p = acc[ai][bj][m][0]; *(f32x4*)(p + 4) = acc[ai][bj][m][1]; }
                }
        } else if (mode == EPI_BRA || mode == EPI_BRB || mode == EPI_PLEP) {
#pragma unroll
            for (int ai = 0; ai < 2; ++ai)
#pragma unroll
                for (int m = 0; m < 4; ++m) {
                    const int row = row0 + ai * HALF + m * 16;
#pragma unroll
                    for (int bj = 0; bj < 2; ++bj) {
                        const int col = u.pn * BM + bj * HALF + cb;
                        float g[8]; unpack8(*(const u32x4*)(g16 + (size_t)row * (mode == EPI_PLEP ? 1024 : 2048) + (mode == EPI_BRB ? 1024 : 0) + col), g);
                        f32x4 r0, r1;
#pragma unroll
                        for (int i = 0; i < 4; ++i) { r0[i] = g[i] * acc[ai][bj][m][0][i]; r1[i] = g[4 + i] * acc[ai][bj][m][1][i]; }
                        if (mode == EPI_PLEP) { float* p = o32 + (size_t)row * ldo + col; *(f32x4*)p = r0; *(f32x4*)(p + 4) = r1; }
                        else {
                            h16* p = o16 + (size_t)row * ldo + col;
                            if (mode == EPI_BRB) { float o[8]; unpack8(*(const u32x4*)p, o);
#pragma unroll
                                for (int i = 0; i < 4; ++i) { r0[i] += o[i]; r1[i] += o[4 + i]; } }
                            *(u32x4*)p = pack8(r0, r1);
                        }
                    }
                }
        } else if (mode == EPI_PLEG) {
#pragma unroll
            for (int ai = 0; ai < 2; ++ai)
#pragma unroll
                for (int m = 0; m < 4; ++m) {
                    const int row = row0 + ai * HALF + m * 16;
#pragma unroll
                    for (int bj = 0; bj < 2; ++bj) {
                        f32x4 r0, r1;
#pragma unroll
                        for (int i = 0; i < 4; ++i) { r0[i] = sigmoidf_(acc[ai][bj][m][0][i]); r1[i] = sigmoidf_(acc[ai][bj][m][1][i]); }
                        *(u32x4*)(o16 + (size_t)row * ldo + u.pn * BM + bj * HALF + cb) = pack8(r0, r1);
                    }
                }
        } else {
            const int pn = u.pn;
#pragma unroll
            for (int ai = 0; ai < 2; ++ai)
#pragma unroll
                for (int m = 0; m < 4; ++m) {
                    const int row = row0 + ai * HALF + m * 16;
#pragma unroll
                    for (int bj = 0; bj < 2; ++bj) {
                        const int tc = bj * HALF + cb;
                        f32x4 v0 = acc[ai][bj][m][0], v1 = acc[ai][bj][m][1];
                        if (pn < 6) {
                            const u32x4 w = pack8(v0, v1);
                            *(u32x4*)(qkva + (size_t)row * 1536 + pn * 256 + tc) = w;
                            if ((row & 63) >= 61) *(u32x4*)(halo + ((size_t)(row >> 6) * 3 + ((row & 63) - 61)) * 1536 + pn * 256 + tc) = w;
                        } else if (pn < 8) {
#pragma unroll
                            for (int i = 0; i < 4; ++i) { v0[i] = siluf_(v0[i]); v1[i] = siluf_(v1[i]); }
                            *(u32x4*)(zs + (size_t)row * 512 + (pn - 6) * 256 + tc) = pack8(v0, v1);
                        } else if (pn < 16) {
                            const bool rope_tile = (pn < 12) || (pn >= 14);
                            if (rope_tile && !(wc & 1)) {
                                f32x4 p0, p1;
#pragma unroll
                                for (int i = 0; i < 4; ++i) { p0[i] = __shfl_xor(v0[i], 16); p1[i] = __shfl_xor(v1[i], 16); }
                                if (fq < 2) {
                                    const float* rp = rope + (size_t)(row & (SEQ - 1)) * 16;
                                    const f32x4 c0 = *(const f32x4*)rp, c1 = *(const f32x4*)(rp + 4), s0 = *(const f32x4*)(rp + 8), s1 = *(const f32x4*)(rp + 12);
                                    const float sg = fq == 0 ? -1.f : 1.f;
#pragma unroll
                                    for (int i = 0; i < 4; ++i) { v0[i] = v0[i] * c0[i] + sg * p0[i] * s0[i]; v1[i] = v1[i] * c1[i] + sg * p1[i] * s1[i]; }
                                }
                            }
                            if (pn < 10) { v0 = v0 * 0.125f; v1 = v1 * 0.125f; }
                            h16* dst = pn < 14 ? qkvb + (size_t)row * 1536 + (pn - 8) * 256 + tc : qi + (size_t)row * 512 + (pn - 14) * 256 + tc;
                            *(u32x4*)dst = pack8(v0, v1);
                        } else if (pn < 24) {
#pragma unroll
                            for (int i = 0; i < 4; ++i) { v0[i] = sigmoidf_(v0[i]); v1[i] = sigmoidf_(v1[i]); }
                            *(u32x4*)(gates + (size_t)row * 2048 + (pn - 16) * 256 + tc) = pack8(v0, v1);
                        } else if (bj == 0) {
                            float* mp = misc + (size_t)row * 96;
                            if (wc < 2) { *(f32x4*)(mp + tc) = v0; *(f32x4*)(mp + tc + 4) = v1; }
                            else if (wc == 2 && fq < 3) {
                                float r[8] = {v0[0], v0[1], v0[2], v0[3], v1[0], v1[1], v1[2], v1[3]};
                                if (fq == 0) {
#pragma unroll
                                    for (int i = 0; i < 8; ++i) { const float xx = r[i] + dt_bias[i]; const float sp = xx > 20.f ? xx : log1pf(expf(xx)); r[i] = -expf(a_log[i]) * sp; }
                                } else if (fq == 1) {
#pragma unroll
                                    for (int i = 0; i < 8; ++i) r[i] = 1.0f / (1.0f + expf(-r[i]));
                                } else {
#pragma unroll
                                    for (int i = 0; i < 8; ++i) r[i] *= 0.04419417382415922f;
                                }
                                *(f32x4*)(mp + 64 + 8 * fq) = (f32x4){r[0], r[1], r[2], r[3]}; *(f32x4*)(mp + 68 + 8 * fq) = (f32x4){r[4], r[5], r[6], r[7]};
                            }
                        }
                    }
                }
        }
    }
};

__device__ __forceinline__ void gemm_phase(LAS unsigned char* lds, const Gemm g, const StaticOrder& S, const Epi& E, const int tid) {
    const int wid = __builtin_amdgcn_readfirstlane(tid >> 6), lane = tid & 63, wr = wid >> 2, wc = wid & 3, fr = lane & 15, fq = lane >> 4;
    const int K = g.K, nt = K / BK, lda = g.lda;
    unsigned voffA[2], voffB[2];
#pragma unroll
    for (int i = 0; i < 2; ++i) { int R, C; stage_rc(tid * 16 + i * 8192, R, C); const int Rb = (R & ~31) + perm32(R & 31);
        voffA[i] = (unsigned)(R * lda + C) * 2u; voffB[i] = (unsigned)(Rb * K + C) * 2u; }
    const size_t kstep = (size_t)(BK * 2);
    const size_t hstepA = (size_t)HALF * lda * 2, hstepB = (size_t)HALF * K * 2;
    const size_t tstepA = 2 * hstepA, tstepB = 2 * hstepB;
    const unsigned ldsw = (unsigned)wid * 1024u;
    const int aoff = lds_byte(wr * 64 + fr, fq * 8), boff = lds_byte(wc * 32 + fr, fq * 8);
#define PG8_SA(b, h) (((b) * 2 + (h)) * HTB)
#define PG8_SB(b, h) ((4 + (b) * 2 + (h)) * HTB)
#define PG8_STAGE(bufoff, gbase, voff) do { _Pragma("unroll") for (int _i = 0; _i < 2; ++_i) \
        __builtin_amdgcn_global_load_lds((const unsigned*)((const char*)(gbase) + (voff)[_i]), (LAS unsigned*)(lds + (bufoff) + ldsw + _i * 8192), 16, 0, 0); } while (0)
#define PG8_LDA(dst, b, h) do { _Pragma("unroll") for (int m = 0; m < 4; ++m) _Pragma("unroll") for (int k = 0; k < 2; ++k) dst[m][k] = *(const LAS s16x8*)(lds + PG8_SA(b, h) + aoff + m * 2048 + k * 1024); } while (0)
#define PG8_LDB(dst, b, h) do { _Pragma("unroll") for (int n = 0; n < 2; ++n) _Pragma("unroll") for (int k = 0; k < 2; ++k) dst[n][k] = *(const LAS s16x8*)(lds + PG8_SB(b, h) + boff + n * 2048 + k * 1024); } while (0)
#define PG8_MMA(ai, bj, At, Bt) do { __builtin_amdgcn_s_setprio(1); _Pragma("unroll") for (int m = 0; m < 4; ++m) _Pragma("unroll") for (int n = 0; n < 2; ++n) _Pragma("unroll") for (int k = 0; k < 2; ++k) \
        acc[ai][bj][m][n] = __builtin_amdgcn_mfma_f32_16x16x32_f16(__builtin_bit_cast(h16x8, Bt[n][k]), __builtin_bit_cast(h16x8, At[m][k]), acc[ai][bj][m][n], 0, 0, 0); __builtin_amdgcn_s_setprio(0); } while (0)
#define PG8_WAIT_V(n) asm volatile("s_waitcnt vmcnt(" #n ")" ::: "memory")
#define PG8_WAIT_L(n) asm volatile("s_waitcnt lgkmcnt(" #n ")" ::: "memory")
#define PG8_BAR __builtin_amdgcn_s_barrier()
#define PG8_SCHED __builtin_amdgcn_sched_barrier(0)
    Unit cur, nxt; int ui = 0;
    if (!S.next(0, cur)) return;
    f32x4 acc[2][2][4][2];
#pragma unroll
    for (int a = 0; a < 2; ++a)
#pragma unroll
        for (int b = 0; b < 2; ++b)
#pragma unroll
            for (int m = 0; m < 4; ++m)
#pragma unroll
                for (int n = 0; n < 2; ++n) acc[a][b][m][n] = (f32x4){0.f, 0.f, 0.f, 0.f};
    s16x8 At[4][2], B0[2][2], B1[2][2];
    const char* cA = (const char*)g.A + (size_t)cur.pm * tstepA; const char* cB = (const char*)g.Bt + (size_t)cur.pn * tstepB;
    PG8_STAGE(PG8_SB(0, 0), cB, voffB); PG8_STAGE(PG8_SB(0, 1), cB + hstepB, voffB); PG8_STAGE(PG8_SA(0, 0), cA, voffA); PG8_STAGE(PG8_SA(0, 1), cA + hstepA, voffA);
    if (wr == 1) PG8_BAR;
    PG8_WAIT_V(2); PG8_BAR;
    PG8_STAGE(PG8_SB(1, 0), cB + kstep, voffB); PG8_STAGE(PG8_SA(1, 0), cA + kstep, voffA); PG8_STAGE(PG8_SB(1, 1), cB + hstepB + kstep, voffB);
    PG8_WAIT_V(6); PG8_BAR;
    for (;;) {
        const bool has_next = S.next(ui + 1, nxt);
        const char* nA = has_next ? (const char*)g.A + (size_t)nxt.pm * tstepA : cA; const char* nB = has_next ? (const char*)g.Bt + (size_t)nxt.pn * tstepB : cB;
        for (int t = 0; t < nt; t += 2) {
            const bool last = (t == nt - 2);
            const char* a1 = cA + (size_t)(t + 1) * kstep;
            const char* a2 = last ? nA : cA + (size_t)(t + 2) * kstep; const char* b2 = last ? nB : cB + (size_t)(t + 2) * kstep;
            const char* a3 = a2 + kstep; const char* b3 = b2 + kstep;
            PG8_LDB(B0, 0, 0); PG8_LDB(B1, 0, 1); PG8_SCHED; PG8_LDA(At, 0, 0); PG8_STAGE(PG8_SA(1, 1), a1 + hstepA, voffA);
            PG8_WAIT_V(8); PG8_WAIT_L(0); PG8_BAR; PG8_MMA(0, 0, At, B0); PG8_MMA(0, 1, At, B1); PG8_BAR; PG8_SCHED;
            PG8_LDA(At, 0, 1); PG8_STAGE(PG8_SB(0, 0), b2, voffB); PG8_STAGE(PG8_SB(0, 1), b2 + hstepB, voffB); PG8_STAGE(PG8_SA(0, 0), a2, voffA);
            PG8_WAIT_V(8); PG8_WAIT_L(0); PG8_BAR; PG8_MMA(1, 0, At, B0); PG8_MMA(1, 1, At, B1); PG8_BAR; PG8_SCHED;
            PG8_LDB(B0, 1, 0); PG8_LDB(B1, 1, 1); PG8_SCHED; PG8_LDA(At, 1, 0); PG8_STAGE(PG8_SA(0, 1), a2 + hstepA, voffA);
            PG8_WAIT_V(8); PG8_WAIT_L(0); PG8_BAR; PG8_MMA(0, 0, At, B0); PG8_MMA(0, 1, At, B1); PG8_BAR; PG8_SCHED;
            PG8_LDA(At, 1, 1); PG8_STAGE(PG8_SB(1, 0), b3, voffB); PG8_STAGE(PG8_SB(1, 1), b3 + hstepB, voffB); PG8_STAGE(PG8_SA(1, 0), a3, voffA);
            PG8_WAIT_V(8); PG8_WAIT_L(0); PG8_BAR; PG8_MMA(1, 0, At, B0); PG8_MMA(1, 1, At, B1); PG8_BAR; PG8_SCHED;
        }
        if (wr == 0) PG8_BAR;
        E(acc, cur, wr, wc, fr, fq);
        if (!has_next) break;
#pragma unroll
        for (int a = 0; a < 2; ++a)
#pragma unroll
            for (int b = 0; b < 2; ++b)
#pragma unroll
                for (int m = 0; m < 4; ++m)
#pragma unroll
                    for (int n = 0; n < 2; ++n) acc[a][b][m][n] = (f32x4){0.f, 0.f, 0.f, 0.f};
        cur = nxt; cA = nA; cB = nB; ++ui;
        if (wr == 1) PG8_BAR;
    }
    PG8_WAIT_V(0);
    PG8_BAR;
#undef PG8_SA
#undef PG8_SB
#undef PG8_STAGE
#undef PG8_LDA
#undef PG8_LDB
#undef PG8_MMA
#undef PG8_WAIT_V
#undef PG8_WAIT_L
#undef PG8_BAR
#undef PG8_SCHED
}
}

struct Args { const float* in[25]; float* out; unsigned char* ws; int ph_lo, ph_hi; };
enum { I_X = 0, I_P, I_F1PRE, I_F1POST, I_F1WIN, I_F1WOUT, I_MPRE, I_MPOST, I_MWIN, I_CONVW, I_ALOG, I_DTB, I_DNG, I_IDXG, I_WBA, I_WBB, I_MWOUT,
       I_F2PRE, I_F2POST, I_F2WIN, I_F2WOUT, I_PPRE, I_PPOST, I_PWG, I_PWP };

__device__ __forceinline__ int srccol(int map, int n) {
    if (map == 0) return n;
    if (map == 1) { const int pn = n >> 8, tc = n & 255; return tc < 128 ? pn * 128 + tc : FF + pn * 128 + (tc - 128); }
    if (n < 2048) return n;
    if (n < 4096) return 2064 + (n - 2048);
    if (n < 6144) return 4184 + (n - 4096);
    const int tc = n - 6144;
    if (tc < 64) return 4112 + tc;
    if (tc < 72) return 2048 + (tc - 64);
    if (tc < 80) return 2056 + (tc - 72);
    if (tc < 88) return 4176 + (tc - 80);
    return -1;
}
__device__ __forceinline__ void transpose_item(const float* W, int K, int N, h16* WT, int NP, int map, float* scr, int item, int lane) {
    const int nblk = NP / 32, kb = item / nblk, nb = item % nblk, k0 = 64 * kb, n0 = 32 * nb;
    const int sc = srccol(map, n0 + (lane & 31));
#pragma unroll 8
    for (int i = 0; i < 32; ++i) { const int kk = 2 * i + (lane >> 5); scr[kk * 33 + (lane & 31)] = sc >= 0 ? W[(size_t)(k0 + kk) * N + sc] : 0.f; }
    LDS_WAIT();
    const int c = lane & 7;
#pragma unroll
    for (int j = 0; j < 4; ++j) { const int n = (lane >> 3) + 8 * j; const float* s = scr + (8 * c) * 33 + n;
        f32x4 a = {s[0], s[33], s[66], s[99]}, b = {s[132], s[165], s[198], s[231]};
        *(u32x4*)(WT + (size_t)(n0 + n) * K + k0 + 8 * c) = pack8(a, b); }
    LDS_WAIT();
}

__device__ __forceinline__ void load_row_f32(const float* p, int lane, f32x4 (&v)[4]) {
#pragma unroll
    for (int j = 0; j < 4; ++j) v[j] = *(const f32x4*)(p + 4 * lane + 256 * j);
}
__device__ __forceinline__ void load_row_h16(const h16* p, int lane, f32x4 (&v)[4]) {
#pragma unroll
    for (int j = 0; j < 4; ++j) { const h16x4 h = *(const h16x4*)(p + 4 * lane + 256 * j); v[j] = (f32x4){(float)h[0], (float)h[1], (float)h[2], (float)h[3]}; }
}
__device__ __forceinline__ float row_rms_scale(const f32x4 (&v)[4]) {
    float s = 0.f;
#pragma unroll
    for (int j = 0; j < 4; ++j) s += (v[j][0] * v[j][0] + v[j][1] * v[j][1]) + (v[j][2] * v[j][2] + v[j][3] * v[j][3]);
    return rsqrtf(wave_sum(s) * (1.0f / D) + EPS);
}
template <bool BASE_F32, bool FINAL>
__device__ __forceinline__ void resid_norm_phase(const float* xbase, h16* H, const float* Y, float coef, const float* g_post, const float* g_pre, h16* XN, float* outp, int gw, int ngw, int lane) {
    for (int row = gw; row < T; row += ngw) {
        f32x4 y[4], b[4], gp[4];
        load_row_f32(Y + (size_t)row * D, lane, y);
        if (BASE_F32) load_row_f32(xbase + (size_t)row * D, lane, b); else load_row_h16(H + (size_t)row * D, lane, b);
        load_row_f32(g_post, lane, gp);
        const float r = row_rms_scale(y) * coef;
#pragma unroll
        for (int j = 0; j < 4; ++j) b[j] = b[j] + y[j] * r * gp[j];
        if (FINAL) {
#pragma unroll
            for (int j = 0; j < 4; ++j) *(f32x4*)(outp + (size_t)row * D + 4 * lane + 256 * j) = b[j];
        } else {
            f32x4 g2[4]; load_row_f32(g_pre, lane, g2);
            const float r2 = row_rms_scale(b);
#pragma unroll
            for (int j = 0; j < 4; ++j) {
                *(u32x2*)(H + (size_t)row * D + 4 * lane + 256 * j) = pack4(b[j]);
                *(u32x2*)(XN + (size_t)row * D + 4 * lane + 256 * j) = pack4(b[j] * r2 * g2[j]);
            }
        }
    }
}

__global__ void __launch_bounds__(NTHREADS, 2) fwd_kernel(Args args) {
    extern __shared__ __attribute__((aligned(16))) unsigned char lds[];
    cg::grid_group grid = cg::this_grid();
    const int G = gridDim.x, bid = blockIdx.x;
    for (int ph = args.ph_lo; ph < args.ph_hi; ++ph) {
    int tid = threadIdx.x; asm volatile("" : "+v"(tid));
    unsigned char* ws = args.ws; asm volatile("" : "+s"(ws));
    float* outp_ = args.out; asm volatile("" : "+s"(outp_));
    const int lane = tid & 63, wave = __builtin_amdgcn_readfirstlane(tid >> 6);
    const int gw = bid * NWAVES + wave, ngw = G * NWAVES;
    float* ROPE = (float*)(ws + WS_ROPE);
    h16 *W1 = (h16*)(ws + WS_W1), *W2 = (h16*)(ws + WS_W2), *WM = (h16*)(ws + WS_WM), *WBA = (h16*)(ws + WS_WBA), *WBB = (h16*)(ws + WS_WBB), *WO = (h16*)(ws + WS_WO);
    h16 *W3 = (h16*)(ws + WS_W3), *W4 = (h16*)(ws + WS_W4), *WG = (h16*)(ws + WS_WG), *WP = (h16*)(ws + WS_WP);
    h16 *P16 = (h16*)(ws + WS_P16), *XN = (h16*)(ws + WS_XN), *H16 = (h16*)(ws + WS_H16), *HID = (h16*)(ws + WS_HID), *TMP = (h16*)(ws + WS_TMP);
    h16 *QKVA = (h16*)(ws + WS_QKVA), *ZS = (h16*)(ws + WS_ZS), *QKVB = (h16*)(ws + WS_QKVB), *QI = (h16*)(ws + WS_QI), *HALO = (h16*)(ws + WS_HALO), *KI = (h16*)(ws + WS_KI);
    float* MISC = (float*)(ws + WS_MISC);
    unsigned long long* MASK = (unsigned long long*)(ws + WS_MASK);
    float* Y = outp_;
    h16* GATES = (h16*)outp_;

        pg8::Gemm g{nullptr, nullptr, T, 0, 0, 0};
        pg8::Epi E{}; E.mode = -1;
        switch (ph) {
        case 0: {
            float* scr = (float*)lds + wave * (64 * 33);
            constexpr int I1 = 16 * (5632 / 32), I2 = 44 * 32, IM = 16 * (NMIX / 32), IB = 8 * 32, IO = 16 * 32, IP = 4 * 32;
            constexpr int NIT = 2 * I1 + 2 * I2 + IM + 2 * IB + 2 * IO + IP;
            for (int it = gw; it < NIT; it += ngw) {
                int r = it;
                if (r < I1) { transpose_item(args.in[I_F1WIN], D, 2 * FF, W1, 2 * FF, 1, scr, r, lane); continue; } r -= I1;
                if (r < I1) { transpose_item(args.in[I_F2WIN], D, 2 * FF, W3, 2 * FF, 1, scr, r, lane); continue; } r -= I1;
                if (r < I2) { transpose_item(args.in[I_F1WOUT], FF, D, W2, D, 0, scr, r, lane); continue; } r -= I2;
                if (r < I2) { transpose_item(args.in[I_F2WOUT], FF, D, W4, D, 0, scr, r, lane); continue; } r -= I2;
                if (r < IM) { transpose_item(args.in[I_MWIN], D, 6232, WM, NMIX, 2, scr, r, lane); continue; } r -= IM;
                if (r < IB) { transpose_item(args.in[I_WBA], 512, D, WBA, D, 0, scr, r, lane); continue; } r -= IB;
                if (r < IB) { transpose_item(args.in[I_WBB], 512, D, WBB, D, 0, scr, r, lane); continue; } r -= IB;
                if (r < IO) { transpose_item(args.in[I_MWOUT], D, D, WO, D, 0, scr, r, lane); continue; } r -= IO;
                if (r < IO) { transpose_item(args.in[I_PWG], D, D, WG, D, 0, scr, r, lane); continue; } r -= IO;
                transpose_item(args.in[I_PWP], PLE, D, WP, D, 0, scr, r, lane);
            }
            { const float* p = args.in[I_P]; const size_t n8 = (size_t)T * PLE / 8;
              for (size_t i = (size_t)bid * NTHREADS + tid; i < n8; i += (size_t)G * NTHREADS) { const f32x4 a = *(const f32x4*)(p + 8 * i), b = *(const f32x4*)(p + 8 * i + 4); *(u32x4*)(P16 + 8 * i) = pack8(a, b); } }
            for (int i = bid * NTHREADS + tid; i < SEQ * 8; i += G * NTHREADS) {
                const int pos = i >> 3, f = i & 7;
                const float invt[8] = {1.0f, 0.1939227432012558f, 0.03760603070259094f, 0.007292664609849453f, 0.0014142135623842478f, 0.00027424818836152554f, 5.3182957344688475e-05f, 1.0313385246263351e-05f};
                float inv = invt[0];
#pragma unroll
                for (int q = 1; q < 8; ++q) inv = (f == q) ? invt[q] : inv;
                const float ang = (float)pos * inv;
                ROPE[pos * 16 + f] = cosf(ang); ROPE[pos * 16 + 8 + f] = sinf(ang);
            }
            { const float* x = args.in[I_X]; const float* gp = args.in[I_F1PRE];
              for (int row = gw; row < T; row += ngw) { f32x4 v[4], gg[4]; load_row_f32(x + (size_t)row * D, lane, v); load_row_f32(gp, lane, gg); const float r = row_rms_scale(v);
#pragma unroll
                  for (int j = 0; j < 4; ++j) *(u32x2*)(XN + (size_t)row * D + 4 * lane + 256 * j) = pack4(v[j] * r * gg[j]); } }
        } break;
        case 1: g = pg8::Gemm{XN, W1, T, 2 * FF, D, D}; E.mode = pg8::EPI_SWIGLU; E.o16 = HID; E.ldo = FF; break;
        case 2: g = pg8::Gemm{HID, W2, T, D, FF, FF}; E.mode = pg8::EPI_F32; E.o32 = Y; E.ldo = D; break;
        case 3: resid_norm_phase<true, false>(args.in[I_X], H16, Y, 0.5f, args.in[I_F1POST], args.in[I_MPRE], XN, nullptr, gw, ngw, lane); break;
        case 4: g = pg8::Gemm{XN, WM, T, NMIX, D, D}; E.mode = pg8::EPI_MIX; E.qkva = QKVA; E.zs = ZS; E.qkvb = QKVB; E.qi = QI; E.gates = GATES; E.halo = HALO; E.misc = MISC;
                E.rope = ROPE; E.a_log = args.in[I_ALOG]; E.dt_bias = args.in[I_DTB]; break;
        case 5: {
            const float* cw = args.in[I_CONVW];
            for (int unit = gw; unit < 512 * 24; unit += ngw) {
                const int c = unit / 24, grp = unit % 24, ch = grp * 64 + lane;
                const float w0 = cw[ch], w1 = cw[1536 + ch], w2 = cw[2 * 1536 + ch], w3 = cw[3 * 1536 + ch];
                float xm3 = 0.f, xm2 = 0.f, xm1 = 0.f;
                if (c & 63) { const h16* hp = HALO + (size_t)(c - 1) * 3 * 1536 + ch; xm3 = (float)hp[0]; xm2 = (float)hp[1536]; xm1 = (float)hp[2 * 1536]; }
                h16* base = QKVA + (size_t)c * 64 * 1536 + ch;
                float xv[64];
#pragma unroll
                for (int r = 0; r < 64; ++r) xv[r] = (float)base[(size_t)r * 1536];
#pragma unroll
                for (int r = 0; r < 64; ++r) {
                    const float x0 = xv[r];
                    float yv = siluf_(w0 * xm3 + w1 * xm2 + w2 * xm1 + w3 * x0);
                    xm3 = xm2; xm2 = xm1; xm1 = x0;
                    if (grp < 16) { const float ss = wave_sum(yv * yv); yv *= rsqrtf(ss + EPS); if (grp < 8) yv *= 0.125f; }
                    xv[r] = yv;
                }
#pragma unroll
                for (int r = 0; r < 64; ++r) base[(size_t)r * 1536] = (h16)xv[r];
            }
            const float* ig = args.in[I_IDXG];
            for (int row = gw; row < T; row += ngw) {
                float v = MISC[(size_t)row * 96 + lane];
                const float ss = wave_sum(v * v);
                v = v * rsqrtf(ss * (1.0f / 64.0f) + EPS) * ig[lane];
                const float pr = __shfl_xor(v, 8);
                if (lane < 16) { const float* rp = ROPE + (size_t)(row & (SEQ - 1)) * 16; const float c = rp[lane & 7], s = rp[8 + (lane & 7)]; v = lane < 8 ? v * c - pr * s : v * c + pr * s; }
                KI[(size_t)row * 64 + lane] = (h16)v;
            }
        } break;
        case 6: {
            unsigned* sc = (unsigned*)lds;
            float* qs = (float*)(lds + 131072);
            float* wq = (float*)(lds + 131072 + 16384);
            for (int grp = bid; grp < T / 8; grp += G) {
                const int row0 = grp * 8, b = row0 / SEQ, t0 = row0 % SEQ;
                for (int i = tid; i < 8 * 512; i += NTHREADS) qs[i] = (float)QI[(size_t)row0 * 512 + i];
                if (tid < 64) wq[tid] = MISC[(size_t)(row0 + (tid >> 3)) * 96 + 80 + (tid & 7)];
                __syncthreads();
                const int nk = t0 + 8;
                for (int k0 = 0; k0 < nk; k0 += NTHREADS) {
                    const int key = k0 + tid;
                    float kr[64];
                    { const h16* kp = KI + ((size_t)b * SEQ + key) * 64;
#pragma unroll
                      for (int i = 0; i < 8; ++i) { float f[8]; unpack8(*(const u32x4*)(kp + 8 * i), f);
#pragma unroll
                          for (int j = 0; j < 8; ++j) kr[8 * i + j] = f[j]; } }
#pragma unroll 1
                    for (int q = 0; q < 8; ++q) {
                        float s = 0.f;
#pragma unroll 1
                        for (int h = 0; h < 8; ++h) {
                            const float* qp = qs + q * 512 + h * 64;
                            float d0 = 0.f, d1 = 0.f, d2 = 0.f, d3 = 0.f;
#pragma unroll
                            for (int i = 0; i < 16; ++i) { const f32x4 qv = *(const f32x4*)(qp + 4 * i); d0 += qv[0] * kr[4 * i]; d1 += qv[1] * kr[4 * i + 1]; d2 += qv[2] * kr[4 * i + 2]; d3 += qv[3] * kr[4 * i + 3]; }
                            const float dot = (d0 + d1) + (d2 + d3);
                            s += wq[q * 8 + h] * fmaxf(dot, 0.f);
                        }
                        unsigned u = __float_as_uint(s); u = (u & 0x80000000u) ? ~u : (u | 0x80000000u);
                        sc[q * 4096 + key] = (key <= t0 + q) ? u : 0u;
                    }
                }
                __syncthreads();
                {
                    const int t = t0 + wave, n = t + 1, nw = (n + 63) >> 6;
                    const unsigned* scq = sc + wave * 4096;
                    unsigned thr = 0u; int need = 0;
                    if (n > 256) {
                        unsigned prefix = 0u;
                        for (int bit = 31; bit >= 0; --bit) {
                            const unsigned cand = prefix | (1u << bit);
                            int cnt = 0;
                            for (int i = 0; i < nw; ++i) cnt += (scq[i * 64 + lane] >= cand) ? 1 : 0;
                            cnt = wave_sum_i(cnt);
                            if (cnt >= 256) prefix = cand;
                        }
                        thr = prefix;
                        int cg_ = 0;
                        for (int i = 0; i < nw; ++i) cg_ += (scq[i * 64 + lane] > thr) ? 1 : 0;
                        need = 256 - wave_sum_i(cg_);
                    }
                    int running = 0;
                    unsigned long long* mrow = MASK + (size_t)(row0 + wave) * 64;
                    for (int i = 0; i < 64; ++i) {
                        bool gt = false, eq = false;
                        if (i < nw) { const unsigned uk = scq[i * 64 + lane]; if (n > 256) { gt = uk > thr; eq = uk == thr; } else gt = uk != 0u; }
                        const unsigned long long beq = __ballot(eq);
                        const int rank = running + __popcll(beq & ((1ull << lane) - 1ull));
                        const bool take = gt || (eq && rank < need);
                        running += __popcll(beq);
                        const unsigned long long mm = __ballot(take);
                        if (lane == 0) mrow[i] = mm;
                    }
                }
                __syncthreads();
            }
        } break;
        case 7: {
            constexpr int NSCAN = 32;
            if (bid < NSCAN) {
                const int pair = wave >> 2, sub = wave & 3, bh = 2 * bid + pair, b = bh >> 3, h = bh & 7;
                float* Lk = (float*)lds + pair * (3 * 4096 + 128);
                float* Lq = Lk + 4096; float* Lv = Lq + 4096; float* Lg = Lv + 4096; float* Lb = Lg + 64;
                const int jl = lane & 15, r = lane >> 4, j = 16 * sub + jl;
                const int t4 = sub * 64 + lane;
                float Sr[16];
#pragma unroll
                for (int i = 0; i < 16; ++i) Sr[i] = 0.f;
                for (int c = 0; c < 64; ++c) {
                    const size_t rbase = (size_t)b * SEQ + c * 64;
                    __syncthreads();
#pragma unroll
                    for (int e = 0; e < 2; ++e) {
                        const int idx = (t4 * 2 + e) * 8;
                        const int tr = idx >> 6, dc = idx & 63;
                        const h16* src = QKVA + (rbase + tr) * 1536 + h * 64 + dc;
                        float f[8];
                        unpack8(*(const u32x4*)(src + 512), f);
#pragma unroll
                        for (int i = 0; i < 8; ++i) Lk[idx + i] = f[i];
                        unpack8(*(const u32x4*)(src), f);
#pragma unroll
                        for (int i = 0; i < 8; ++i) Lq[idx + i] = f[i];
                        unpack8(*(const u32x4*)(src + 1024), f);
#pragma unroll
                        for (int i = 0; i < 8; ++i) Lv[idx + i] = f[i];
                    }
                    if (t4 < 64) { Lg[t4] = __expf(MISC[(rbase + t4) * 96 + 64 + h]); Lb[t4] = MISC[(rbase + t4) * 96 + 72 + h]; }
                    __syncthreads();
                    for (int s = 0; s < 64; ++s) {
                        const float a = Lg[s], be = Lb[s];
                        const float* kp = Lk + s * 64 + 16 * r; const float* qp = Lq + s * 64 + 16 * r;
                        float kk[16], qq[16];
#pragma unroll
                        for (int i = 0; i < 4; ++i) { const f32x4 kv = *(const f32x4*)(kp + 4 * i), qv = *(const f32x4*)(qp + 4 * i);
                            kk[4 * i] = kv[0]; kk[4 * i + 1] = kv[1]; kk[4 * i + 2] = kv[2]; kk[4 * i + 3] = kv[3]; qq[4 * i] = qv[0]; qq[4 * i + 1] = qv[1]; qq[4 * i + 2] = qv[2]; qq[4 * i + 3] = qv[3]; }
                        float p0 = 0.f, p1 = 0.f;
#pragma unroll
                        for (int i = 0; i < 16; i += 2) { p0 += kk[i] * Sr[i]; p1 += kk[i + 1] * Sr[i + 1]; }
                        float kS = p0 + p1; kS += __shfl_xor(kS, 16); kS += __shfl_xor(kS, 32);
                        const float cj = be * (Lv[s * 64 + j] - a * kS);
                        float o0 = 0.f, o1 = 0.f;
#pragma unroll
                        for (int i = 0; i < 16; i += 2) { Sr[i] = a * Sr[i] + kk[i] * cj; Sr[i + 1] = a * Sr[i + 1] + kk[i + 1] * cj; o0 += qq[i] * Sr[i]; o1 += qq[i + 1] * Sr[i + 1]; }
                        float o = o0 + o1; o += __shfl_xor(o, 16); o += __shfl_xor(o, 32);
                        if (r == 0) QKVA[(rbase + s) * 1536 + 1024 + h * 64 + j] = (h16)o;
                    }
                }
            } else {
                int* sel = (int*)lds + wave * 256;
                float* pb = (float*)(lds + 8192) + wave * 2048;
                const int nblk = G - NSCAN;
                for (int qg = bid - NSCAN; qg < T / 8; qg += nblk) {
                    const int row = qg * 8 + wave, b = row / SEQ;
                    unsigned long long word = MASK[(size_t)row * 64 + lane];
                    const int c = __popcll(word);
                    int incl = c;
#pragma unroll
                    for (int o = 1; o < 64; o <<= 1) { const int v = __shfl_up(incl, o); if (lane >= o) incl += v; }
                    const int tot = __shfl(incl, 63);
                    int pos = incl - c;
                    while (word) { const int bit = __ffsll((long long)word) - 1; sel[pos++] = lane * 64 + bit; word &= word - 1ull; }
                    float qf[8]; unpack8(*(const u32x4*)(QKVB + (size_t)row * 1536 + lane * 8), qf);
                    LDS_WAIT();
                    const h16* kbase = QKVB + (size_t)b * SEQ * 1536 + 512 + lane * 8;
                    for (int jj = 0; jj < tot; ++jj) {
                        const int s = sel[jj];
                        float kf[8]; unpack8(*(const u32x4*)(kbase + (size_t)s * 1536), kf);
                        float d = 0.f;
#pragma unroll
                        for (int i = 0; i < 8; ++i) d += qf[i] * kf[i];
                        d += __shfl_xor(d, 1); d += __shfl_xor(d, 2); d += __shfl_xor(d, 4);
                        if ((lane & 7) == 0) pb[(lane >> 3) * 256 + jj] = d;
                    }
                    LDS_WAIT();
                    float* ph_ = pb + (lane >> 3) * 256;
                    float mx = -INFINITY;
                    for (int jj = lane & 7; jj < tot; jj += 8) mx = fmaxf(mx, ph_[jj]);
                    mx = fmaxf(mx, __shfl_xor(mx, 1)); mx = fmaxf(mx, __shfl_xor(mx, 2)); mx = fmaxf(mx, __shfl_xor(mx, 4));
                    float sm = 0.f;
                    for (int jj = lane & 7; jj < tot; jj += 8) { const float e = __expf(ph_[jj] - mx); ph_[jj] = e; sm += e; }
                    sm += __shfl_xor(sm, 1); sm += __shfl_xor(sm, 2); sm += __shfl_xor(sm, 4);
                    const float inv = 1.0f / sm;
                    LDS_WAIT();
                    float acc[8];
#pragma unroll
                    for (int i = 0; i < 8; ++i) acc[i] = 0.f;
                    const h16* vbase = kbase + 512;
                    for (int jj = 0; jj < tot; ++jj) {
                        const int s = sel[jj];
                        float vf[8]; unpack8(*(const u32x4*)(vbase + (size_t)s * 1536), vf);
                        const float p = ph_[jj];
#pragma unroll
                        for (int i = 0; i < 8; ++i) acc[i] += p * vf[i];
                    }
                    f32x4 a0 = {acc[0] * inv, acc[1] * inv, acc[2] * inv, acc[3] * inv}, a1 = {acc[4] * inv, acc[5] * inv, acc[6] * inv, acc[7] * inv};
                    *(u32x4*)(QKVB + (size_t)row * 1536 + lane * 8) = pack8(a0, a1);
                    LDS_WAIT();
                }
            }
        } break;
        case 8: {
            const float* dg = args.in[I_DNG];
            float gg[8];
#pragma unroll
            for (int i = 0; i < 8; ++i) gg[i] = dg[(lane & 7) * 8 + i];
            for (int row = gw; row < T; row += ngw) {
                h16* op = QKVA + (size_t)row * 1536 + 1024 + lane * 8;
                float o[8], z[8]; unpack8(*(const u32x4*)op, o); unpack8(*(const u32x4*)(ZS + (size_t)row * 512 + lane * 8), z);
                float ss = 0.f;
#pragma unroll
                for (int i = 0; i < 8; ++i) ss += o[i] * o[i];
                ss += __shfl_xor(ss, 1); ss += __shfl_xor(ss, 2); ss += __shfl_xor(ss, 4);
                const float r = rsqrtf(ss * (1.0f / 64.0f) + EPS);
                f32x4 a0, a1;
#pragma unroll
                for (int i = 0; i < 4; ++i) { a0[i] = o[i] * r * gg[i] * z[i]; a1[i] = o[4 + i] * r * gg[4 + i] * z[4 + i]; }
                *(u32x4*)op = pack8(a0, a1);
            }
        } break;
        case 9:  g = pg8::Gemm{QKVA + 1024, WBA, T, D, 512, 1536}; E.mode = pg8::EPI_BRA; E.o16 = XN; E.ldo = D; E.g16 = GATES; break;
        case 10: g = pg8::Gemm{QKVB, WBB, T, D, 512, 1536}; E.mode = pg8::EPI_BRB; E.o16 = XN; E.ldo = D; E.g16 = GATES; break;
        case 11: g = pg8::Gemm{XN, WO, T, D, D, D}; E.mode = pg8::EPI_F32; E.o32 = Y; E.ldo = D; break;
        case 12: resid_norm_phase<false, false>(nullptr, H16, Y, 1.0f, args.in[I_MPOST], args.in[I_F2PRE], XN, nullptr, gw, ngw, lane); break;
        case 13: g = pg8::Gemm{XN, W3, T, 2 * FF, D, D}; E.mode = pg8::EPI_SWIGLU; E.o16 = HID; E.ldo = FF; break;
        case 14: g = pg8::Gemm{HID, W4, T, D, FF, FF}; E.mode = pg8::EPI_F32; E.o32 = Y; E.ldo = D; break;
        case 15: resid_norm_phase<false, false>(nullptr, H16, Y, 0.5f, args.in[I_F2POST], args.in[I_PPRE], XN, nullptr, gw, ngw, lane); break;
        case 16: g = pg8::Gemm{XN, WG, T, D, D, D}; E.mode = pg8::EPI_PLEG; E.o16 = TMP; E.ldo = D; break;
        case 17: g = pg8::Gemm{P16, WP, T, D, PLE, PLE}; E.mode = pg8::EPI_PLEP; E.o32 = Y; E.ldo = D; E.g16 = TMP; break;
        case 18: resid_norm_phase<false, true>(nullptr, H16, Y, 1.0f, args.in[I_PPOST], nullptr, nullptr, outp_, gw, ngw, lane); break;
        default: break;
        }
        if (E.mode >= 0) { pg8::StaticOrder S; S.init(T, g.N, G, bid); pg8::gemm_phase((LAS unsigned char*)lds, g, S, E, tid); }
        if (ph + 1 < args.ph_hi) grid.sync();
    }
}

constexpr int NPHASES = 19;

extern "C" void kernel_launch(void* const* d_in, const int* in_sizes, int n_in, void* d_out, int out_size, void* d_ws, size_t ws_size, hipStream_t stream) {
    static int grid = 0;
    if (grid == 0) {
        if (n_in != 25 || in_sizes[0] != T * D || out_size != T * D || ws_size < WS_END || ws_size < WS_HID + (size_t)T * FF * 2) {
            fprintf(stderr, "kernel_launch: unexpected shapes / workspace (n_in %d, in0 %d, out %d, ws %zu); nothing launched\n", n_in, n_in > 0 ? in_sizes[0] : -1, out_size, ws_size); grid = -1; return; }
        int dev = 0, cus = 0, per_cu = 0;
        hipGetDevice(&dev);
        hipDeviceGetAttribute(&cus, hipDeviceAttributeMultiprocessorCount, dev);
        hipFuncSetAttribute((const void*)fwd_kernel, hipFuncAttributeMaxDynamicSharedMemorySize, LDS_BYTES);
        hipOccupancyMaxActiveBlocksPerMultiprocessor(&per_cu, (const void*)fwd_kernel, NTHREADS, LDS_BYTES);
        if (per_cu < 1) { fprintf(stderr, "kernel_launch: occupancy query says %d blocks per CU\n", per_cu); per_cu = 1; }
        if (per_cu > 1) per_cu = 1;
        grid = cus * per_cu;
        (void)hipGetLastError();
    }
    if (grid < 0) return;
    Args a{};
    for (int i = 0; i < 25; ++i) a.in[i] = (const float*)d_in[i];
    a.out = (float*)d_out; a.ws = (unsigned char*)d_ws;
#if MK_PER_PHASE
    for (int ph = 0; ph < NPHASES; ++ph) {
        a.ph_lo = ph; a.ph_hi = ph + 1;
        void* kargs[] = {&a};
        hipError_t e = hipLaunchCooperativeKernel((const void*)fwd_kernel, dim3(grid), dim3(NTHREADS), kargs, LDS_BYTES, stream);
        if (e != hipSuccess) { fprintf(stderr, "launch failed: %s\n", hipGetErrorString(e)); break; }
    }
#else
    a.ph_lo = 0; a.ph_hi = NPHASES;
    void* kargs[] = {&a};
    hipError_t e = hipLaunchCooperativeKernel((const void*)fwd_kernel, dim3(grid), dim3(NTHREADS), kargs, LDS_BYTES, stream);
    if (e != hipSuccess) fprintf(stderr, "cooperative launch failed: %s (grid %d)\n", hipGetErrorString(e), grid);
#endif
}
```

```cpp
#include <hip/hip_runtime.h>
#include <hip/hip_cooperative_groups.h>
#include <cstdio>
#include <cstdint>
namespace cg = cooperative_groups;

#ifndef MK_PER_PHASE
#define MK_PER_PHASE 0
#endif

constexpr int T = 32768, D = 1024, FF = 2816, SEQ = 4096, NBATCH = 8, PLE = 256;
constexpr int NMIX = 6400;
constexpr float EPS = 1e-6f;
constexpr int NWAVES = 8, NTHREADS = 512;
constexpr int LDS_BYTES = 155648;

typedef _Float16 h16;
typedef _Float16 h16x8 __attribute__((ext_vector_type(8)));
typedef _Float16 h16x4 __attribute__((ext_vector_type(4)));
typedef short s16x8 __attribute__((ext_vector_type(8)));
typedef float f32x4 __attribute__((ext_vector_type(4)));
typedef unsigned u32x4 __attribute__((ext_vector_type(4)));
typedef unsigned u32x2 __attribute__((ext_vector_type(2)));
#define LAS __attribute__((address_space(3)))

constexpr size_t MiB = 1u << 20;
constexpr size_t WS_ROPE = 1 * MiB;
constexpr size_t WS_W1 = 2 * MiB;
constexpr size_t WS_W2 = WS_W1 + 11 * MiB;
constexpr size_t WS_WM = WS_W2 + 11 * MiB / 2;
constexpr size_t WS_WBA = WS_WM + 25 * MiB / 2;
constexpr size_t WS_WBB = WS_WBA + 1 * MiB;
constexpr size_t WS_WO = WS_WBB + 1 * MiB;
constexpr size_t WS_W3 = WS_WO + 2 * MiB;
constexpr size_t WS_W4 = WS_W3 + 11 * MiB;
constexpr size_t WS_WG = WS_W4 + 11 * MiB / 2;
constexpr size_t WS_WP = WS_WG + 2 * MiB;
constexpr size_t WS_P16 = 54 * MiB;
constexpr size_t WS_XN = 70 * MiB;
constexpr size_t WS_H16 = 134 * MiB;
constexpr size_t WS_ARENA = 198 * MiB;
constexpr size_t WS_HID = WS_ARENA;
constexpr size_t WS_TMP = WS_ARENA;
constexpr size_t WS_QKVA = WS_ARENA;
constexpr size_t WS_ZS = WS_QKVA + 96 * MiB;
constexpr size_t WS_QKVB = WS_ZS + 32 * MiB;
constexpr size_t WS_QI = WS_QKVB + 96 * MiB;
constexpr size_t WS_MISC = WS_QI + 32 * MiB;
constexpr size_t WS_MASK = WS_MISC + 12 * MiB;
constexpr size_t WS_HALO = WS_MASK + 16 * MiB;
constexpr size_t WS_KI = WS_HALO + 5 * MiB;
constexpr size_t WS_END = WS_KI + 4 * MiB;
static_assert(WS_WP + MiB / 2 <= WS_P16 && WS_END <= 512 * MiB && WS_HID + (size_t)T * FF * 2 <= 512 * MiB, "ws map");

__device__ __forceinline__ float sigmoidf_(float x) { return 1.0f / (1.0f + __expf(-x)); }
__device__ __forceinline__ float siluf_(float x) { return x / (1.0f + __expf(-x)); }
__device__ __forceinline__ u32x4 pack8(f32x4 a, f32x4 b) {
    h16x8 h = {(h16)a[0], (h16)a[1], (h16)a[2], (h16)a[3], (h16)b[0], (h16)b[1], (h16)b[2], (h16)b[3]};
    return __builtin_bit_cast(u32x4, h);
}
__device__ __forceinline__ u32x2 pack4(f32x4 a) {
    h16x4 h = {(h16)a[0], (h16)a[1], (h16)a[2], (h16)a[3]};
    return __builtin_bit_cast(u32x2, h);
}
__device__ __forceinline__ void unpack8(u32x4 w, float (&f)[8]) {
    h16x8 h = __builtin_bit_cast(h16x8, w);
#pragma unroll
    for (int i = 0; i < 8; ++i) f[i] = (float)h[i];
}
__device__ __forceinline__ float wave_sum(float v) {
#pragma unroll
    for (int o = 1; o < 64; o <<= 1) v += __shfl_xor(v, o);
    return v;
}
__device__ __forceinline__ int wave_sum_i(int v) {
#pragma unroll
    for (int o = 1; o < 64; o <<= 1) v += __shfl_xor(v, o);
    return v;
}
#define LDS_WAIT() asm volatile("s_waitcnt lgkmcnt(0)" ::: "memory")

namespace pg8 {
constexpr int BM = 256, BK = 64, HALF = 128, HTB = HALF * BK * 2, STAGE_BYTES = 8 * HTB, NXCD = 8, WGM = 8;
__host__ __device__ __forceinline__ int lds_byte(int r, int c) { const int st = (r >> 4) * 2 + (c >> 5), rr = r & 15, cc = c & 31, ob = rr * 64 + cc * 2; return st * 1024 + (ob ^ (((ob >> 9) & 1) << 5)); }
__host__ __device__ __forceinline__ void stage_rc(int b, int& R, int& C) { const int st = b / 1024, sb = b % 1024, swz = sb ^ (((sb >> 9) & 1) << 5); R = (st >> 1) * 16 + swz / 64; C = (st & 1) * 32 + (swz % 64) / 2; }
__host__ __device__ __forceinline__ int perm32(int rho) { const int n = rho >> 4, i = rho & 15; return 8 * (i >> 2) + 4 * n + (i & 3); }
struct Unit { int pm, pn; };
struct Gemm { const h16* A; const h16* Bt; int M, N, K, lda; };
struct StaticOrder {
    int nM, nN, nwg, G, c;
    __device__ void init(int M, int N, int G_, int c_) { nM = M / BM; nN = N / BM; nwg = nM * nN; G = G_; c = c_; }
    __device__ bool next(int i, Unit& u) const {
        const long L = (long)i * G + c; if (L >= nwg) return false;
        int wgid = (int)L; { const int q = nwg / NXCD, r = nwg % NXCD, xcd = wgid % NXCD, off = wgid / NXCD; wgid = (xcd < r ? xcd * (q + 1) : r * (q + 1) + (xcd - r) * q) + off; }
        const int nig = WGM * nN, gid = wgid / nig, fm = gid * WGM, gsz = (nM - fm) < WGM ? (nM - fm) : WGM;
        u.pm = fm + ((wgid % nig) % gsz); u.pn = (wgid % nig) / gsz; return true;
    }
};

enum { EPI_SWIGLU = 0, EPI_F32 = 1, EPI_MIX = 2, EPI_BRA = 3, EPI_BRB = 4, EPI_PLEG = 5, EPI_PLEP = 6 };
struct Epi {
    int mode;
    h16* o16; float* o32; int ldo;
    const h16* g16;
    h16 *qkva, *zs, *qkvb, *qi, *gates, *halo; float* misc; const float *rope, *a_log, *dt_bias;
    __device__ __forceinline__ void operator()(const f32x4 (&acc)[2][2][4][2], const Unit& u, int wr, int wc, int fr, int fq) const {
        const int cb = wc * 32 + 8 * fq;
        const int row0 = u.pm * BM + wr * 64 + fr;
        if (mode == EPI_SWIGLU) {
#pragma unroll
            for (int ai = 0; ai < 2; ++ai)
#pragma unroll
                for (int m = 0; m < 4; ++m) {
                    const int row = row0 + ai * HALF + m * 16;
                    f32x4 r0, r1;
#pragma unroll
                    for (int i = 0; i < 4; ++i) { r0[i] = siluf_(acc[ai][0][m][0][i]) * acc[ai][1][m][0][i]; r1[i] = siluf_(acc[ai][0][m][1][i]) * acc[ai][1][m][1][i]; }
                    *(u32x4*)(o16 + (size_t)row * ldo + u.pn * 128 + cb) = pack8(r0, r1);
                }
        } else if (mode == EPI_F32) {
#pragma unroll
            for (int ai = 0; ai < 2; ++ai)
#pragma unroll
                for (int m = 0; m < 4; ++m) {
                    const int row = row0 + ai * HALF + m * 16;
#pragma unroll
                    for (int bj = 0; bj < 2; ++bj) { float* p = o32 + (size_t)row * ldo + u.pn * BM + bj * HALF + cb; *(f32x4*)p = acc[ai][bj][m][0]; *(f32x4*)(p + 4) = acc[ai][bj][m][1]; }
                }
        } else if (mode == EPI_BRA || mode == EPI_BRB || mode == EPI_PLEP) {
#pragma unroll
            for (int ai = 0; ai < 2; ++ai)
#pragma unroll
                for (int m = 0; m < 4; ++m) {
                    const int row = row0 + ai * HALF + m * 16;
#pragma unroll
                    for (int bj = 0; bj < 2; ++bj) {
                        const int col = u.pn * BM + bj * HALF + cb;
                        float g[8]; unpack8(*(const u32x4*)(g16 + (size_t)row * (mode == EPI_PLEP ? 1024 : 2048) + (mode == EPI_BRB ? 1024 : 0) + col), g);
                        f32x4 r0, r1;
#pragma unroll
                        for (int i = 0; i < 4; ++i) { r0[i] = g[i] * acc[ai][bj][m][0][i]; r1[i] = g[4 + i] * acc[ai][bj][m][1][i]; }
                        if (mode == EPI_PLEP) { float* p = o32 + (size_t)row * ldo + col; *(f32x4*)p = r0; *(f32x4*)(p + 4) = r1; }
                        else {
                            h16* p = o16 + (size_t)row * ldo + col;
                            if (mode == EPI_BRB) { float o[8]; unpack8(*(const u32x4*)p, o);
#pragma unroll
                                for (int i = 0; i < 4; ++i) { r0[i] += o[i]; r1[i] += o[4 + i]; } }
                            *(u32x4*)p = pack8(r0, r1);
                        }
                    }
                }
        } else if (mode == EPI_PLEG) {
#pragma unroll
            for (int ai = 0; ai < 2; ++ai)
#pragma unroll
                for (int m = 0; m < 4; ++m) {
                    const int row = row0 + ai * HALF + m * 16;
#pragma unroll
                    for (int bj = 0; bj < 2; ++bj) {
                        f32x4 r0, r1;
#pragma unroll
                        for (int i = 0; i < 4; ++i) { r0[i] = sigmoidf_(acc[ai][bj][m][0][i]); r1[i] = sigmoidf_(acc[ai][bj][m][1][i]); }
                        *(u32x4*)(o16 + (size_t)row * ldo + u.pn * BM + bj * HALF + cb) = pack8(r0, r1);
                    }
                }
        } else {
            const int pn = u.pn;
#pragma unroll
            for (int ai = 0; ai < 2; ++ai)
#pragma unroll
                for (int m = 0; m < 4; ++m) {
                    const int row = row0 + ai * HALF + m * 16;
#pragma unroll
                    for (int bj = 0; bj < 2; ++bj) {
                        const int tc = bj * HALF + cb;
                        f32x4 v0 = acc[ai][bj][m][0], v1 = acc[ai][bj][m][1];
                        if (pn < 6) {
                            const u32x4 w = pack8(v0, v1);
                            *(u32x4*)(qkva + (size_t)row * 1536 + pn * 256 + tc) = w;
                            if ((row & 63) >= 61) *(u32x4*)(halo + ((size_t)(row >> 6) * 3 + ((row & 63) - 61)) * 1536 + pn * 256 + tc) = w;
                        } else if (pn < 8) {
#pragma unroll
                            for (int i = 0; i < 4; ++i) { v0[i] = siluf_(v0[i]); v1[i] = siluf_(v1[i]); }
                            *(u32x4*)(zs + (size_t)row * 512 + (pn - 6) * 256 + tc) = pack8(v0, v1);
                        } else if (pn < 16) {
                            const bool rope_tile = (pn < 12) || (pn >= 14);
                            if (rope_tile && !(wc & 1)) {
                                f32x4 p0, p1;
#pragma unroll
                                for (int i = 0; i < 4; ++i) { p0[i] = __shfl_xor(v0[i], 16); p1[i] = __shfl_xor(v1[i], 16); }
                                if (fq < 2) {
                                    const float* rp = rope + (size_t)(row & (SEQ - 1)) * 16;
                                    const f32x4 c0 = *(const f32x4*)rp, c1 = *(const f32x4*)(rp + 4), s0 = *(const f32x4*)(rp + 8), s1 = *(const f32x4*)(rp + 12);
                                    const float sg = fq == 0 ? -1.f : 1.f;
#pragma unroll
                                    for (int i = 0; i < 4; ++i) { v0[i] = v0[i] * c0[i] + sg * p0[i] * s0[i]; v1[i] = v1[i] * c1[i] + sg * p1[i] * s1[i]; }
                                }
                            }
                            if (pn < 10) { v0 = v0 * 0.125f; v1 = v1 * 0.125f; }
                            h16* dst = pn < 14 ? qkvb + (size_t)row * 1536 + (pn - 8) * 256 + tc : qi + (size_t)row * 512 + (pn - 14) * 256 + tc;
                            *(u32x4*)dst = pack8(v0, v1);
                        } else if (pn < 24) {
#pragma unroll
                            for (int i = 0; i < 4; ++i) { v0[i] = sigmoidf_(v0[i]); v1[i] = sigmoidf_(v1[i]); }
                            *(u32x4*)(gates + (size_t)row * 2048 + (pn - 16) * 256 + tc) = pack8(v0, v1);
                        } else if (bj == 0) {
                            float* mp = misc + (size_t)row * 96;
                            if (wc < 2) { *(f32x4*)(mp + tc) = v0; *(f32x4*)(mp + tc + 4) = v1; }
                            else if (wc == 2 && fq < 3) {
                                float r[8] = {v0[0], v0[1], v0[2], v0[3], v1[0], v1[1], v1[2], v1[3]};
                                if (fq == 0) {
#pragma unroll
                                    for (int i = 0; i < 8; ++i) { const float xx = r[i] + dt_bias[i]; const float sp = xx > 20.f ? xx : log1pf(expf(xx)); r[i] = -expf(a_log[i]) * sp; }
                                } else if (fq == 1) {
#pragma unroll
                                    for (int i = 0; i < 8; ++i) r[i] = 1.0f / (1.0f + expf(-r[i]));
                                } else {
#pragma unroll
                                    for (int i = 0; i < 8; ++i) r[i] *= 0.04419417382415922f;
                                }
                                *(f32x4*)(mp + 64 + 8 * fq) = (f32x4){r[0], r[1], r[2], r[3]}; *(f32x4*)(mp + 68 + 8 * fq) = (f32x4){r[4], r[5], r[6], r[7]};
                            }
                        }
                    }
                }
        }
    }
};

__device__ __forceinline__ void gemm_phase(LAS unsigned char* lds, const Gemm g, const StaticOrder& S, const Epi& E, const int tid) {
    const int wid = __builtin_amdgcn_readfirstlane(tid >> 6), lane = tid & 63, wr = wid >> 2, wc = wid & 3, fr = lane & 15, fq = lane >> 4;
    const int K = g.K, nt = K / BK, lda = g.lda;
    unsigned voffA[2], voffB[2];
#pragma unroll
    for (int i = 0; i < 2; ++i) { int R, C; stage_rc(tid * 16 + i * 8192, R, C); const int Rb = (R & ~31) + perm32(R & 31);
        voffA[i] = (unsigned)(R * lda + C) * 2u; voffB[i] = (unsigned)(Rb * K + C) * 2u; }
    const size_t kstep = (size_t)(BK * 2);
    const size_t hstepA = (size_t)HALF * lda * 2, hstepB = (size_t)HALF * K * 2;
    const size_t tstepA = 2 * hstepA, tstepB = 2 * hstepB;
    const unsigned ldsw = (unsigned)wid * 1024u;
    const int aoff = lds_byte(wr * 64 + fr, fq * 8), boff = lds_byte(wc * 32 + fr, fq * 8);
#define PG8_SA(b, h) (((b) * 2 + (h)) * HTB)
#define PG8_SB(b, h) ((4 + (b) * 2 + (h)) * HTB)
#define PG8_STAGE(bufoff, gbase, voff) do { _Pragma("unroll") for (int _i = 0; _i < 2; ++_i) \
        __builtin_amdgcn_global_load_lds((const unsigned*)((const char*)(gbase) + (voff)[_i]), (LAS unsigned*)(lds + (bufoff) + ldsw + _i * 8192), 16, 0, 0); } while (0)
#define PG8_LDA(dst, b, h) do { _Pragma("unroll") for (int m = 0; m < 4; ++m) _Pragma("unroll") for (int k = 0; k < 2; ++k) dst[m][k] = *(const LAS s16x8*)(lds + PG8_SA(b, h) + aoff + m * 2048 + k * 1024); } while (0)
#define PG8_LDB(dst, b, h) do { _Pragma("unroll") for (int n = 0; n < 2; ++n) _Pragma("unroll") for (int k = 0; k < 2; ++k) dst[n][k] = *(const LAS s16x8*)(lds + PG8_SB(b, h) + boff + n * 2048 + k * 1024); } while (0)
#define PG8_MMA(ai, bj, At, Bt) do { __builtin_amdgcn_s_setprio(1); _Pragma("unroll") for (int m = 0; m < 4; ++m) _Pragma("unroll") for (int n = 0; n < 2; ++n) _Pragma("unroll") for (int k = 0; k < 2; ++k) \
        acc[ai][bj][m][n] = __builtin_amdgcn_mfma_f32_16x16x32_f16(__builtin_bit_cast(h16x8, Bt[n][k]), __builtin_bit_cast(h16x8, At[m][k]), acc[ai][bj][m][n], 0, 0, 0); __builtin_amdgcn_s_setprio(0); } while (0)
#define PG8_WAIT_V(n) asm volatile("s_waitcnt vmcnt(" #n ")" ::: "memory")
#define PG8_WAIT_L(n) asm volatile("s_waitcnt lgkmcnt(" #n ")" ::: "memory")
#define PG8_BAR __builtin_amdgcn_s_barrier()
#define PG8_SCHED __builtin_amdgcn_sched_barrier(0)
    Unit cur, nxt; int ui = 0;
    if (!S.next(0, cur)) return;
    f32x4 acc[2][2][4][2];
#pragma unroll
    for (int a = 0; a < 2; ++a)
#pragma unroll
        for (int b = 0; b < 2; ++b)
#pragma unroll
            for (int m = 0; m < 4; ++m)
#pragma unroll
                for (int n = 0; n < 2; ++n) acc[a][b][m][n] = (f32x4){0.f, 0.f, 0.f, 0.f};
    s16x8 At[4][2], B0[2][2], B1[2][2];
    const char* cA = (const char*)g.A + (size_t)cur.pm * tstepA; const char* cB = (const char*)g.Bt + (size_t)cur.pn * tstepB;
    PG8_STAGE(PG8_SB(0, 0), cB, voffB); PG8_STAGE(PG8_SB(0, 1), cB + hstepB, voffB); PG8_STAGE(PG8_SA(0, 0), cA, voffA); PG8_STAGE(PG8_SA(0, 1), cA + hstepA, voffA);
    if (wr == 1) PG8_BAR;
    PG8_WAIT_V(2); PG8_BAR;
    PG8_STAGE(PG8_SB(1, 0), cB + kstep, voffB); PG8_STAGE(PG8_SA(1, 0), cA + kstep, voffA); PG8_STAGE(PG8_SB(1, 1), cB + hstepB + kstep, voffB);
    PG8_WAIT_V(6); PG8_BAR;
    for (;;) {
        const bool has_next = S.next(ui + 1, nxt);
        const char* nA = has_next ? (const char*)g.A + (size_t)nxt.pm * tstepA : cA; const char* nB = has_next ? (const char*)g.Bt + (size_t)nxt.pn * tstepB : cB;
        for (int t = 0; t < nt; t += 2) {
            const bool last = (t == nt - 2);
            const char* a1 = cA + (size_t)(t + 1) * kstep;
            const char* a2 = last ? nA : cA + (size_t)(t + 2) * kstep; const char* b2 = last ? nB : cB + (size_t)(t + 2) * kstep;
            const char* a3 = a2 + kstep; const char* b3 = b2 + kstep;
            PG8_LDB(B0, 0, 0); PG8_LDB(B1, 0, 1); PG8_SCHED; PG8_LDA(At, 0, 0); PG8_STAGE(PG8_SA(1, 1), a1 + hstepA, voffA);
            PG8_WAIT_V(8); PG8_WAIT_L(0); PG8_BAR; PG8_MMA(0, 0, At, B0); PG8_MMA(0, 1, At, B1); PG8_BAR; PG8_SCHED;
            PG8_LDA(At, 0, 1); PG8_STAGE(PG8_SB(0, 0), b2, voffB); PG8_STAGE(PG8_SB(0, 1), b2 + hstepB, voffB); PG8_STAGE(PG8_SA(0, 0), a2, voffA);
            PG8_WAIT_V(8); PG8_WAIT_L(0); PG8_BAR; PG8_MMA(1, 0, At, B0); PG8_MMA(1, 1, At, B1); PG8_BAR; PG8_SCHED;
            PG8_LDB(B0, 1, 0); PG8_LDB(B1, 1, 1); PG8_SCHED; PG8_LDA(At, 1, 0); PG8_STAGE(PG8_SA(0, 1), a2 + hstepA, voffA);
            PG8_WAIT_V(8); PG8_WAIT_L(0); PG8_BAR; PG8_MMA(0, 0, At, B0); PG8_MMA(0, 1, At, B1); PG8_BAR; PG8_SCHED;
            PG8_LDA(At, 1, 1); PG8_STAGE(PG8_SB(1, 0), b3, voffB); PG8_STAGE(PG8_SB(1, 1), b3 + hstepB, voffB); PG8_STAGE(PG8_SA(1, 0), a3, voffA);
            PG8_WAIT_V(8); PG8_WAIT_L(0); PG8_BAR; PG8_MMA(1, 0, At, B0); PG8_MMA(1, 1, At, B1); PG8_BAR; PG8_SCHED;
        }
        if (wr == 0) PG8_BAR;
        E(acc, cur, wr, wc, fr, fq);
        if (!has_next) break;
#pragma unroll
        for (int a = 0; a < 2; ++a)
#pragma unroll
            for (int b = 0; b < 2; ++b)
#pragma unroll
                for (int m = 0; m < 4; ++m)
#pragma unroll
                    for (int n = 0; n < 2; ++n) acc[a][b][m][n] = (f32x4){0.f, 0.f, 0.f, 0.f};
        cur = nxt; cA = nA; cB = nB; ++ui;
        if (wr == 1) PG8_BAR;
    }
    PG8_WAIT_V(0);
    PG8_BAR;
#undef PG8_SA
#undef PG8_SB
#undef PG8_STAGE
#undef PG8_LDA
#undef PG8_LDB
#undef PG8_MMA
#undef PG8_WAIT_V
#undef PG8_WAIT_L
#undef PG8_BAR
#undef PG8_SCHED
}
}

struct Args { const float* in[25]; float* out; unsigned char* ws; int ph_lo, ph_hi; };
enum { I_X = 0, I_P, I_F1PRE, I_F1POST, I_F1WIN, I_F1WOUT, I_MPRE, I_MPOST, I_MWIN, I_CONVW, I_ALOG, I_DTB, I_DNG, I_IDXG, I_WBA, I_WBB, I_MWOUT,
       I_F2PRE, I_F2POST, I_F2WIN, I_F2WOUT, I_PPRE, I_PPOST, I_PWG, I_PWP };

__device__ __forceinline__ int srccol(int map, int n) {
    if (map == 0) return n;
    if (map == 1) { const int pn = n >> 8, tc = n & 255; return tc < 128 ? pn * 128 + tc : FF + pn * 128 + (tc - 128); }
    if (n < 2048) return n;
    if (n < 4096) return 2064 + (n - 2048);
    if (n < 6144) return 4184 + (n - 4096);
    const int tc = n - 6144;
    if (tc < 64) return 4112 + tc;
    if (tc < 72) return 2048 + (tc - 64);
    if (tc < 80) return 2056 + (tc - 72);
    if (tc < 88) return 4176 + (tc - 80);
    return -1;
}
__device__ __forceinline__ void transpose_item(const float* W, int K, int N, h16* WT, int NP, int map, float* scr, int item, int lane) {
    const int nblk = NP / 32, kb = item / nblk, nb = item % nblk, k0 = 64 * kb, n0 = 32 * nb;
    const int sc = srccol(map, n0 + (lane & 31));
#pragma unroll 8
    for (int i = 0; i < 32; ++i) { const int kk = 2 * i + (lane >> 5); scr[kk * 33 + (lane & 31)] = sc >= 0 ? W[(size_t)(k0 + kk) * N + sc] : 0.f; }
    LDS_WAIT();
    const int c = lane & 7;
#pragma unroll
    for (int j = 0; j < 4; ++j) { const int n = (lane >> 3) + 8 * j; const float* s = scr + (8 * c) * 33 + n;
        f32x4 a = {s[0], s[33], s[66], s[99]}, b = {s[132], s[165], s[198], s[231]};
        *(u32x4*)(WT + (size_t)(n0 + n) * K + k0 + 8 * c) = pack8(a, b); }
    LDS_WAIT();
}

__device__ __forceinline__ void load_row_f32(const float* p, int lane, f32x4 (&v)[4]) {
#pragma unroll
    for (int j = 0; j < 4; ++j) v[j] = *(const f32x4*)(p + 4 * lane + 256 * j);
}
__device__ __forceinline__ void load_row_h16(const h16* p, int lane, f32x4 (&v)[4]) {
#pragma unroll
    for (int j = 0; j < 4; ++j) { const h16x4 h = *(const h16x4*)(p + 4 * lane + 256 * j); v[j] = (f32x4){(float)h[0], (float)h[1], (float)h[2], (float)h[3]}; }
}
__device__ __forceinline__ float row_rms_scale(const f32x4 (&v)[4]) {
    float s = 0.f;
#pragma unroll
    for (int j = 0; j < 4; ++j) s += (v[j][0] * v[j][0] + v[j][1] * v[j][1]) + (v[j][2] * v[j][2] + v[j][3] * v[j][3]);
    return rsqrtf(wave_sum(s) * (1.0f / D) + EPS);
}
template <bool BASE_F32, bool FINAL>
__device__ __forceinline__ void resid_norm_phase(const float* xbase, h16* H, const float* Y, float coef, const float* g_post, const float* g_pre, h16* XN, float* outp, int gw, int ngw, int lane) {
    for (int row = gw; row < T; row += ngw) {
        f32x4 y[4], b[4], gp[4];
        load_row_f32(Y + (size_t)row * D, lane, y);
        if (BASE_F32) load_row_f32(xbase + (size_t)row * D, lane, b); else load_row_h16(H + (size_t)row * D, lane, b);
        load_row_f32(g_post, lane, gp);
        const float r = row_rms_scale(y) * coef;
#pragma unroll
        for (int j = 0; j < 4; ++j) b[j] = b[j] + y[j] * r * gp[j];
        if (FINAL) {
#pragma unroll
            for (int j = 0; j < 4; ++j) *(f32x4*)(outp + (size_t)row * D + 4 * lane + 256 * j) = b[j];
        } else {
            f32x4 g2[4]; load_row_f32(g_pre, lane, g2);
            const float r2 = row_rms_scale(b);
#pragma unroll
            for (int j = 0; j < 4; ++j) {
                *(u32x2*)(H + (size_t)row * D + 4 * lane + 256 * j) = pack4(b[j]);
                *(u32x2*)(XN + (size_t)row * D + 4 * lane + 256 * j) = pack4(b[j] * r2 * g2[j]);
            }
        }
    }
}

__global__ void __launch_bounds__(NTHREADS, 2) fwd_kernel(Args args) {
    extern __shared__ __attribute__((aligned(16))) unsigned char lds[];
    cg::grid_group grid = cg::this_grid();
    const int G = gridDim.x, bid = blockIdx.x;
#ifdef DUP_PHASE
    bool dup_done = false;
#endif
    for (int ph = args.ph_lo; ph < args.ph_hi; ++ph) {
    int tid = threadIdx.x; asm volatile("" : "+v"(tid));
    unsigned char* ws = args.ws; asm volatile("" : "+s"(ws));
    float* outp_ = args.out; asm volatile("" : "+s"(outp_));
    const int lane = tid & 63, wave = __builtin_amdgcn_readfirstlane(tid >> 6);
    const int gw = bid * NWAVES + wave, ngw = G * NWAVES;
    float* ROPE = (float*)(ws + WS_ROPE);
    h16 *W1 = (h16*)(ws + WS_W1), *W2 = (h16*)(ws + WS_W2), *WM = (h16*)(ws + WS_WM), *WBA = (h16*)(ws + WS_WBA), *WBB = (h16*)(ws + WS_WBB), *WO = (h16*)(ws + WS_WO);
    h16 *W3 = (h16*)(ws + WS_W3), *W4 = (h16*)(ws + WS_W4), *WG = (h16*)(ws + WS_WG), *WP = (h16*)(ws + WS_WP);
    h16 *P16 = (h16*)(ws + WS_P16), *XN = (h16*)(ws + WS_XN), *H16 = (h16*)(ws + WS_H16), *HID = (h16*)(ws + WS_HID), *TMP = (h16*)(ws + WS_TMP);
    h16 *QKVA = (h16*)(ws + WS_QKVA), *ZS = (h16*)(ws + WS_ZS), *QKVB = (h16*)(ws + WS_QKVB), *QI = (h16*)(ws + WS_QI), *HALO = (h16*)(ws + WS_HALO), *KI = (h16*)(ws + WS_KI);
    float* MISC = (float*)(ws + WS_MISC);
    unsigned long long* MASK = (unsigned long long*)(ws + WS_MASK);
    float* Y = outp_;
    h16* GATES = (h16*)outp_;

        pg8::Gemm g{nullptr, nullptr, T, 0, 0, 0};
        pg8::Epi E{}; E.mode = -1;
        switch (ph) {
        case 0: {
            float* scr = (float*)lds + wave * (64 * 33);
            constexpr int I1 = 16 * (5632 / 32), I2 = 44 * 32, IM = 16 * (NMIX / 32), IB = 8 * 32, IO = 16 * 32, IP = 4 * 32;
            constexpr int NIT = 2 * I1 + 2 * I2 + IM + 2 * IB + 2 * IO + IP;
            for (int it = gw; it < NIT; it += ngw) {
                int r = it;
                if (r < I1) { transpose_item(args.in[I_F1WIN], D, 2 * FF, W1, 2 * FF, 1, scr, r, lane); continue; } r -= I1;
                if (r < I1) { transpose_item(args.in[I_F2WIN], D, 2 * FF, W3, 2 * FF, 1, scr, r, lane); continue; } r -= I1;
                if (r < I2) { transpose_item(args.in[I_F1WOUT], FF, D, W2, D, 0, scr, r, lane); continue; } r -= I2;
                if (r < I2) { transpose_item(args.in[I_F2WOUT], FF, D, W4, D, 0, scr, r, lane); continue; } r -= I2;
                if (r < IM) { transpose_item(args.in[I_MWIN], D, 6232, WM, NMIX, 2, scr, r, lane); continue; } r -= IM;
                if (r < IB) { transpose_item(args.in[I_WBA], 512, D, WBA, D, 0, scr, r, lane); continue; } r -= IB;
                if (r < IB) { transpose_item(args.in[I_WBB], 512, D, WBB, D, 0, scr, r, lane); continue; } r -= IB;
                if (r < IO) { transpose_item(args.in[I_MWOUT], D, D, WO, D, 0, scr, r, lane); continue; } r -= IO;
                if (r < IO) { transpose_item(args.in[I_PWG], D, D, WG, D, 0, scr, r, lane); continue; } r -= IO;
                transpose_item(args.in[I_PWP], PLE, D, WP, D, 0, scr, r, lane);
            }
            { const float* p = args.in[I_P]; const size_t n8 = (size_t)T * PLE / 8;
              for (size_t i = (size_t)bid * NTHREADS + tid; i < n8; i += (size_t)G * NTHREADS) { const f32x4 a = *(const f32x4*)(p + 8 * i), b = *(const f32x4*)(p + 8 * i + 4); *(u32x4*)(P16 + 8 * i) = pack8(a, b); } }
            for (int i = bid * NTHREADS + tid; i < SEQ * 8; i += G * NTHREADS) {
                const int pos = i >> 3, f = i & 7;
                const float invt[8] = {1.0f, 0.1939227432012558f, 0.03760603070259094f, 0.007292664609849453f, 0.0014142135623842478f, 0.00027424818836152554f, 5.3182957344688475e-05f, 1.0313385246263351e-05f};
                float inv = invt[0];
#pragma unroll
                for (int q = 1; q < 8; ++q) inv = (f == q) ? invt[q] : inv;
                const float ang = (float)pos * inv;
                ROPE[pos * 16 + f] = cosf(ang); ROPE[pos * 16 + 8 + f] = sinf(ang);
            }
            { const float* x = args.in[I_X]; const float* gp = args.in[I_F1PRE];
              for (int row = gw; row < T; row += ngw) { f32x4 v[4], gg[4]; load_row_f32(x + (size_t)row * D, lane, v); load_row_f32(gp, lane, gg); const float r = row_rms_scale(v);
#pragma unroll
                  for (int j = 0; j < 4; ++j) *(u32x2*)(XN + (size_t)row * D + 4 * lane + 256 * j) = pack4(v[j] * r * gg[j]); } }
        } break;
        case 1: g = pg8::Gemm{XN, W1, T, 2 * FF, D, D}; E.mode = pg8::EPI_SWIGLU; E.o16 = HID; E.ldo = FF; break;
        case 2: g = pg8::Gemm{HID, W2, T, D, FF, FF}; E.mode = pg8::EPI_F32; E.o32 = Y; E.ldo = D; break;
        case 3: resid_norm_phase<true, false>(args.in[I_X], H16, Y, 0.5f, args.in[I_F1POST], args.in[I_MPRE], XN, nullptr, gw, ngw, lane); break;
        case 4: g = pg8::Gemm{XN, WM, T, NMIX, D, D}; E.mode = pg8::EPI_MIX; E.qkva = QKVA; E.zs = ZS; E.qkvb = QKVB; E.qi = QI; E.gates = GATES; E.halo = HALO; E.misc = MISC;
                E.rope = ROPE; E.a_log = args.in[I_ALOG]; E.dt_bias = args.in[I_DTB]; break;
        case 5: {
            const float* cw = args.in[I_CONVW];
            for (int unit = gw; unit < 512 * 24; unit += ngw) {
                const int c = unit / 24, grp = unit % 24, ch = grp * 64 + lane;
                const float w0 = cw[ch], w1 = cw[1536 + ch], w2 = cw[2 * 1536 + ch], w3 = cw[3 * 1536 + ch];
                float xm3 = 0.f, xm2 = 0.f, xm1 = 0.f;
                if (c & 63) { const h16* hp = HALO + (size_t)(c - 1) * 3 * 1536 + ch; xm3 = (float)hp[0]; xm2 = (float)hp[1536]; xm1 = (float)hp[2 * 1536]; }
                h16* base = QKVA + (size_t)c * 64 * 1536 + ch;
                float xv[64];
#pragma unroll
                for (int r = 0; r < 64; ++r) xv[r] = (float)base[(size_t)r * 1536];
#pragma unroll
                for (int r = 0; r < 64; ++r) {
                    const float x0 = xv[r];
                    float yv = siluf_(w0 * xm3 + w1 * xm2 + w2 * xm1 + w3 * x0);
                    xm3 = xm2; xm2 = xm1; xm1 = x0;
                    if (grp < 16) { const float ss = wave_sum(yv * yv); yv *= rsqrtf(ss + EPS); if (grp < 8) yv *= 0.125f; }
                    xv[r] = yv;
                }
#pragma unroll
                for (int r = 0; r < 64; ++r) base[(size_t)r * 1536] = (h16)xv[r];
            }
            { h16* VT = (h16*)(ws + WS_XN);
              for (int unit = gw; unit < 64 * 64; unit += ngw) {
                  const int bh = unit >> 6, tt = unit & 63, b = bh >> 3, h = bh & 7;
                  const h16* src = QKVB + ((size_t)b * SEQ + tt * 64) * 1536 + 1024 + h * 64 + lane;
                  h16 col[64];
#pragma unroll
                  for (int r = 0; r < 64; ++r) col[r] = src[(size_t)r * 1536];
                  h16* dst = VT + ((size_t)bh * 64 + lane) * SEQ + tt * 64;
#pragma unroll
                  for (int c8 = 0; c8 < 8; ++c8) { h16x8 v;
#pragma unroll
                      for (int i = 0; i < 8; ++i) v[i] = col[8 * c8 + i];
                      *(h16x8*)(dst + 8 * c8) = v; }
              } }
            const float* ig = args.in[I_IDXG];
            for (int row = gw; row < T; row += ngw) {
                float v = MISC[(size_t)row * 96 + lane];
                const float ss = wave_sum(v * v);
                v = v * rsqrtf(ss * (1.0f / 64.0f) + EPS) * ig[lane];
                const float pr = __shfl_xor(v, 8);
                if (lane < 16) { const float* rp = ROPE + (size_t)(row & (SEQ - 1)) * 16; const float c = rp[lane & 7], s = rp[8 + (lane & 7)]; v = lane < 8 ? v * c - pr * s : v * c + pr * s; }
                KI[(size_t)row * 64 + lane] = (h16)v;
            }
        } break;
        case 6: {
            typedef float f32x16 __attribute__((ext_vector_type(16)));
            unsigned* sc = (unsigned*)lds;
            const int r32 = lane & 31, hi = lane >> 5;
            for (int k = bid; k < T / 8; k += G) {
                const int b = k & 7, t0 = (511 - (k >> 3)) * 8, row0 = b * SEQ + t0;
                h16x8 qa[2][4]; float wv[2][2][8];
                {   const int g_ = r32 >> 3, hi_ = (r32 >> 2) & 1, head = 4 * (g_ & 1) + (r32 & 3);
#pragma unroll
                    for (int mt = 0; mt < 2; ++mt) { const h16* qp = QI + (size_t)(row0 + 4 * mt + 2 * hi_ + (g_ >> 1)) * 512 + head * 64 + 8 * hi;
#pragma unroll
                        for (int ks = 0; ks < 4; ++ks) qa[mt][ks] = *(const h16x8*)(qp + 16 * ks); }
#pragma unroll
                    for (int mt = 0; mt < 2; ++mt)
#pragma unroll
                        for (int qq = 0; qq < 2; ++qq) { const float* wp = MISC + (size_t)(row0 + 4 * mt + 2 * hi + qq) * 96 + 80; const f32x4 a = *(const f32x4*)wp, c = *(const f32x4*)(wp + 4);
                            wv[mt][qq][0] = a[0]; wv[mt][qq][1] = a[1]; wv[mt][qq][2] = a[2]; wv[mt][qq][3] = a[3]; wv[mt][qq][4] = c[0]; wv[mt][qq][5] = c[1]; wv[mt][qq][6] = c[2]; wv[mt][qq][7] = c[3]; }
                }
                const int nkt = 2 * ((t0 + 8 + 63) >> 6);
                for (int kt = wave; kt < nkt; kt += NWAVES) {
                    const h16* kp = KI + ((size_t)b * SEQ + 32 * kt + r32) * 64 + 8 * hi;
                    h16x8 kb[4];
#pragma unroll
                    for (int ks = 0; ks < 4; ++ks) kb[ks] = *(const h16x8*)(kp + 16 * ks);
                    const int key = 32 * kt + r32;
#pragma unroll
                    for (int mt = 0; mt < 2; ++mt) {
                        f32x16 acc = {0.f, 0.f, 0.f, 0.f, 0.f, 0.f, 0.f, 0.f, 0.f, 0.f, 0.f, 0.f, 0.f, 0.f, 0.f, 0.f};
#pragma unroll
                        for (int ks = 0; ks < 4; ++ks) acc = __builtin_amdgcn_mfma_f32_32x32x16_f16(qa[mt][ks], kb[ks], acc, 0, 0, 0);
#pragma unroll
                        for (int qq = 0; qq < 2; ++qq) {
                            float sv = 0.f;
#pragma unroll
                            for (int h = 0; h < 8; ++h) sv = fmaf(wv[mt][qq][h], fmaxf(acc[8 * qq + h], 0.f), sv);
                            const int ql = 4 * mt + 2 * hi + qq;
                            unsigned u = __float_as_uint(sv); u = (u & 0x80000000u) ? ~u : (u | 0x80000000u);
                            sc[ql * 4096 + key] = (key <= t0 + ql) ? u : 0u;
                        }
                    }
                }
                __syncthreads();
                {
                    const int t = t0 + wave, n = t + 1, nw = (n + 63) >> 6;
                    const unsigned* scq = sc + wave * 4096;
                    unsigned uk[64];
#pragma unroll
                    for (int i = 0; i < 64; ++i) uk[i] = (i < nw) ? scq[i * 64 + lane] : 0u;
                    unsigned thr = 1u; int need = 0;
                    if (n > 256) {
                        unsigned prefix = 0u;
#pragma unroll 1
                        for (int bit = 31; bit >= 0; --bit) {
                            const unsigned cand = prefix | (1u << bit);
                            int cnt = 0;
#pragma unroll
                            for (int i = 0; i < 64; ++i) cnt += __popcll(__ballot(uk[i] >= cand));
                            if (cnt >= 256) prefix = cand;
                        }
                        thr = prefix;
                        int cg_ = 0;
#pragma unroll
                        for (int i = 0; i < 64; ++i) cg_ += __popcll(__ballot(uk[i] > thr));
                        need = 256 - cg_;
                    }
                    int running = 0;
                    unsigned long long* mrow = MASK + (size_t)(row0 + wave) * 64;
                    unsigned long long mine = 0ull;
#pragma unroll
                    for (int i = 0; i < 64; ++i) {
                        const bool gt = (n > 256) ? (uk[i] > thr) : (uk[i] != 0u);
                        const bool eq = (n > 256) && (uk[i] == thr);
                        const unsigned long long beq = __ballot(eq);
                        const int rank = running + __popcll(beq & ((1ull << lane) - 1ull));
                        const bool take = gt || (eq && rank < need);
                        running += __popcll(beq);
                        const unsigned long long mm = __ballot(take);
                        if (lane == i) mine = mm;
                    }
                    mrow[lane] = mine;
                }
                __syncthreads();
            }
        } break;
        case 7: {
            constexpr int NSCAN = 32;
            if (bid < NSCAN) {
                const int pair = wave >> 2, sub = wave & 3, bh = 2 * bid + pair, b = bh >> 3, h = bh & 7;
                float* Lk = (float*)lds + pair * (3 * 4096 + 128);
                float* Lq = Lk + 4096; float* Lv = Lq + 4096; float* Lg = Lv + 4096; float* Lb = Lg + 64;
                const int jl = lane & 15, r = lane >> 4, j = 16 * sub + jl;
                const int t4 = sub * 64 + lane;
                float Sr[16];
#pragma unroll
                for (int i = 0; i < 16; ++i) Sr[i] = 0.f;
                for (int c = 0; c < 64; ++c) {
                    const size_t rbase = (size_t)b * SEQ + c * 64;
                    __syncthreads();
#pragma unroll
                    for (int e = 0; e < 2; ++e) {
                        const int idx = (t4 * 2 + e) * 8;
                        const int tr = idx >> 6, dc = idx & 63;
                        const h16* src = QKVA + (rbase + tr) * 1536 + h * 64 + dc;
                        float f[8];
                        unpack8(*(const u32x4*)(src + 512), f);
#pragma unroll
                        for (int i = 0; i < 8; ++i) Lk[idx + i] = f[i];
                        unpack8(*(const u32x4*)(src), f);
#pragma unroll
                        for (int i = 0; i < 8; ++i) Lq[idx + i] = f[i];
                        unpack8(*(const u32x4*)(src + 1024), f);
#pragma unroll
                        for (int i = 0; i < 8; ++i) Lv[idx + i] = f[i];
                    }
                    if (t4 < 64) { Lg[t4] = __expf(MISC[(rbase + t4) * 96 + 64 + h]); Lb[t4] = MISC[(rbase + t4) * 96 + 72 + h]; }
                    __syncthreads();
                    for (int s = 0; s < 64; ++s) {
                        const float a = Lg[s], be = Lb[s];
                        const float* kp = Lk + s * 64 + 16 * r; const float* qp = Lq + s * 64 + 16 * r;
                        float kk[16], qq[16];
#pragma unroll
                        for (int i = 0; i < 4; ++i) { const f32x4 kv = *(const f32x4*)(kp + 4 * i), qv = *(const f32x4*)(qp + 4 * i);
                            kk[4 * i] = kv[0]; kk[4 * i + 1] = kv[1]; kk[4 * i + 2] = kv[2]; kk[4 * i + 3] = kv[3]; qq[4 * i] = qv[0]; qq[4 * i + 1] = qv[1]; qq[4 * i + 2] = qv[2]; qq[4 * i + 3] = qv[3]; }
                        float p0 = 0.f, p1 = 0.f;
#pragma unroll
                        for (int i = 0; i < 16; i += 2) { p0 += kk[i] * Sr[i]; p1 += kk[i + 1] * Sr[i + 1]; }
                        float kS = p0 + p1; kS += __shfl_xor(kS, 16); kS += __shfl_xor(kS, 32);
                        const float cj = be * (Lv[s * 64 + j] - a * kS);
                        float o0 = 0.f, o1 = 0.f;
#pragma unroll
                        for (int i = 0; i < 16; i += 2) { Sr[i] = a * Sr[i] + kk[i] * cj; Sr[i + 1] = a * Sr[i + 1] + kk[i + 1] * cj; o0 += qq[i] * Sr[i]; o1 += qq[i + 1] * Sr[i + 1]; }
                        float o = o0 + o1; o += __shfl_xor(o, 16); o += __shfl_xor(o, 32);
                        if (r == 0) QKVA[(rbase + s) * 1536 + 1024 + h * 64 + j] = (h16)o;
                    }
                }
            } else {
                typedef float f32x16 __attribute__((ext_vector_type(16)));
                unsigned char* kbuf = lds;
                unsigned char* vbuf = lds + 16384;
                const unsigned* MASK32 = (const unsigned*)MASK;
                const h16* VT = (const h16*)(ws + WS_XN);
                const int r32 = lane & 31, hi = lane >> 5;
                const int nblk = G - NSCAN;
                const int srow = tid >> 3, sch = tid & 7;
                const int kws = srow * 128 + ((sch ^ (srow & 7)) * 16), vws = srow * 136 + sch * 16;
                for (int p = bid - NSCAN; p < 512; p += nblk) {
#pragma unroll 1
                    for (int half = 0; half < 2; ++half) {
                        const int bh = p >> 3, qb = half ? 15 - (p & 7) : (p & 7), b = bh >> 3, h = bh & 7, q0 = qb * 256;
                        const int qrow = b * SEQ + q0 + 32 * wave + r32;
                        h16x8 qf[4];
                        { const h16* qp = QKVB + (size_t)qrow * 1536 + h * 64 + 8 * hi;
#pragma unroll
                          for (int ks = 0; ks < 4; ++ks) { const h16x8 t8 = *(const h16x8*)(qp + 16 * ks);
#pragma unroll
                              for (int i = 0; i < 8; ++i) qf[ks][i] = (h16)((float)t8[i] * 1.4426950408889634f); } }
                        f32x16 o[2];
#pragma unroll
                        for (int i = 0; i < 16; ++i) { o[0][i] = 0.f; o[1][i] = 0.f; }
                        float m = -1e30f, l = 0.f;
                        const int nkt = 4 * qb + 4;
                        const h16* kg = QKVB + ((size_t)b * SEQ + srow) * 1536 + 512 + h * 64 + 8 * sch;
                        const h16* vg = VT + ((size_t)bh * 64 + srow) * SEQ + 8 * sch;
                        u32x4 kreg = *(const u32x4*)kg, vreg = *(const u32x4*)vg;
                        __syncthreads();
                        *(u32x4*)(kbuf + kws) = kreg; *(u32x2*)(vbuf + vws) = (u32x2){vreg[0], vreg[1]}; *(u32x2*)(vbuf + vws + 8) = (u32x2){vreg[2], vreg[3]};
                        __syncthreads();
                        const int wq_last = q0 + 32 * wave + 31;
                        for (int kt = 0; kt < nkt; ++kt) {
                            const int cur = kt & 1;
                            if (kt + 1 < nkt) { kreg = *(const u32x4*)(kg + (size_t)(kt + 1) * 64 * 1536); vreg = *(const u32x4*)(vg + (kt + 1) * 64); }
                            if (64 * kt <= wq_last) {
                                const unsigned* mp = MASK32 + (size_t)qrow * 128 + 2 * kt;
                                unsigned mw[2] = {mp[0] >> (4 * hi), mp[1] >> (4 * hi)};
                                f32x16 S[2];
#pragma unroll
                                for (int i = 0; i < 16; ++i) { S[0][i] = 0.f; S[1][i] = 0.f; }
                                const unsigned char* kb_ = kbuf + cur * 8192 + r32 * 128;
#pragma unroll
                                for (int ks = 0; ks < 4; ++ks) {
                                    const int off = ((2 * ks + hi) ^ (r32 & 7)) * 16;
                                    const h16x8 a0 = *(const h16x8*)(kb_ + off), a1 = *(const h16x8*)(kb_ + 4096 + off);
                                    S[0] = __builtin_amdgcn_mfma_f32_32x32x16_f16(a0, qf[ks], S[0], 0, 0, 0);
                                    S[1] = __builtin_amdgcn_mfma_f32_32x32x16_f16(a1, qf[ks], S[1], 0, 0, 0);
                                }
                                float mx = S[0][0];
#pragma unroll
                                for (int i = 0; i < 16; ++i) { mx = fmaxf(mx, S[0][i]); mx = fmaxf(mx, S[1][i]); }
                                mx = fmaxf(mx, __shfl_xor(mx, 32));
                                const float mn = fmaxf(m, mx), alpha = __builtin_amdgcn_exp2f(m - mn);
                                m = mn;
                                float ps = 0.f;
#pragma unroll
                                for (int rt = 0; rt < 2; ++rt)
#pragma unroll
                                    for (int i = 0; i < 16; ++i) {
                                        const float e = __builtin_amdgcn_exp2f(S[rt][i] - mn);
                                        const int bm = __builtin_amdgcn_sbfe((int)mw[rt], (i & 3) + 8 * (i >> 2), 1);
                                        const float pe = __uint_as_float(__float_as_uint(e) & (unsigned)bm);
                                        ps += pe; S[rt][i] = pe;
                                    }
                                l = l * alpha + ps;
#pragma unroll
                                for (int i = 0; i < 16; ++i) { o[0][i] *= alpha; o[1][i] *= alpha; }
                                const unsigned char* vb_ = vbuf + cur * 8704 + r32 * 136 + 8 * hi;
#pragma unroll
                                for (int rt = 0; rt < 2; ++rt)
#pragma unroll
                                    for (int s2 = 0; s2 < 2; ++s2) {
                                        h16x8 pb;
#pragma unroll
                                        for (int j = 0; j < 8; ++j) pb[j] = (h16)S[rt][8 * s2 + j];
#pragma unroll
                                        for (int dt = 0; dt < 2; ++dt) {
                                            const unsigned char* vp = vb_ + dt * (32 * 136) + (32 * rt + 16 * s2) * 2;
                                            const h16x4 lo = *(const h16x4*)vp, hi4 = *(const h16x4*)(vp + 16);
                                            const h16x8 va = {lo[0], lo[1], lo[2], lo[3], hi4[0], hi4[1], hi4[2], hi4[3]};
                                            o[dt] = __builtin_amdgcn_mfma_f32_32x32x16_f16(va, pb, o[dt], 0, 0, 0);
                                        }
                                    }
                            }
                            if (kt + 1 < nkt) { unsigned char* kd = kbuf + (cur ^ 1) * 8192 + kws; unsigned char* vd = vbuf + (cur ^ 1) * 8704 + vws;
                                *(u32x4*)kd = kreg; *(u32x2*)vd = (u32x2){vreg[0], vreg[1]}; *(u32x2*)(vd + 8) = (u32x2){vreg[2], vreg[3]}; }
                            __syncthreads();
                        }
                        l += __shfl_xor(l, 32);
                        const float inv = 1.0f / l;
                        h16* op = QKVB + (size_t)qrow * 1536 + h * 64 + 4 * hi;
#pragma unroll
                        for (int dt = 0; dt < 2; ++dt)
#pragma unroll
                            for (int g4 = 0; g4 < 4; ++g4) {
                                const f32x4 v4 = {o[dt][4 * g4] * inv, o[dt][4 * g4 + 1] * inv, o[dt][4 * g4 + 2] * inv, o[dt][4 * g4 + 3] * inv};
                                *(u32x2*)(op + 32 * dt + 8 * g4) = pack4(v4);
                            }
                    }
                }
            }
        } break;
        case 8: {
            const float* dg = args.in[I_DNG];
            float gg[8];
#pragma unroll
            for (int i = 0; i < 8; ++i) gg[i] = dg[(lane & 7) * 8 + i];
            for (int row = gw; row < T; row += ngw) {
                h16* op = QKVA + (size_t)row * 1536 + 1024 + lane * 8;
                float o[8], z[8]; unpack8(*(const u32x4*)op, o); unpack8(*(const u32x4*)(ZS + (size_t)row * 512 + lane * 8), z);
                float ss = 0.f;
#pragma unroll
                for (int i = 0; i < 8; ++i) ss += o[i] * o[i];
                ss += __shfl_xor(ss, 1); ss += __shfl_xor(ss, 2); ss += __shfl_xor(ss, 4);
                const float r = rsqrtf(ss * (1.0f / 64.0f) + EPS);
                f32x4 a0, a1;
#pragma unroll
                for (int i = 0; i < 4; ++i) { a0[i] = o[i] * r * gg[i] * z[i]; a1[i] = o[4 + i] * r * gg[4 + i] * z[4 + i]; }
                *(u32x4*)op = pack8(a0, a1);
            }
        } break;
        case 9:  g = pg8::Gemm{QKVA + 1024, WBA, T, D, 512, 1536}; E.mode = pg8::EPI_BRA; E.o16 = XN; E.ldo = D; E.g16 = GATES; break;
        case 10: g = pg8::Gemm{QKVB, WBB, T, D, 512, 1536}; E.mode = pg8::EPI_BRB; E.o16 = XN; E.ldo = D; E.g16 = GATES; break;
        case 11: g = pg8::Gemm{XN, WO, T, D, D, D}; E.mode = pg8::EPI_F32; E.o32 = Y; E.ldo = D; break;
        case 12: resid_norm_phase<false, false>(nullptr, H16, Y, 1.0f, args.in[I_MPOST], args.in[I_F2PRE], XN, nullptr, gw, ngw, lane); break;
        case 13: g = pg8::Gemm{XN, W3, T, 2 * FF, D, D}; E.mode = pg8::EPI_SWIGLU; E.o16 = HID; E.ldo = FF; break;
        case 14: g = pg8::Gemm{HID, W4, T, D, FF, FF}; E.mode = pg8::EPI_F32; E.o32 = Y; E.ldo = D; break;
        case 15: resid_norm_phase<false, false>(nullptr, H16, Y, 0.5f, args.in[I_F2POST], args.in[I_PPRE], XN, nullptr, gw, ngw, lane); break;
        case 16: g = pg8::Gemm{XN, WG, T, D, D, D}; E.mode = pg8::EPI_PLEG; E.o16 = TMP; E.ldo = D; break;
        case 17: g = pg8::Gemm{P16, WP, T, D, PLE, PLE}; E.mode = pg8::EPI_PLEP; E.o32 = Y; E.ldo = D; E.g16 = TMP; break;
        case 18: resid_norm_phase<false, true>(nullptr, H16, Y, 1.0f, args.in[I_PPOST], nullptr, nullptr, outp_, gw, ngw, lane); break;
        default: break;
        }
        if (E.mode >= 0) { pg8::StaticOrder S; S.init(T, g.N, G, bid); pg8::gemm_phase((LAS unsigned char*)lds, g, S, E, tid); }
#ifdef DUP_PHASE
        if (ph == DUP_PHASE && !dup_done) { dup_done = true; --ph; }
#endif
        if (ph + 1 < args.ph_hi) grid.sync();
    }
}

constexpr int NPHASES = 19;

extern "C" void kernel_launch(void* const* d_in, const int* in_sizes, int n_in, void* d_out, int out_size, void* d_ws, size_t ws_size, hipStream_t stream) {
    static int grid = 0;
    if (grid == 0) {
        if (n_in != 25 || in_sizes[0] != T * D || out_size != T * D || ws_size < WS_END || ws_size < WS_HID + (size_t)T * FF * 2) {
            fprintf(stderr, "kernel_launch: unexpected shapes / workspace (n_in %d, in0 %d, out %d, ws %zu); nothing launched\n", n_in, n_in > 0 ? in_sizes[0] : -1, out_size, ws_size); grid = -1; return; }
        int dev = 0, cus = 0, per_cu = 0;
        hipGetDevice(&dev);
        hipDeviceGetAttribute(&cus, hipDeviceAttributeMultiprocessorCount, dev);
        hipFuncSetAttribute((const void*)fwd_kernel, hipFuncAttributeMaxDynamicSharedMemorySize, LDS_BYTES);
        hipOccupancyMaxActiveBlocksPerMultiprocessor(&per_cu, (const void*)fwd_kernel, NTHREADS, LDS_BYTES);
        if (per_cu < 1) { fprintf(stderr, "kernel_launch: occupancy query says %d blocks per CU\n", per_cu); per_cu = 1; }
        if (per_cu > 1) per_cu = 1;
        grid = cus * per_cu;
        (void)hipGetLastError();
    }
    if (grid < 0) return;
    Args a{};
    for (int i = 0; i < 25; ++i) a.in[i] = (const float*)d_in[i];
    a.out = (float*)d_out; a.ws = (unsigned char*)d_ws;
#if MK_PER_PHASE
    for (int ph = 0; ph < NPHASES; ++ph) {
        a.ph_lo = ph; a.ph_hi = ph + 1;
        void* kargs[] = {&a};
        hipError_t e = hipLaunchCooperativeKernel((const void*)fwd_kernel, dim3(grid), dim3(NTHREADS), kargs, LDS_BYTES, stream);
        if (e != hipSuccess) { fprintf(stderr, "launch failed: %s\n", hipGetErrorString(e)); break; }
    }
#else
    a.ph_lo = 0; a.ph_hi = NPHASES;
    void* kargs[] = {&a};
    hipError_t e = hipLaunchCooperativeKernel((const void*)fwd_kernel, dim3(grid), dim3(NTHREADS), kargs, LDS_BYTES, stream);
    if (e != hipSuccess) fprintf(stderr, "cooperative launch failed: %s (grid %d)\n", hipGetErrorString(e), grid);
#endif
}
```

```cpp
#include <hip/hip_runtime.h>
#include <hip/hip_cooperative_groups.h>
#include <cstdio>
#include <cstdint>
namespace cg = cooperative_groups;

#ifndef MK_PER_PHASE
#define MK_PER_PHASE 0
#endif

constexpr int T = 32768, D = 1024, FF = 2816, SEQ = 4096, NBATCH = 8, PLE = 256;
constexpr int NMIX = 6400;
constexpr float EPS = 1e-6f;
constexpr int NWAVES = 8, NTHREADS = 512;
constexpr int LDS_BYTES = 155648;

typedef _Float16 h16;
typedef _Float16 h16x8 __attribute__((ext_vector_type(8)));
typedef _Float16 h16x4 __attribute__((ext_vector_type(4)));
typedef short s16x8 __attribute__((ext_vector_type(8)));
typedef float f32x4 __attribute__((ext_vector_type(4)));
typedef unsigned u32x4 __attribute__((ext_vector_type(4)));
typedef unsigned u32x2 __attribute__((ext_vector_type(2)));
#define LAS __attribute__((address_space(3)))

constexpr size_t MiB = 1u << 20;
constexpr size_t WS_ROPE = 1 * MiB;
constexpr size_t WS_W1 = 2 * MiB;
constexpr size_t WS_W2 = WS_W1 + 11 * MiB;
constexpr size_t WS_WM = WS_W2 + 11 * MiB / 2;
constexpr size_t WS_WBA = WS_WM + 25 * MiB / 2;
constexpr size_t WS_WBB = WS_WBA + 1 * MiB;
constexpr size_t WS_WO = WS_WBB + 1 * MiB;
constexpr size_t WS_W3 = WS_WO + 2 * MiB;
constexpr size_t WS_W4 = WS_W3 + 11 * MiB;
constexpr size_t WS_WG = WS_W4 + 11 * MiB / 2;
constexpr size_t WS_WP = WS_WG + 2 * MiB;
constexpr size_t WS_P16 = 54 * MiB;
constexpr size_t WS_XN = 70 * MiB;
constexpr size_t WS_H16 = 134 * MiB;
constexpr size_t WS_ARENA = 198 * MiB;
constexpr size_t WS_HID = WS_ARENA;
constexpr size_t WS_TMP = WS_ARENA;
constexpr size_t WS_QKVA = WS_ARENA;
constexpr size_t WS_ZS = WS_QKVA + 96 * MiB;
constexpr size_t WS_QKVB = WS_ZS + 32 * MiB;
constexpr size_t WS_QI = WS_QKVB + 96 * MiB;
constexpr size_t WS_MISC = WS_QI + 32 * MiB;
constexpr size_t WS_MASK = WS_MISC + 12 * MiB;
constexpr size_t WS_HALO = WS_MASK + 16 * MiB;
constexpr size_t WS_KI = WS_HALO + 5 * MiB;
constexpr size_t WS_END = WS_KI + 4 * MiB;
static_assert(WS_WP + MiB / 2 <= WS_P16 && WS_END <= 512 * MiB && WS_HID + (size_t)T * FF * 2 <= 512 * MiB, "ws map");

__device__ __forceinline__ float sigmoidf_(float x) { return 1.0f / (1.0f + __expf(-x)); }
__device__ __forceinline__ float siluf_(float x) { return x / (1.0f + __expf(-x)); }
__device__ __forceinline__ u32x4 pack8(f32x4 a, f32x4 b) {
    h16x8 h = {(h16)a[0], (h16)a[1], (h16)a[2], (h16)a[3], (h16)b[0], (h16)b[1], (h16)b[2], (h16)b[3]};
    return __builtin_bit_cast(u32x4, h);
}
__device__ __forceinline__ u32x2 pack4(f32x4 a) {
    h16x4 h = {(h16)a[0], (h16)a[1], (h16)a[2], (h16)a[3]};
    return __builtin_bit_cast(u32x2, h);
}
__device__ __forceinline__ void unpack8(u32x4 w, float (&f)[8]) {
    h16x8 h = __builtin_bit_cast(h16x8, w);
#pragma unroll
    for (int i = 0; i < 8; ++i) f[i] = (float)h[i];
}
__device__ __forceinline__ float wave_sum(float v) {
#pragma unroll
    for (int o = 1; o < 64; o <<= 1) v += __shfl_xor(v, o);
    return v;
}
__device__ __forceinline__ int wave_sum_i(int v) {
#pragma unroll
    for (int o = 1; o < 64; o <<= 1) v += __shfl_xor(v, o);
    return v;
}
#define LDS_WAIT() asm volatile("s_waitcnt lgkmcnt(0)" ::: "memory")

namespace pg8 {
constexpr int BM = 256, BK = 64, HALF = 128, HTB = HALF * BK * 2, STAGE_BYTES = 8 * HTB, NXCD = 8, WGM = 8;
__host__ __device__ __forceinline__ int lds_byte(int r, int c) { const int st = (r >> 4) * 2 + (c >> 5), rr = r & 15, cc = c & 31, ob = rr * 64 + cc * 2; return st * 1024 + (ob ^ (((ob >> 9) & 1) << 5)); }
__host__ __device__ __forceinline__ void stage_rc(int b, int& R, int& C) { const int st = b / 1024, sb = b % 1024, swz = sb ^ (((sb >> 9) & 1) << 5); R = (st >> 1) * 16 + swz / 64; C = (st & 1) * 32 + (swz % 64) / 2; }
__host__ __device__ __forceinline__ int perm32(int rho) { const int n = rho >> 4, i = rho & 15; return 8 * (i >> 2) + 4 * n + (i & 3); }
struct Unit { int pm, pn; };
struct Gemm { const h16* A; const h16* Bt; int M, N, K, lda; };
struct StaticOrder {
    int nM, nN, nwg, G, c;
    __device__ void init(int M, int N, int G_, int c_) { nM = M / BM; nN = N / BM; nwg = nM * nN; G = G_; c = c_; }
    __device__ bool next(int i, Unit& u) const {
        const long L = (long)i * G + c; if (L >= nwg) return false;
        int wgid = (int)L; { const int q = nwg / NXCD, r = nwg % NXCD, xcd = wgid % NXCD, off = wgid / NXCD; wgid = (xcd < r ? xcd * (q + 1) : r * (q + 1) + (xcd - r) * q) + off; }
        const int nig = WGM * nN, gid = wgid / nig, fm = gid * WGM, gsz = (nM - fm) < WGM ? (nM - fm) : WGM;
        u.pm = fm + ((wgid % nig) % gsz); u.pn = (wgid % nig) / gsz; return true;
    }
};

enum { EPI_SWIGLU = 0, EPI_F32 = 1, EPI_MIX = 2, EPI_BRA = 3, EPI_BRB = 4, EPI_PLEG = 5, EPI_PLEP = 6 };
struct Epi {
    int mode;
    h16* o16; float* o32; int ldo;
    const h16* g16;
    h16 *qkva, *zs, *qkvb, *qi, *gates, *halo; float* misc; const float *rope, *a_log, *dt_bias;
    __device__ __forceinline__ void operator()(const f32x4 (&acc)[2][2][4][2], const Unit& u, int wr, int wc, int fr, int fq) const {
        const int cb = wc * 32 + 8 * fq;
        const int row0 = u.pm * BM + wr * 64 + fr;
        if (mode == EPI_SWIGLU) {
#pragma unroll
            for (int ai = 0; ai < 2; ++ai)
#pragma unroll
                for (int m = 0; m < 4; ++m) {
                    const int row = row0 + ai * HALF + m * 16;
                    f32x4 r0, r1;
#pragma unroll
                    for (int i = 0; i < 4; ++i) { r0[i] = siluf_(acc[ai][0][m][0][i]) * acc[ai][1][m][0][i]; r1[i] = siluf_(acc[ai][0][m][1][i]) * acc[ai][1][m][1][i]; }
                    *(u32x4*)(o16 + (size_t)row * ldo + u.pn * 128 + cb) = pack8(r0, r1);
                }
        } else if (mode == EPI_F32) {
#pragma unroll
            for (int ai = 0; ai < 2; ++ai)
#pragma unroll
                for (int m = 0; m < 4; ++m) {
                    const int row = row0 + ai * HALF + m * 16;
#pragma unroll
                    for (int bj = 0; bj < 2; ++bj) { float* p = o32 + (size_t)row * ldo + u.pn * BM + bj * HALF + cb; *(f32x4*)p = acc[ai][bj][m][0]; *(f32x4*)(p + 4) = acc[ai][bj][m][1]; }
                }
        } else if (mode == EPI_BRA || mode == EPI_BRB || mode == EPI_PLEP) {
#pragma unroll
            for (int ai = 0; ai < 2; ++ai)
#pragma unroll
                for (int m = 0; m < 4; ++m) {
                    const int row = row0 + ai * HALF + m * 16;
#pragma unroll
                    for (int bj = 0; bj < 2; ++bj) {
                        const int col = u.pn * BM + bj * HALF + cb;
                        float g[8]; unpack8(*(const u32x4*)(g16 + (size_t)row * (mode == EPI_PLEP ? 1024 : 2048) + (mode == EPI_BRB ? 1024 : 0) + col), g);
                        f32x4 r0, r1;
#pragma unroll
                        for (int i = 0; i < 4; ++i) { r0[i] = g[i] * acc[ai][bj][m][0][i]; r1[i] = g[4 + i] * acc[ai][bj][m][1][i]; }
                        if (mode == EPI_PLEP) { float* p = o32 + (size_t)row * ldo + col; *(f32x4*)p = r0; *(f32x4*)(p + 4) = r1; }
                        else {
                            h16* p = o16 + (size_t)row * ldo + col;
                            if (mode == EPI_BRB) { float o[8]; unpack8(*(const u32x4*)p, o);
#pragma unroll
                                for (int i = 0; i < 4; ++i) { r0[i] += o[i]; r1[i] += o[4 + i]; } }
                            *(u32x4*)p = pack8(r0, r1);
                        }
                    }
                }
        } else if (mode == EPI_PLEG) {
#pragma unroll
            for (int ai = 0; ai < 2; ++ai)
#pragma unroll
                for (int m = 0; m < 4; ++m) {
                    const int row = row0 + ai * HALF + m * 16;
#pragma unroll
                    for (int bj = 0; bj < 2; ++bj) {
                        f32x4 r0, r1;
#pragma unroll
                        for (int i = 0; i < 4; ++i) { r0[i] = sigmoidf_(acc[ai][bj][m][0][i]); r1[i] = sigmoidf_(acc[ai][bj][m][1][i]); }
                        *(u32x4*)(o16 + (size_t)row * ldo + u.pn * BM + bj * HALF + cb) = pack8(r0, r1);
                    }
                }
        } else {
            const int pn = u.pn;
#pragma unroll
            for (int ai = 0; ai < 2; ++ai)
#pragma unroll
                for (int m = 0; m < 4; ++m) {
                    const int row = row0 + ai * HALF + m * 16;
#pragma unroll
                    for (int bj = 0; bj < 2; ++bj) {
                        const int tc = bj * HALF + cb;
                        f32x4 v0 = acc[ai][bj][m][0], v1 = acc[ai][bj][m][1];
                        if (pn < 6) {
                            const u32x4 w = pack8(v0, v1);
                            *(u32x4*)(qkva + (size_t)row * 1536 + pn * 256 + tc) = w;
                            if ((row & 63) >= 61) *(u32x4*)(halo + ((size_t)(row >> 6) * 3 + ((row & 63) - 61)) * 1536 + pn * 256 + tc) = w;
                        } else if (pn < 8) {
#pragma unroll
                            for (int i = 0; i < 4; ++i) { v0[i] = siluf_(v0[i]); v1[i] = siluf_(v1[i]); }
                            *(u32x4*)(zs + (size_t)row * 512 + (pn - 6) * 256 + tc) = pack8(v0, v1);
                        } else if (pn < 16) {
                            const bool rope_tile = (pn < 12) || (pn >= 14);
                            if (rope_tile && !(wc & 1)) {
                                f32x4 p0, p1;
#pragma unroll
                                for (int i = 0; i < 4; ++i) { p0[i] = __shfl_xor(v0[i], 16); p1[i] = __shfl_xor(v1[i], 16); }
                                if (fq < 2) {
                                    const float* rp = rope + (size_t)(row & (SEQ - 1)) * 16;
                                    const f32x4 c0 = *(const f32x4*)rp, c1 = *(const f32x4*)(rp + 4), s0 = *(const f32x4*)(rp + 8), s1 = *(const f32x4*)(rp + 12);
                                    const float sg = fq == 0 ? -1.f : 1.f;
#pragma unroll
                                    for (int i = 0; i < 4; ++i) { v0[i] = v0[i] * c0[i] + sg * p0[i] * s0[i]; v1[i] = v1[i] * c1[i] + sg * p1[i] * s1[i]; }
                                }
                            }
                            if (pn < 10) { v0 = v0 * 0.125f; v1 = v1 * 0.125f; }
                            h16* dst = pn < 14 ? qkvb + (size_t)row * 1536 + (pn - 8) * 256 + tc : qi + (size_t)row * 512 + (pn - 14) * 256 + tc;
                            *(u32x4*)dst = pack8(v0, v1);
                        } else if (pn < 24) {
#pragma unroll
                            for (int i = 0; i < 4; ++i) { v0[i] = sigmoidf_(v0[i]); v1[i] = sigmoidf_(v1[i]); }
                            *(u32x4*)(gates + (size_t)row * 2048 + (pn - 16) * 256 + tc) = pack8(v0, v1);
                        } else if (bj == 0) {
                            float* mp = misc + (size_t)row * 96;
                            if (wc < 2) { *(f32x4*)(mp + tc) = v0; *(f32x4*)(mp + tc + 4) = v1; }
                            else if (wc == 2 && fq < 3) {
                                float r[8] = {v0[0], v0[1], v0[2], v0[3], v1[0], v1[1], v1[2], v1[3]};
                                if (fq == 0) {
#pragma unroll
                                    for (int i = 0; i < 8; ++i) { const float xx = r[i] + dt_bias[i]; const float sp = xx > 20.f ? xx : log1pf(expf(xx)); r[i] = -expf(a_log[i]) * sp; }
                                } else if (fq == 1) {
#pragma unroll
                                    for (int i = 0; i < 8; ++i) r[i] = 1.0f / (1.0f + expf(-r[i]));
                                } else {
#pragma unroll
                                    for (int i = 0; i < 8; ++i) r[i] *= 0.04419417382415922f;
                                }
                                *(f32x4*)(mp + 64 + 8 * fq) = (f32x4){r[0], r[1], r[2], r[3]}; *(f32x4*)(mp + 68 + 8 * fq) = (f32x4){r[4], r[5], r[6], r[7]};
                            }
                        }
                    }
                }
        }
    }
};

__device__ __forceinline__ void gemm_phase(LAS unsigned char* lds, const Gemm g, const StaticOrder& S, const Epi& E, const int tid) {
    const int wid = __builtin_amdgcn_readfirstlane(tid >> 6), lane = tid & 63, wr = wid >> 2, wc = wid & 3, fr = lane & 15, fq = lane >> 4;
    const int K = g.K, nt = K / BK, lda = g.lda;
    unsigned voffA[2], voffB[2];
#pragma unroll
    for (int i = 0; i < 2; ++i) { int R, C; stage_rc(tid * 16 + i * 8192, R, C); const int Rb = (R & ~31) + perm32(R & 31);
        voffA[i] = (unsigned)(R * lda + C) * 2u; voffB[i] = (unsigned)(Rb * K + C) * 2u; }
    const size_t kstep = (size_t)(BK * 2);
    const size_t hstepA = (size_t)HALF * lda * 2, hstepB = (size_t)HALF * K * 2;
    const size_t tstepA = 2 * hstepA, tstepB = 2 * hstepB;
    const unsigned ldsw = (unsigned)wid * 1024u;
    const int aoff = lds_byte(wr * 64 + fr, fq * 8), boff = lds_byte(wc * 32 + fr, fq * 8);
#define PG8_SA(b, h) (((b) * 2 + (h)) * HTB)
#define PG8_SB(b, h) ((4 + (b) * 2 + (h)) * HTB)
#define PG8_STAGE(bufoff, gbase, voff) do { _Pragma("unroll") for (int _i = 0; _i < 2; ++_i) \
        __builtin_amdgcn_global_load_lds((const unsigned*)((const char*)(gbase) + (voff)[_i]), (LAS unsigned*)(lds + (bufoff) + ldsw + _i * 8192), 16, 0, 0); } while (0)
#define PG8_LDA(dst, b, h) do { _Pragma("unroll") for (int m = 0; m < 4; ++m) _Pragma("unroll") for (int k = 0; k < 2; ++k) dst[m][k] = *(const LAS s16x8*)(lds + PG8_SA(b, h) + aoff + m * 2048 + k * 1024); } while (0)
#define PG8_LDB(dst, b, h) do { _Pragma("unroll") for (int n = 0; n < 2; ++n) _Pragma("unroll") for (int k = 0; k < 2; ++k) dst[n][k] = *(const LAS s16x8*)(lds + PG8_SB(b, h) + boff + n * 2048 + k * 1024); } while (0)
#define PG8_MMA(ai, bj, At, Bt) do { __builtin_amdgcn_s_setprio(1); _Pragma("unroll") for (int m = 0; m < 4; ++m) _Pragma("unroll") for (int n = 0; n < 2; ++n) _Pragma("unroll") for (int k = 0; k < 2; ++k) \
        acc[ai][bj][m][n] = __builtin_amdgcn_mfma_f32_16x16x32_f16(__builtin_bit_cast(h16x8, Bt[n][k]), __builtin_bit_cast(h16x8, At[m][k]), acc[ai][bj][m][n], 0, 0, 0); __builtin_amdgcn_s_setprio(0); } while (0)
#define PG8_WAIT_V(n) asm volatile("s_waitcnt vmcnt(" #n ")" ::: "memory")
#define PG8_WAIT_L(n) asm volatile("s_waitcnt lgkmcnt(" #n ")" ::: "memory")
#define PG8_BAR __builtin_amdgcn_s_barrier()
#define PG8_SCHED __builtin_amdgcn_sched_barrier(0)
    Unit cur, nxt; int ui = 0;
    if (!S.next(0, cur)) return;
    f32x4 acc[2][2][4][2];
#pragma unroll
    for (int a = 0; a < 2; ++a)
#pragma unroll
        for (int b = 0; b < 2; ++b)
#pragma unroll
            for (int m = 0; m < 4; ++m)
#pragma unroll
                for (int n = 0; n < 2; ++n) acc[a][b][m][n] = (f32x4){0.f, 0.f, 0.f, 0.f};
    s16x8 At[4][2], B0[2][2], B1[2][2];
    const char* cA = (const char*)g.A + (size_t)cur.pm * tstepA; const char* cB = (const char*)g.Bt + (size_t)cur.pn * tstepB;
    PG8_STAGE(PG8_SB(0, 0), cB, voffB); PG8_STAGE(PG8_SB(0, 1), cB + hstepB, voffB); PG8_STAGE(PG8_SA(0, 0), cA, voffA); PG8_STAGE(PG8_SA(0, 1), cA + hstepA, voffA);
    if (wr == 1) PG8_BAR;
    PG8_WAIT_V(2); PG8_BAR;
    PG8_STAGE(PG8_SB(1, 0), cB + kstep, voffB); PG8_STAGE(PG8_SA(1, 0), cA + kstep, voffA); PG8_STAGE(PG8_SB(1, 1), cB + hstepB + kstep, voffB);
    PG8_WAIT_V(6); PG8_BAR;
    for (;;) {
        const bool has_next = S.next(ui + 1, nxt);
        const char* nA = has_next ? (const char*)g.A + (size_t)nxt.pm * tstepA : cA; const char* nB = has_next ? (const char*)g.Bt + (size_t)nxt.pn * tstepB : cB;
        for (int t = 0; t < nt; t += 2) {
            const bool last = (t == nt - 2);
            const char* a1 = cA + (size_t)(t + 1) * kstep;
            const char* a2 = last ? nA : cA + (size_t)(t + 2) * kstep; const char* b2 = last ? nB : cB + (size_t)(t + 2) * kstep;
            const char* a3 = a2 + kstep; const char* b3 = b2 + kstep;
            PG8_LDB(B0, 0, 0); PG8_LDB(B1, 0, 1); PG8_SCHED; PG8_LDA(At, 0, 0); PG8_STAGE(PG8_SA(1, 1), a1 + hstepA, voffA);
            PG8_WAIT_V(8); PG8_WAIT_L(0); PG8_BAR; PG8_MMA(0, 0, At, B0); PG8_MMA(0, 1, At, B1); PG8_BAR; PG8_SCHED;
            PG8_LDA(At, 0, 1); PG8_STAGE(PG8_SB(0, 0), b2, voffB); PG8_STAGE(PG8_SB(0, 1), b2 + hstepB, voffB); PG8_STAGE(PG8_SA(0, 0), a2, voffA);
            PG8_WAIT_V(8); PG8_WAIT_L(0); PG8_BAR; PG8_MMA(1, 0, At, B0); PG8_MMA(1, 1, At, B1); PG8_BAR; PG8_SCHED;
            PG8_LDB(B0, 1, 0); PG8_LDB(B1, 1, 1); PG8_SCHED; PG8_LDA(At, 1, 0); PG8_STAGE(PG8_SA(0, 1), a2 + hstepA, voffA);
            PG8_WAIT_V(8); PG8_WAIT_L(0); PG8_BAR; PG8_MMA(0, 0, At, B0); PG8_MMA(0, 1, At, B1); PG8_BAR; PG8_SCHED;
            PG8_LDA(At, 1, 1); PG8_STAGE(PG8_SB(1, 0), b3, voffB); PG8_STAGE(PG8_SB(1, 1), b3 + hstepB, voffB); PG8_STAGE(PG8_SA(1, 0), a3, voffA);
            PG8_WAIT_V(8); PG8_WAIT_L(0); PG8_BAR; PG8_MMA(1, 0, At, B0); PG8_MMA(1, 1, At, B1); PG8_BAR; PG8_SCHED;
        }
        if (wr == 0) PG8_BAR;
        E(acc, cur, wr, wc, fr, fq);
        if (!has_next) break;
#pragma unroll
        for (int a = 0; a < 2; ++a)
#pragma unroll
            for (int b = 0; b < 2; ++b)
#pragma unroll
                for (int m = 0; m < 4; ++m)
#pragma unroll
                    for (int n = 0; n < 2; ++n) acc[a][b][m][n] = (f32x4){0.f, 0.f, 0.f, 0.f};
        cur = nxt; cA = nA; cB = nB; ++ui;
        if (wr == 1) PG8_BAR;
    }
    PG8_WAIT_V(0);
    PG8_BAR;
#undef PG8_SA
#undef PG8_SB
#undef PG8_STAGE
#undef PG8_LDA
#undef PG8_LDB
#undef PG8_MMA
#undef PG8_WAIT_V
#undef PG8_WAIT_L
#undef PG8_BAR
#undef PG8_SCHED
}
}

struct Args { const float* in[25]; float* out; unsigned char* ws; int ph_lo, ph_hi; };
enum { I_X = 0, I_P, I_F1PRE, I_F1POST, I_F1WIN, I_F1WOUT, I_MPRE, I_MPOST, I_MWIN, I_CONVW, I_ALOG, I_DTB, I_DNG, I_IDXG, I_WBA, I_WBB, I_MWOUT,
       I_F2PRE, I_F2POST, I_F2WIN, I_F2WOUT, I_PPRE, I_PPOST, I_PWG, I_PWP };

__device__ __forceinline__ int srccol(int map, int n) {
    if (map == 0) return n;
    if (map == 1) { const int pn = n >> 8, tc = n & 255; return tc < 128 ? pn * 128 + tc : FF + pn * 128 + (tc - 128); }
    if (n < 2048) return n;
    if (n < 4096) return 2064 + (n - 2048);
    if (n < 6144) return 4184 + (n - 4096);
    const int tc = n - 6144;
    if (tc < 64) return 4112 + tc;
    if (tc < 72) return 2048 + (tc - 64);
    if (tc < 80) return 2056 + (tc - 72);
    if (tc < 88) return 4176 + (tc - 80);
    return -1;
}
__device__ __forceinline__ void transpose_item(const float* W, int K, int N, h16* WT, int NP, int map, float* scr, int item, int lane) {
    const int nblk = NP / 32, kb = item / nblk, nb = item % nblk, k0 = 64 * kb, n0 = 32 * nb;
    const int sc = srccol(map, n0 + (lane & 31));
#pragma unroll 8
    for (int i = 0; i < 32; ++i) { const int kk = 2 * i + (lane >> 5); scr[kk * 33 + (lane & 31)] = sc >= 0 ? W[(size_t)(k0 + kk) * N + sc] : 0.f; }
    LDS_WAIT();
    const int c = lane & 7;
#pragma unroll
    for (int j = 0; j < 4; ++j) { const int n = (lane >> 3) + 8 * j; const float* s = scr + (8 * c) * 33 + n;
        f32x4 a = {s[0], s[33], s[66], s[99]}, b = {s[132], s[165], s[198], s[231]};
        *(u32x4*)(WT + (size_t)(n0 + n) * K + k0 + 8 * c) = pack8(a, b); }
    LDS_WAIT();
}

__device__ __forceinline__ void load_row_f32(const float* p, int lane, f32x4 (&v)[4]) {
#pragma unroll
    for (int j = 0; j < 4; ++j) v[j] = *(const f32x4*)(p + 4 * lane + 256 * j);
}
__device__ __forceinline__ void load_row_h16(const h16* p, int lane, f32x4 (&v)[4]) {
#pragma unroll
    for (int j = 0; j < 4; ++j) { const h16x4 h = *(const h16x4*)(p + 4 * lane + 256 * j); v[j] = (f32x4){(float)h[0], (float)h[1], (float)h[2], (float)h[3]}; }
}
__device__ __forceinline__ float row_rms_scale(const f32x4 (&v)[4]) {
    float s = 0.f;
#pragma unroll
    for (int j = 0; j < 4; ++j) s += (v[j][0] * v[j][0] + v[j][1] * v[j][1]) + (v[j][2] * v[j][2] + v[j][3] * v[j][3]);
    return rsqrtf(wave_sum(s) * (1.0f / D) + EPS);
}
template <bool BASE_F32, bool FINAL>
__device__ __forceinline__ void resid_norm_phase(const float* xbase, h16* H, const float* Y, float coef, const float* g_post, const float* g_pre, h16* XN, float* outp, int gw, int ngw, int lane) {
    for (int row = gw; row < T; row += ngw) {
        f32x4 y[4], b[4], gp[4];
        load_row_f32(Y + (size_t)row * D, lane, y);
        if (BASE_F32) load_row_f32(xbase + (size_t)row * D, lane, b); else load_row_h16(H + (size_t)row * D, lane, b);
        load_row_f32(g_post, lane, gp);
        const float r = row_rms_scale(y) * coef;
#pragma unroll
        for (int j = 0; j < 4; ++j) b[j] = b[j] + y[j] * r * gp[j];
        if (FINAL) {
#pragma unroll
            for (int j = 0; j < 4; ++j) *(f32x4*)(outp + (size_t)row * D + 4 * lane + 256 * j) = b[j];
        } else {
            f32x4 g2[4]; load_row_f32(g_pre, lane, g2);
            const float r2 = row_rms_scale(b);
#pragma unroll
            for (int j = 0; j < 4; ++j) {
                *(u32x2*)(H + (size_t)row * D + 4 * lane + 256 * j) = pack4(b[j]);
                *(u32x2*)(XN + (size_t)row * D + 4 * lane + 256 * j) = pack4(b[j] * r2 * g2[j]);
            }
        }
    }
}

__global__ void __launch_bounds__(NTHREADS, 2) fwd_kernel(Args args) {
    extern __shared__ __attribute__((aligned(16))) unsigned char lds[];
    cg::grid_group grid = cg::this_grid();
    const int G = gridDim.x, bid = blockIdx.x;
#ifdef DUP_PHASE
    bool dup_done = false;
#endif
    for (int ph = args.ph_lo; ph < args.ph_hi; ++ph) {
    int tid = threadIdx.x; asm volatile("" : "+v"(tid));
    unsigned char* ws = args.ws; asm volatile("" : "+s"(ws));
    float* outp_ = args.out; asm volatile("" : "+s"(outp_));
    const int lane = tid & 63, wave = __builtin_amdgcn_readfirstlane(tid >> 6);
    const int gw = bid * NWAVES + wave, ngw = G * NWAVES;
    float* ROPE = (float*)(ws + WS_ROPE);
    h16 *W1 = (h16*)(ws + WS_W1), *W2 = (h16*)(ws + WS_W2), *WM = (h16*)(ws + WS_WM), *WBA = (h16*)(ws + WS_WBA), *WBB = (h16*)(ws + WS_WBB), *WO = (h16*)(ws + WS_WO);
    h16 *W3 = (h16*)(ws + WS_W3), *W4 = (h16*)(ws + WS_W4), *WG = (h16*)(ws + WS_WG), *WP = (h16*)(ws + WS_WP);
    h16 *P16 = (h16*)(ws + WS_P16), *XN = (h16*)(ws + WS_XN), *H16 = (h16*)(ws + WS_H16), *HID = (h16*)(ws + WS_HID), *TMP = (h16*)(ws + WS_TMP);
    h16 *QKVA = (h16*)(ws + WS_QKVA), *ZS = (h16*)(ws + WS_ZS), *QKVB = (h16*)(ws + WS_QKVB), *QI = (h16*)(ws + WS_QI), *HALO = (h16*)(ws + WS_HALO), *KI = (h16*)(ws + WS_KI);
    float* MISC = (float*)(ws + WS_MISC);
    unsigned long long* MASK = (unsigned long long*)(ws + WS_MASK);
    float* Y = outp_;
    h16* GATES = (h16*)outp_;

        pg8::Gemm g{nullptr, nullptr, T, 0, 0, 0};
        pg8::Epi E{}; E.mode = -1;
        switch (ph) {
        case 0: {
            float* scr = (float*)lds + wave * (64 * 33);
            constexpr int I1 = 16 * (5632 / 32), I2 = 44 * 32, IM = 16 * (NMIX / 32), IB = 8 * 32, IO = 16 * 32, IP = 4 * 32;
            constexpr int NIT = 2 * I1 + 2 * I2 + IM + 2 * IB + 2 * IO + IP;
            for (int it = gw; it < NIT; it += ngw) {
                int r = it;
                if (r < I1) { transpose_item(args.in[I_F1WIN], D, 2 * FF, W1, 2 * FF, 1, scr, r, lane); continue; } r -= I1;
                if (r < I1) { transpose_item(args.in[I_F2WIN], D, 2 * FF, W3, 2 * FF, 1, scr, r, lane); continue; } r -= I1;
                if (r < I2) { transpose_item(args.in[I_F1WOUT], FF, D, W2, D, 0, scr, r, lane); continue; } r -= I2;
                if (r < I2) { transpose_item(args.in[I_F2WOUT], FF, D, W4, D, 0, scr, r, lane); continue; } r -= I2;
                if (r < IM) { transpose_item(args.in[I_MWIN], D, 6232, WM, NMIX, 2, scr, r, lane); continue; } r -= IM;
                if (r < IB) { transpose_item(args.in[I_WBA], 512, D, WBA, D, 0, scr, r, lane); continue; } r -= IB;
                if (r < IB) { transpose_item(args.in[I_WBB], 512, D, WBB, D, 0, scr, r, lane); continue; } r -= IB;
                if (r < IO) { transpose_item(args.in[I_MWOUT], D, D, WO, D, 0, scr, r, lane); continue; } r -= IO;
                if (r < IO) { transpose_item(args.in[I_PWG], D, D, WG, D, 0, scr, r, lane); continue; } r -= IO;
                transpose_item(args.in[I_PWP], PLE, D, WP, D, 0, scr, r, lane);
            }
            if (bid == 0 && tid == 0) *(unsigned*)ws = 0u;
            { const float* p = args.in[I_P]; const size_t n8 = (size_t)T * PLE / 8;
              for (size_t i = (size_t)bid * NTHREADS + tid; i < n8; i += (size_t)G * NTHREADS) { const f32x4 a = *(const f32x4*)(p + 8 * i), b = *(const f32x4*)(p + 8 * i + 4); *(u32x4*)(P16 + 8 * i) = pack8(a, b); } }
            for (int i = bid * NTHREADS + tid; i < SEQ * 8; i += G * NTHREADS) {
                const int pos = i >> 3, f = i & 7;
                const float invt[8] = {1.0f, 0.1939227432012558f, 0.03760603070259094f, 0.007292664609849453f, 0.0014142135623842478f, 0.00027424818836152554f, 5.3182957344688475e-05f, 1.0313385246263351e-05f};
                float inv = invt[0];
#pragma unroll
                for (int q = 1; q < 8; ++q) inv = (f == q) ? invt[q] : inv;
                const float ang = (float)pos * inv;
                ROPE[pos * 16 + f] = cosf(ang); ROPE[pos * 16 + 8 + f] = sinf(ang);
            }
            { const float* x = args.in[I_X]; const float* gp = args.in[I_F1PRE];
              for (int row = gw; row < T; row += ngw) { f32x4 v[4], gg[4]; load_row_f32(x + (size_t)row * D, lane, v); load_row_f32(gp, lane, gg); const float r = row_rms_scale(v);
#pragma unroll
                  for (int j = 0; j < 4; ++j) *(u32x2*)(XN + (size_t)row * D + 4 * lane + 256 * j) = pack4(v[j] * r * gg[j]); } }
        } break;
        case 1: g = pg8::Gemm{XN, W1, T, 2 * FF, D, D}; E.mode = pg8::EPI_SWIGLU; E.o16 = HID; E.ldo = FF; break;
        case 2: g = pg8::Gemm{HID, W2, T, D, FF, FF}; E.mode = pg8::EPI_F32; E.o32 = Y; E.ldo = D; break;
        case 3: resid_norm_phase<true, false>(args.in[I_X], H16, Y, 0.5f, args.in[I_F1POST], args.in[I_MPRE], XN, nullptr, gw, ngw, lane); break;
        case 4: g = pg8::Gemm{XN, WM, T, NMIX, D, D}; E.mode = pg8::EPI_MIX; E.qkva = QKVA; E.zs = ZS; E.qkvb = QKVB; E.qi = QI; E.gates = GATES; E.halo = HALO; E.misc = MISC;
                E.rope = ROPE; E.a_log = args.in[I_ALOG]; E.dt_bias = args.in[I_DTB]; break;
        case 5: {
            const float* cw = args.in[I_CONVW];
            for (int unit = gw; unit < 512 * 24; unit += ngw) {
                const int c = unit / 24, grp = unit % 24, ch = grp * 64 + lane;
                const float w0 = cw[ch], w1 = cw[1536 + ch], w2 = cw[2 * 1536 + ch], w3 = cw[3 * 1536 + ch];
                float xm3 = 0.f, xm2 = 0.f, xm1 = 0.f;
                if (c & 63) { const h16* hp = HALO + (size_t)(c - 1) * 3 * 1536 + ch; xm3 = (float)hp[0]; xm2 = (float)hp[1536]; xm1 = (float)hp[2 * 1536]; }
                h16* base = QKVA + (size_t)c * 64 * 1536 + ch;
                float xv[64];
#pragma unroll
                for (int r = 0; r < 64; ++r) xv[r] = (float)base[(size_t)r * 1536];
#pragma unroll
                for (int r = 0; r < 64; ++r) {
                    const float x0 = xv[r];
                    float yv = siluf_(w0 * xm3 + w1 * xm2 + w2 * xm1 + w3 * x0);
                    xm3 = xm2; xm2 = xm1; xm1 = x0;
                    if (grp < 16) { const float ss = wave_sum(yv * yv); yv *= rsqrtf(ss + EPS); if (grp < 8) yv *= 0.125f; }
                    xv[r] = yv;
                }
#pragma unroll
                for (int r = 0; r < 64; ++r) base[(size_t)r * 1536] = (h16)xv[r];
            }
            { h16* VT = (h16*)(ws + WS_XN);
              for (int unit = gw; unit < 64 * 64; unit += ngw) {
                  const int bh = unit >> 6, tt = unit & 63, b = bh >> 3, h = bh & 7;
                  const h16* src = QKVB + ((size_t)b * SEQ + tt * 64) * 1536 + 1024 + h * 64 + lane;
                  h16 col[64];
#pragma unroll
                  for (int r = 0; r < 64; ++r) col[r] = src[(size_t)r * 1536];
                  h16* dst = VT + ((size_t)bh * 64 + lane) * SEQ + tt * 64;
#pragma unroll
                  for (int c8 = 0; c8 < 8; ++c8) { h16x8 v;
#pragma unroll
                      for (int i = 0; i < 8; ++i) v[i] = col[8 * c8 + i];
                      *(h16x8*)(dst + 8 * c8) = v; }
              } }
            const float* ig = args.in[I_IDXG];
            for (int row = gw; row < T; row += ngw) {
                float v = MISC[(size_t)row * 96 + lane];
                const float ss = wave_sum(v * v);
                v = v * rsqrtf(ss * (1.0f / 64.0f) + EPS) * ig[lane];
                const float pr = __shfl_xor(v, 8);
                if (lane < 16) { const float* rp = ROPE + (size_t)(row & (SEQ - 1)) * 16; const float c = rp[lane & 7], s = rp[8 + (lane & 7)]; v = lane < 8 ? v * c - pr * s : v * c + pr * s; }
                KI[(size_t)row * 64 + lane] = (h16)v;
            }
        } break;
        case 6: {
            typedef float f32x16 __attribute__((ext_vector_type(16)));
            unsigned* sc = (unsigned*)lds;
            const int r32 = lane & 31, hi = lane >> 5;
            for (int k = bid; k < T / 8; k += G) {
                const int b = k & 7, t0 = (511 - (k >> 3)) * 8, row0 = b * SEQ + t0;
                h16x8 qa[2][4]; float wv[2][2][8];
                {   const int g_ = r32 >> 3, hi_ = (r32 >> 2) & 1, head = 4 * (g_ & 1) + (r32 & 3);
#pragma unroll
                    for (int mt = 0; mt < 2; ++mt) { const h16* qp = QI + (size_t)(row0 + 4 * mt + 2 * hi_ + (g_ >> 1)) * 512 + head * 64 + 8 * hi;
#pragma unroll
                        for (int ks = 0; ks < 4; ++ks) qa[mt][ks] = *(const h16x8*)(qp + 16 * ks); }
#pragma unroll
                    for (int mt = 0; mt < 2; ++mt)
#pragma unroll
                        for (int qq = 0; qq < 2; ++qq) { const float* wp = MISC + (size_t)(row0 + 4 * mt + 2 * hi + qq) * 96 + 80; const f32x4 a = *(const f32x4*)wp, c = *(const f32x4*)(wp + 4);
                            wv[mt][qq][0] = a[0]; wv[mt][qq][1] = a[1]; wv[mt][qq][2] = a[2]; wv[mt][qq][3] = a[3]; wv[mt][qq][4] = c[0]; wv[mt][qq][5] = c[1]; wv[mt][qq][6] = c[2]; wv[mt][qq][7] = c[3]; }
                }
                const int nkt = 2 * ((t0 + 8 + 63) >> 6);
                for (int kt = wave; kt < nkt; kt += NWAVES) {
                    const h16* kp = KI + ((size_t)b * SEQ + 32 * kt + r32) * 64 + 8 * hi;
                    h16x8 kb[4];
#pragma unroll
                    for (int ks = 0; ks < 4; ++ks) kb[ks] = *(const h16x8*)(kp + 16 * ks);
                    const int key = 32 * kt + r32;
#pragma unroll
                    for (int mt = 0; mt < 2; ++mt) {
                        f32x16 acc = {0.f, 0.f, 0.f, 0.f, 0.f, 0.f, 0.f, 0.f, 0.f, 0.f, 0.f, 0.f, 0.f, 0.f, 0.f, 0.f};
#pragma unroll
                        for (int ks = 0; ks < 4; ++ks) acc = __builtin_amdgcn_mfma_f32_32x32x16_f16(qa[mt][ks], kb[ks], acc, 0, 0, 0);
#pragma unroll
                        for (int qq = 0; qq < 2; ++qq) {
                            float sv = 0.f;
#pragma unroll
                            for (int h = 0; h < 8; ++h) sv = fmaf(wv[mt][qq][h], fmaxf(acc[8 * qq + h], 0.f), sv);
                            const int ql = 4 * mt + 2 * hi + qq;
                            unsigned u = __float_as_uint(sv); u = (u & 0x80000000u) ? ~u : (u | 0x80000000u);
                            sc[ql * 4096 + key] = (key <= t0 + ql) ? u : 0u;
                        }
                    }
                }
                __syncthreads();
                {
                    const int t = t0 + wave, n = t + 1, nw = (n + 63) >> 6;
                    const unsigned* scq = sc + wave * 4096;
                    unsigned uk[64];
#pragma unroll
                    for (int i = 0; i < 64; ++i) uk[i] = (i < nw) ? scq[i * 64 + lane] : 0u;
                    unsigned thr = 1u; int need = 0;
                    if (n > 256) {
                        unsigned prefix = 0u;
#pragma unroll 1
                        for (int bit = 31; bit >= 0; --bit) {
                            const unsigned cand = prefix | (1u << bit);
                            int cnt = 0;
#pragma unroll
                            for (int i = 0; i < 64; ++i) cnt += __popcll(__ballot(uk[i] >= cand));
                            if (cnt >= 256) prefix = cand;
                        }
                        thr = prefix;
                        int cg_ = 0;
#pragma unroll
                        for (int i = 0; i < 64; ++i) cg_ += __popcll(__ballot(uk[i] > thr));
                        need = 256 - cg_;
                    }
                    int running = 0;
                    unsigned long long* mrow = MASK + (size_t)(row0 + wave) * 64;
                    unsigned long long mine = 0ull;
#pragma unroll
                    for (int i = 0; i < 64; ++i) {
                        const bool gt = (n > 256) ? (uk[i] > thr) : (uk[i] != 0u);
                        const bool eq = (n > 256) && (uk[i] == thr);
                        const unsigned long long beq = __ballot(eq);
                        const int rank = running + __popcll(beq & ((1ull << lane) - 1ull));
                        const bool take = gt || (eq && rank < need);
                        running += __popcll(beq);
                        const unsigned long long mm = __ballot(take);
                        if (lane == i) mine = mm;
                    }
                    mrow[lane] = mine;
                }
                __syncthreads();
            }
        } break;
        case 7: {
            typedef float f32x16 __attribute__((ext_vector_type(16)));
            float* Lw = (float*)lds + wave * (4096 + 128);
            float* sg = Lw + 4096; float* sb = sg + 64;
            h16* WB = (h16*)(ws + WS_XN + 32 * MiB); h16* KDT = (h16*)(ws + WS_QI);
            const int r32 = lane & 31, hi = lane >> 5;
            for (int unit = gw; unit < 4096; unit += ngw) {
                const int c = unit >> 3, h = unit & 7; const size_t row0 = (size_t)c * 64;
                float* mg = MISC + (row0 + lane) * 96 + 64 + h;
                float gc = mg[0]; const float bt = mg[8];
#pragma unroll
                for (int o = 1; o < 64; o <<= 1) { const float v = __shfl_up(gc, o); if (lane >= o) gc += v; }
                sg[lane] = gc; sb[lane] = bt;
                const float gc63 = __shfl(gc, 63);
                h16* qbase = QKVA + row0 * 1536 + h * 64;
                h16x8 ak[2][4], bq[2][4];
                { const h16* fp = qbase + (size_t)r32 * 1536 + 8 * hi;
#pragma unroll
                  for (int rt = 0; rt < 2; ++rt)
#pragma unroll
                      for (int ks = 0; ks < 4; ++ks) { ak[rt][ks] = *(const h16x8*)(fp + (size_t)rt * 32 * 1536 + 512 + 16 * ks); bq[rt][ks] = *(const h16x8*)(fp + (size_t)rt * 32 * 1536 + 16 * ks); } }
                LDS_WAIT();
#pragma unroll
                for (int tile = 0; tile < 3; ++tile) {
                    const int rt = tile == 0 ? 0 : 1, ct = tile == 2 ? 1 : 0;
                    f32x16 acc;
#pragma unroll
                    for (int i = 0; i < 16; ++i) acc[i] = 0.f;
#pragma unroll
                    for (int ks = 0; ks < 4; ++ks) acc = __builtin_amdgcn_mfma_f32_32x32x16_f16(ak[rt][ks], ak[ct][ks], acc, 0, 0, 0);
                    const int tp = 32 * ct + r32; const float gcol = sg[tp];
#pragma unroll
                    for (int i = 0; i < 16; ++i) { const int t = 32 * rt + (i & 3) + 8 * (i >> 2) + 4 * hi;
                        Lw[t * 64 + tp] = (t > tp) ? sb[t] * acc[i] * __expf(sg[t] - gcol) : 0.f; }
                }
                u32x2 xt[3][4];
#pragma unroll
                for (int tile = 0; tile < 3; ++tile) {
                    const int rt = tile == 2 ? 1 : 0, ct = tile == 0 ? 0 : 1;
                    f32x16 acc;
#pragma unroll
                    for (int i = 0; i < 16; ++i) acc[i] = 0.f;
#pragma unroll
                    for (int ks = 0; ks < 4; ++ks) acc = __builtin_amdgcn_mfma_f32_32x32x16_f16(ak[rt][ks], bq[ct][ks], acc, 0, 0, 0);
                    const int t = 32 * ct + r32; const float gcol = sg[t];
#pragma unroll
                    for (int g4 = 0; g4 < 4; ++g4) { f32x4 v4;
#pragma unroll
                        for (int i = 0; i < 4; ++i) { const int tp = 32 * rt + i + 8 * g4 + 4 * hi; v4[i] = (t >= tp) ? acc[4 * g4 + i] * __expf(gcol - sg[tp]) : 0.f; }
                        xt[tile][g4] = pack4(v4); }
                }
                { h16* qp = qbase + lane;
#pragma unroll 8
                  for (int t = 0; t < 64; ++t) { *qp = (h16)((float)*qp * __expf(sg[t])); qp += 1536; asm volatile("" : "+v"(qp)); } }
                float xx[64];
                { const h16* kp = qbase + 512 + lane;
#pragma unroll
                  for (int t = 0; t < 64; ++t) { xx[t] = (float)*kp; kp += 1536; asm volatile("" : "+v"(kp)); } }
                {
                    h16* kd = KDT + ((size_t)unit * 64 + lane) * 64;
#pragma unroll
                    for (int c8 = 0; c8 < 8; ++c8) { f32x4 a, b2;
#pragma unroll
                        for (int i = 0; i < 4; ++i) { a[i] = xx[8 * c8 + i] * __expf(gc63 - sg[8 * c8 + i]); b2[i] = xx[8 * c8 + 4 + i] * __expf(gc63 - sg[8 * c8 + 4 + i]); }
                        *(u32x4*)(kd + 8 * c8) = pack8(a, b2); }
                }
#pragma unroll
                for (int tile = 0; tile < 3; ++tile) {
                    const int rt = tile == 2 ? 1 : 0, ct = tile == 0 ? 0 : 1;
                    h16* xp = qbase + (size_t)(32 * ct + r32) * 1536 + 512 + 32 * rt + 4 * hi;
#pragma unroll
                    for (int g4 = 0; g4 < 4; ++g4) *(u32x2*)(xp + 8 * g4) = xt[tile][g4];
                }
#define FWD_SUBST(X) do { _Pragma("unroll") for (int i = 1; i < 64; ++i) { float a_ = X[i]; \
                    _Pragma("unroll") for (int j4 = 0; j4 < (i + 3) / 4; ++j4) { const f32x4 l4 = *(const f32x4*)(Lw + i * 64 + 4 * j4); \
                        _Pragma("unroll") for (int jj = 0; jj < 4; ++jj) if (4 * j4 + jj < i) a_ -= l4[jj] * X[4 * j4 + jj]; } \
                    X[i] = a_; if ((i & 3) == 3) asm volatile("" ::: "memory"); } } while (0)
#pragma unroll
                for (int t = 0; t < 64; ++t) xx[t] *= sb[t] * __expf(sg[t]);
                FWD_SUBST(xx);
                { h16* wp = WB + (size_t)unit * 4096 + lane;
#pragma unroll
                  for (int t = 0; t < 64; ++t) { *wp = (h16)xx[t]; wp += 64; asm volatile("" : "+v"(wp)); } }
                { const h16* vp = qbase + 1024 + lane;
#pragma unroll
                  for (int t = 0; t < 64; ++t) { xx[t] = (float)*vp * sb[t]; vp += 1536; asm volatile("" : "+v"(vp)); } }
                FWD_SUBST(xx);
#undef FWD_SUBST
                {
                    h16* up = qbase + (size_t)lane * 1536 + 1024;
#pragma unroll
                    for (int c8 = 0; c8 < 8; ++c8) { const f32x4 a = {xx[8 * c8], xx[8 * c8 + 1], xx[8 * c8 + 2], xx[8 * c8 + 3]}, b2 = {xx[8 * c8 + 4], xx[8 * c8 + 5], xx[8 * c8 + 6], xx[8 * c8 + 7]};
                        *(u32x4*)(up + 8 * c8) = pack8(a, b2); }
                }
                mg[0] = gc;
                LDS_WAIT();
            }
        } break;
        case 8: {
            typedef float f32x16 __attribute__((ext_vector_type(16)));
            const int r32 = lane & 31, hi = lane >> 5;
            const int srow = tid >> 3, sch = tid & 7;
            if (bid < 64) {
                constexpr int MB = 8704, BUFB = 5 * MB;
                const int b = bid >> 3, h = bid & 7;
                const h16* WB = (const h16*)(ws + WS_XN + 32 * MiB); const h16* KDT = (const h16*)(ws + WS_QI);
                const h16* gq = QKVA + ((size_t)b * SEQ + srow) * 1536 + h * 64 + 8 * sch;
                const h16* gwb = WB + ((size_t)(b * 64) * 8 + h) * 4096 + srow * 64 + 8 * sch;
                const h16* gkd = KDT + ((size_t)(b * 64) * 8 + h) * 4096 + srow * 64 + 8 * sch;
                const int sws = srow * 136 + sch * 16;
                u32x4 rg[5];
                rg[0] = *(const u32x4*)gq; rg[1] = *(const u32x4*)gwb; rg[2] = *(const u32x4*)(gq + 512); rg[3] = *(const u32x4*)gkd; rg[4] = *(const u32x4*)(gq + 1024);
#pragma unroll
                for (int mI = 0; mI < 5; ++mI) { unsigned char* d = lds + mI * MB + sws; *(u32x2*)d = (u32x2){rg[mI][0], rg[mI][1]}; *(u32x2*)(d + 8) = (u32x2){rg[mI][2], rg[mI][3]}; }
                __syncthreads();
                f32x16 St[2];
#pragma unroll
                for (int i = 0; i < 16; ++i) { St[0][i] = 0.f; St[1][i] = 0.f; }
                for (int c = 0; c < 64; ++c) {
                    const int cur = c & 1;
                    if (c + 1 < 64) { const size_t go = (size_t)(c + 1) * 64 * 1536, wo = (size_t)(c + 1) * 8 * 4096;
                        rg[0] = *(const u32x4*)(gq + go); rg[1] = *(const u32x4*)(gwb + wo); rg[2] = *(const u32x4*)(gq + go + 512); rg[3] = *(const u32x4*)(gkd + wo); rg[4] = *(const u32x4*)(gq + go + 1024); }
                    if (wave < 2) {
                        const float e63 = __expf(MISC[((size_t)b * SEQ + c * 64 + 63) * 96 + 64 + h]);
                        const unsigned char* B_ = lds + cur * BUFB;
                        const int koff = 8 * hi;
                        h16x8 sf[2][2];
#pragma unroll
                        for (int rt = 0; rt < 2; ++rt)
#pragma unroll
                            for (int s2 = 0; s2 < 2; ++s2)
#pragma unroll
                                for (int j = 0; j < 8; ++j) sf[rt][s2][j] = (h16)St[rt][8 * s2 + j];
                        f32x16 P[2], O[2];
#pragma unroll
                        for (int i = 0; i < 16; ++i) { P[0][i] = 0.f; P[1][i] = 0.f; O[0][i] = 0.f; O[1][i] = 0.f; }
#define FRAG(mI, row, kel) ({ const unsigned char* fp_ = B_ + (mI) * MB + (row) * 136 + (kel) * 2 + koff; const h16x4 lo_ = *(const h16x4*)fp_, hi_ = *(const h16x4*)(fp_ + 16); \
                              (h16x8){lo_[0], lo_[1], lo_[2], lo_[3], hi_[0], hi_[1], hi_[2], hi_[3]}; })
#pragma unroll
                        for (int tt = 0; tt < 2; ++tt)
#pragma unroll
                            for (int rt = 0; rt < 2; ++rt)
#pragma unroll
                                for (int s2 = 0; s2 < 2; ++s2) {
                                    const h16x8 aw = FRAG(1, 32 * tt + r32, 32 * rt + 16 * s2), aq = FRAG(0, 32 * tt + r32, 32 * rt + 16 * s2);
                                    P[tt] = __builtin_amdgcn_mfma_f32_32x32x16_f16(aw, sf[rt][s2], P[tt], 0, 0, 0);
                                    O[tt] = __builtin_amdgcn_mfma_f32_32x32x16_f16(aq, sf[rt][s2], O[tt], 0, 0, 0);
                                }
                        f32x16 Vn[2];
#pragma unroll
                        for (int tt = 0; tt < 2; ++tt)
#pragma unroll
                            for (int g4 = 0; g4 < 4; ++g4) { const h16x4 u4 = *(const h16x4*)(B_ + 4 * MB + (32 * wave + r32) * 136 + (32 * tt + 8 * g4) * 2 + koff);
#pragma unroll
                                for (int i = 0; i < 4; ++i) Vn[tt][4 * g4 + i] = (float)u4[i] - P[tt][4 * g4 + i]; }
                        h16x8 vf[2][2];
#pragma unroll
                        for (int tt = 0; tt < 2; ++tt)
#pragma unroll
                            for (int s2 = 0; s2 < 2; ++s2)
#pragma unroll
                                for (int j = 0; j < 8; ++j) vf[tt][s2][j] = (h16)Vn[tt][8 * s2 + j];
#pragma unroll
                        for (int tt = 0; tt < 2; ++tt)
#pragma unroll
                            for (int t2 = 0; t2 <= tt; ++t2)
#pragma unroll
                                for (int s2 = 0; s2 < 2; ++s2) { const h16x8 ax = FRAG(2, 32 * tt + r32, 32 * t2 + 16 * s2); O[tt] = __builtin_amdgcn_mfma_f32_32x32x16_f16(ax, vf[t2][s2], O[tt], 0, 0, 0); }
#pragma unroll
                        for (int rt = 0; rt < 2; ++rt) {
#pragma unroll
                            for (int i = 0; i < 16; ++i) St[rt][i] *= e63;
#pragma unroll
                            for (int t2 = 0; t2 < 2; ++t2)
#pragma unroll
                                for (int s2 = 0; s2 < 2; ++s2) { const h16x8 akd = FRAG(3, 32 * rt + r32, 32 * t2 + 16 * s2); St[rt] = __builtin_amdgcn_mfma_f32_32x32x16_f16(akd, vf[t2][s2], St[rt], 0, 0, 0); }
                        }
#undef FRAG
                        h16* op = QKVA + ((size_t)b * SEQ + c * 64 + 4 * hi) * 1536 + 1024 + h * 64 + 32 * wave + r32;
#pragma unroll
                        for (int tt = 0; tt < 2; ++tt)
#pragma unroll
                            for (int i = 0; i < 16; ++i) op[(size_t)(32 * tt + (i & 3) + 8 * (i >> 2)) * 1536] = (h16)O[tt][i];
                    }
                    if (c + 1 < 64) {
#pragma unroll
                        for (int mI = 0; mI < 5; ++mI) { unsigned char* d = lds + (cur ^ 1) * BUFB + mI * MB + sws; *(u32x2*)d = (u32x2){rg[mI][0], rg[mI][1]}; *(u32x2*)(d + 8) = (u32x2){rg[mI][2], rg[mI][3]}; } }
                    __syncthreads();
                }
            }
            {
                unsigned char* kbuf = lds;
                unsigned char* vbuf = lds + 16384;
                volatile int* qslot = (volatile int*)(lds + 153600);
                unsigned* qctr = (unsigned*)ws;
                const unsigned* MASK32 = (const unsigned*)MASK;
                const h16* VT = (const h16*)(ws + WS_XN);
                const int kws = srow * 128 + ((sch ^ (srow & 7)) * 16), vws = srow * 136 + sch * 16;
                for (;;) {
                    __syncthreads();
                    if (tid == 0) *qslot = (int)__hip_atomic_fetch_add(qctr, 1u, __ATOMIC_RELAXED, __HIP_MEMORY_SCOPE_AGENT);
                    __syncthreads();
                    const int u = *qslot;
                    if (u >= 1024) break;
                    {
                        const int qb = 15 - (u >> 6), bh = u & 63, b = bh >> 3, h = bh & 7, q0 = qb * 256;
                        const int qrow = b * SEQ + q0 + 32 * wave + r32;
                        h16x8 qf[4];
                        { const h16* qp = QKVB + (size_t)qrow * 1536 + h * 64 + 8 * hi;
#pragma unroll
                          for (int ks = 0; ks < 4; ++ks) { const h16x8 t8 = *(const h16x8*)(qp + 16 * ks);
#pragma unroll
                              for (int i = 0; i < 8; ++i) qf[ks][i] = (h16)((float)t8[i] * 1.4426950408889634f); } }
                        f32x16 o[2];
#pragma unroll
                        for (int i = 0; i < 16; ++i) { o[0][i] = 0.f; o[1][i] = 0.f; }
                        float m = -1e30f, l = 0.f;
                        const int nkt = 4 * qb + 4;
                        const h16* kg = QKVB + ((size_t)b * SEQ + srow) * 1536 + 512 + h * 64 + 8 * sch;
                        const h16* vg = VT + ((size_t)bh * 64 + srow) * SEQ + 8 * sch;
                        u32x4 kreg = *(const u32x4*)kg, vreg = *(const u32x4*)vg;
                        __syncthreads();
                        *(u32x4*)(kbuf + kws) = kreg; *(u32x2*)(vbuf + vws) = (u32x2){vreg[0], vreg[1]}; *(u32x2*)(vbuf + vws + 8) = (u32x2){vreg[2], vreg[3]};
                        __syncthreads();
                        const int wq_last = q0 + 32 * wave + 31;
                        for (int kt = 0; kt < nkt; ++kt) {
                            const int cur = kt & 1;
                            if (kt + 1 < nkt) { kreg = *(const u32x4*)(kg + (size_t)(kt + 1) * 64 * 1536); vreg = *(const u32x4*)(vg + (kt + 1) * 64); }
                            if (64 * kt <= wq_last) {
                                const unsigned* mp = MASK32 + (size_t)qrow * 128 + 2 * kt;
                                unsigned mw[2] = {mp[0] >> (4 * hi), mp[1] >> (4 * hi)};
                                f32x16 S[2];
#pragma unroll
                                for (int i = 0; i < 16; ++i) { S[0][i] = 0.f; S[1][i] = 0.f; }
                                const unsigned char* kb_ = kbuf + cur * 8192 + r32 * 128;
#pragma unroll
                                for (int ks = 0; ks < 4; ++ks) {
                                    const int off = ((2 * ks + hi) ^ (r32 & 7)) * 16;
                                    const h16x8 a0 = *(const h16x8*)(kb_ + off), a1 = *(const h16x8*)(kb_ + 4096 + off);
                                    S[0] = __builtin_amdgcn_mfma_f32_32x32x16_f16(a0, qf[ks], S[0], 0, 0, 0);
                                    S[1] = __builtin_amdgcn_mfma_f32_32x32x16_f16(a1, qf[ks], S[1], 0, 0, 0);
                                }
                                float mx = S[0][0];
#pragma unroll
                                for (int i = 0; i < 16; ++i) { mx = fmaxf(mx, S[0][i]); mx = fmaxf(mx, S[1][i]); }
                                mx = fmaxf(mx, __shfl_xor(mx, 32));
                                const float mn = fmaxf(m, mx), alpha = __builtin_amdgcn_exp2f(m - mn);
                                m = mn;
                                float ps = 0.f;
#pragma unroll
                                for (int rt = 0; rt < 2; ++rt)
#pragma unroll
                                    for (int i = 0; i < 16; ++i) {
                                        const float e = __builtin_amdgcn_exp2f(S[rt][i] - mn);
                                        const int bm = __builtin_amdgcn_sbfe((int)mw[rt], (i & 3) + 8 * (i >> 2), 1);
                                        const float pe = __uint_as_float(__float_as_uint(e) & (unsigned)bm);
                                        ps += pe; S[rt][i] = pe;
                                    }
                                l = l * alpha + ps;
#pragma unroll
                                for (int i = 0; i < 16; ++i) { o[0][i] *= alpha; o[1][i] *= alpha; }
                                const unsigned char* vb_ = vbuf + cur * 8704 + r32 * 136 + 8 * hi;
#pragma unroll
                                for (int rt = 0; rt < 2; ++rt)
#pragma unroll
                                    for (int s2 = 0; s2 < 2; ++s2) {
                                        h16x8 pb;
#pragma unroll
                                        for (int j = 0; j < 8; ++j) pb[j] = (h16)S[rt][8 * s2 + j];
#pragma unroll
                                        for (int dt = 0; dt < 2; ++dt) {
                                            const unsigned char* vp = vb_ + dt * (32 * 136) + (32 * rt + 16 * s2) * 2;
                                            const h16x4 lo = *(const h16x4*)vp, hi4 = *(const h16x4*)(vp + 16);
                                            const h16x8 va = {lo[0], lo[1], lo[2], lo[3], hi4[0], hi4[1], hi4[2], hi4[3]};
                                            o[dt] = __builtin_amdgcn_mfma_f32_32x32x16_f16(va, pb, o[dt], 0, 0, 0);
                                        }
                                    }
                            }
                            if (kt + 1 < nkt) { unsigned char* kd = kbuf + (cur ^ 1) * 8192 + kws; unsigned char* vd = vbuf + (cur ^ 1) * 8704 + vws;
                                *(u32x4*)kd = kreg; *(u32x2*)vd = (u32x2){vreg[0], vreg[1]}; *(u32x2*)(vd + 8) = (u32x2){vreg[2], vreg[3]}; }
                            __syncthreads();
                        }
                        l += __shfl_xor(l, 32);
                        const float inv = 1.0f / l;
                        h16* op = QKVB + (size_t)qrow * 1536 + h * 64 + 4 * hi;
#pragma unroll
                        for (int dt = 0; dt < 2; ++dt)
#pragma unroll
                            for (int g4 = 0; g4 < 4; ++g4) {
                                const f32x4 v4 = {o[dt][4 * g4] * inv, o[dt][4 * g4 + 1] * inv, o[dt][4 * g4 + 2] * inv, o[dt][4 * g4 + 3] * inv};
                                *(u32x2*)(op + 32 * dt + 8 * g4) = pack4(v4);
                            }
                    }
                }
            }
        } break;
        case 9: {
            const float* dg = args.in[I_DNG];
            float gg[8];
#pragma unroll
            for (int i = 0; i < 8; ++i) gg[i] = dg[(lane & 7) * 8 + i];
            for (int row = gw; row < T; row += ngw) {
                h16* op = QKVA + (size_t)row * 1536 + 1024 + lane * 8;
                float o[8], z[8]; unpack8(*(const u32x4*)op, o); unpack8(*(const u32x4*)(ZS + (size_t)row * 512 + lane * 8), z);
                float ss = 0.f;
#pragma unroll
                for (int i = 0; i < 8; ++i) ss += o[i] * o[i];
                ss += __shfl_xor(ss, 1); ss += __shfl_xor(ss, 2); ss += __shfl_xor(ss, 4);
                const float r = rsqrtf(ss * (1.0f / 64.0f) + EPS);
                f32x4 a0, a1;
#pragma unroll
                for (int i = 0; i < 4; ++i) { a0[i] = o[i] * r * gg[i] * z[i]; a1[i] = o[4 + i] * r * gg[4 + i] * z[4 + i]; }
                *(u32x4*)op = pack8(a0, a1);
            }
        } break;
        case 10:  g = pg8::Gemm{QKVA + 1024, WBA, T, D, 512, 1536}; E.mode = pg8::EPI_BRA; E.o16 = XN; E.ldo = D; E.g16 = GATES; break;
        case 11: g = pg8::Gemm{QKVB, WBB, T, D, 512, 1536}; E.mode = pg8::EPI_BRB; E.o16 = XN; E.ldo = D; E.g16 = GATES; break;
        case 12: g = pg8::Gemm{XN, WO, T, D, D, D}; E.mode = pg8::EPI_F32; E.o32 = Y; E.ldo = D; break;
        case 13: resid_norm_phase<false, false>(nullptr, H16, Y, 1.0f, args.in[I_MPOST], args.in[I_F2PRE], XN, nullptr, gw, ngw, lane); break;
        case 14: g = pg8::Gemm{XN, W3, T, 2 * FF, D, D}; E.mode = pg8::EPI_SWIGLU; E.o16 = HID; E.ldo = FF; break;
        case 15: g = pg8::Gemm{HID, W4, T, D, FF, FF}; E.mode = pg8::EPI_F32; E.o32 = Y; E.ldo = D; break;
        case 16: resid_norm_phase<false, false>(nullptr, H16, Y, 0.5f, args.in[I_F2POST], args.in[I_PPRE], XN, nullptr, gw, ngw, lane); break;
        case 17: g = pg8::Gemm{XN, WG, T, D, D, D}; E.mode = pg8::EPI_PLEG; E.o16 = TMP; E.ldo = D; break;
        case 18: g = pg8::Gemm{P16, WP, T, D, PLE, PLE}; E.mode = pg8::EPI_PLEP; E.o32 = Y; E.ldo = D; E.g16 = TMP; break;
        case 19: resid_norm_phase<false, true>(nullptr, H16, Y, 1.0f, args.in[I_PPOST], nullptr, nullptr, outp_, gw, ngw, lane); break;
        default: break;
        }
        if (E.mode >= 0) { pg8::StaticOrder S; S.init(T, g.N, G, bid); pg8::gemm_phase((LAS unsigned char*)lds, g, S, E, tid); }
#ifdef DUP_PHASE
        if (ph == DUP_PHASE && !dup_done) { dup_done = true; --ph; }
#endif
        if (ph + 1 < args.ph_hi) grid.sync();
    }
}

constexpr int NPHASES = 20;

extern "C" void kernel_launch(void* const* d_in, const int* in_sizes, int n_in, void* d_out, int out_size, void* d_ws, size_t ws_size, hipStream_t stream) {
    static int grid = 0;
    if (grid == 0) {
        if (n_in != 25 || in_sizes[0] != T * D || out_size != T * D || ws_size < WS_END || ws_size < WS_HID + (size_t)T * FF * 2) {
            fprintf(stderr, "kernel_launch: unexpected shapes / workspace (n_in %d, in0 %d, out %d, ws %zu); nothing launched\n", n_in, n_in > 0 ? in_sizes[0] : -1, out_size, ws_size); grid = -1; return; }
        int dev = 0, cus = 0, per_cu = 0;
        hipGetDevice(&dev);
        hipDeviceGetAttribute(&cus, hipDeviceAttributeMultiprocessorCount, dev);
        hipFuncSetAttribute((const void*)fwd_kernel, hipFuncAttributeMaxDynamicSharedMemorySize, LDS_BYTES);
        hipOccupancyMaxActiveBlocksPerMultiprocessor(&per_cu, (const void*)fwd_kernel, NTHREADS, LDS_BYTES);
        if (per_cu < 1) { fprintf(stderr, "kernel_launch: occupancy query says %d blocks per CU\n", per_cu); per_cu = 1; }
        if (per_cu > 1) per_cu = 1;
        grid = cus * per_cu;
        (void)hipGetLastError();
    }
    if (grid < 0) return;
    Args a{};
    for (int i = 0; i < 25; ++i) a.in[i] = (const float*)d_in[i];
    a.out = (float*)d_out; a.ws = (unsigned char*)d_ws;
#if MK_PER_PHASE
    for (int ph = 0; ph < NPHASES; ++ph) {
        a.ph_lo = ph; a.ph_hi = ph + 1;
        void* kargs[] = {&a};
        hipError_t e = hipLaunchCooperativeKernel((const void*)fwd_kernel, dim3(grid), dim3(NTHREADS), kargs, LDS_BYTES, stream);
        if (e != hipSuccess) { fprintf(stderr, "launch failed: %s\n", hipGetErrorString(e)); break; }
    }
#else
    a.ph_lo = 0; a.ph_hi = NPHASES;
    void* kargs[] = {&a};
    hipError_t e = hipLaunchCooperativeKernel((const void*)fwd_kernel, dim3(grid), dim3(NTHREADS), kargs, LDS_BYTES, stream);
    if (e != hipSuccess) fprintf(stderr, "cooperative launch failed: %s (grid %d)\n", hipGetErrorString(e), grid);
#endif
}
```

```cpp
#include <hip/hip_runtime.h>
#include <hip/hip_cooperative_groups.h>
#include <cstdio>
#include <cstdint>
namespace cg = cooperative_groups;

#ifndef MK_PER_PHASE
#define MK_PER_PHASE 0
#endif

constexpr int T = 32768, D = 1024, FF = 2816, SEQ = 4096, NBATCH = 8, PLE = 256;
constexpr int NMIX = 6400;
constexpr float EPS = 1e-6f;
constexpr int NWAVES = 8, NTHREADS = 512;
constexpr int LDS_BYTES = 155648;

typedef _Float16 h16;
typedef _Float16 h16x8 __attribute__((ext_vector_type(8)));
typedef _Float16 h16x4 __attribute__((ext_vector_type(4)));
typedef short s16x8 __attribute__((ext_vector_type(8)));
typedef float f32x4 __attribute__((ext_vector_type(4)));
typedef unsigned u32x4 __attribute__((ext_vector_type(4)));
typedef unsigned u32x2 __attribute__((ext_vector_type(2)));
typedef __attribute__((address_space(1))) _Float16 gh16;
#define LAS __attribute__((address_space(3)))

constexpr size_t MiB = 1u << 20;
constexpr size_t WS_ROPE = 1 * MiB;
constexpr size_t WS_W1 = 2 * MiB;
constexpr size_t WS_W2 = WS_W1 + 11 * MiB;
constexpr size_t WS_WM = WS_W2 + 11 * MiB / 2;
constexpr size_t WS_WBA = WS_WM + 25 * MiB / 2;
constexpr size_t WS_WBB = WS_WBA + 1 * MiB;
constexpr size_t WS_WO = WS_WBB + 1 * MiB;
constexpr size_t WS_W3 = WS_WO + 2 * MiB;
constexpr size_t WS_W4 = WS_W3 + 11 * MiB;
constexpr size_t WS_WG = WS_W4 + 11 * MiB / 2;
constexpr size_t WS_WP = WS_WG + 2 * MiB;
constexpr size_t WS_P16 = 54 * MiB;
constexpr size_t WS_XN = 70 * MiB;
constexpr size_t WS_H16 = 134 * MiB;
constexpr size_t WS_ARENA = 198 * MiB;
constexpr size_t WS_HID = WS_ARENA;
constexpr size_t WS_TMP = WS_ARENA;
constexpr size_t WS_E16 = WS_ARENA + 64 * MiB;
constexpr size_t WS_QKVA = WS_ARENA;
constexpr size_t WS_ZS = WS_QKVA + 96 * MiB;
constexpr size_t WS_QKVB = WS_ZS + 32 * MiB;
constexpr size_t WS_QI = WS_QKVB + 96 * MiB;
constexpr size_t WS_MISC = WS_QI + 32 * MiB;
constexpr size_t WS_MASK = WS_MISC + 12 * MiB;
constexpr size_t WS_HALO = WS_MASK + 16 * MiB;
constexpr size_t WS_KI = WS_HALO + 5 * MiB;
constexpr size_t WS_END = WS_KI + 4 * MiB;
static_assert(WS_WP + MiB / 2 <= WS_P16 && WS_END <= 512 * MiB && WS_HID + (size_t)T * FF * 2 <= 512 * MiB, "ws map");

__device__ __forceinline__ float sigmoidf_(float x) { return __builtin_amdgcn_rcpf(1.0f + __builtin_amdgcn_exp2f(-1.4426950408889634f * x)); }
__device__ __forceinline__ float siluf_(float x) { return x * __builtin_amdgcn_rcpf(1.0f + __builtin_amdgcn_exp2f(-1.4426950408889634f * x)); }
__device__ __forceinline__ u32x4 pack8(f32x4 a, f32x4 b) {
    h16x8 h = {(h16)a[0], (h16)a[1], (h16)a[2], (h16)a[3], (h16)b[0], (h16)b[1], (h16)b[2], (h16)b[3]};
    return __builtin_bit_cast(u32x4, h);
}
__device__ __forceinline__ u32x2 pack4(f32x4 a) {
    h16x4 h = {(h16)a[0], (h16)a[1], (h16)a[2], (h16)a[3]};
    return __builtin_bit_cast(u32x2, h);
}
__device__ __forceinline__ void unpack8(u32x4 w, float (&f)[8]) {
    h16x8 h = __builtin_bit_cast(h16x8, w);
#pragma unroll
    for (int i = 0; i < 8; ++i) f[i] = (float)h[i];
}
__device__ __forceinline__ float wave_sum(float v) {
#pragma unroll
    for (int o = 1; o < 64; o <<= 1) v += __shfl_xor(v, o);
    return v;
}
__device__ __forceinline__ float wave_sum_dpp(float v) {
#define DPP_ADD(ctrl, rmask) v += __builtin_bit_cast(float, __builtin_amdgcn_update_dpp(0, __builtin_bit_cast(int, v), ctrl, rmask, 0xF, false))
    DPP_ADD(0xB1, 0xF);
    DPP_ADD(0x4E, 0xF);
    DPP_ADD(0x141, 0xF);
    DPP_ADD(0x140, 0xF);
    DPP_ADD(0x142, 0xA);
    DPP_ADD(0x143, 0xC);
#undef DPP_ADD
    return __builtin_bit_cast(float, __builtin_amdgcn_readlane(__builtin_bit_cast(int, v), 63));
}
__device__ __forceinline__ int wave_sum_dpp_i(int v) {
#define DPP_ADDI(ctrl, rmask) v += __builtin_amdgcn_update_dpp(0, v, ctrl, rmask, 0xF, false)
    DPP_ADDI(0xB1, 0xF); DPP_ADDI(0x4E, 0xF); DPP_ADDI(0x141, 0xF); DPP_ADDI(0x140, 0xF); DPP_ADDI(0x142, 0xA); DPP_ADDI(0x143, 0xC);
#undef DPP_ADDI
    return __builtin_amdgcn_readlane(v, 63);
}
__device__ __forceinline__ float sum8_dpp(float v) {
    v += __builtin_bit_cast(float, __builtin_amdgcn_update_dpp(0, __builtin_bit_cast(int, v), 0xB1, 0xF, 0xF, false));
    v += __builtin_bit_cast(float, __builtin_amdgcn_update_dpp(0, __builtin_bit_cast(int, v), 0x4E, 0xF, 0xF, false));
    v += __builtin_bit_cast(float, __builtin_amdgcn_update_dpp(0, __builtin_bit_cast(int, v), 0x141, 0xF, 0xF, false));
    return v;
}
__device__ __forceinline__ int wave_sum_i(int v) {
#pragma unroll
    for (int o = 1; o < 64; o <<= 1) v += __shfl_xor(v, o);
    return v;
}
#define LDS_WAIT() asm volatile("s_waitcnt lgkmcnt(0)" ::: "memory")

namespace pg8 {
constexpr int BM = 256, BK = 64, HALF = 128, HTB = HALF * BK * 2, STAGE_BYTES = 8 * HTB, NXCD = 8, WGM = 4;
__host__ __device__ __forceinline__ int lds_byte(int r, int c) { const int st = (r >> 4) * 2 + (c >> 5), rr = r & 15, cc = c & 31, ob = rr * 64 + cc * 2; return st * 1024 + (ob ^ (((ob >> 9) & 1) << 5)); }
__host__ __device__ __forceinline__ void stage_rc(int b, int& R, int& C) { const int st = b / 1024, sb = b % 1024, swz = sb ^ (((sb >> 9) & 1) << 5); R = (st >> 1) * 16 + swz / 64; C = (st & 1) * 32 + (swz % 64) / 2; }
__host__ __device__ __forceinline__ int perm32(int rho) { const int n = rho >> 4, i = rho & 15; return 8 * (i >> 2) + 4 * n + (i & 3); }
struct Unit { int pm, pn; };
struct Gemm { const h16* A; const h16* Bt; int M, N, K, lda; };
struct StaticOrder {
    int nM, nN, nwg, G, c;
    __device__ void init(int M, int N, int G_, int c_) { nM = M / BM; nN = N / BM; nwg = nM * nN; G = G_; c = c_; }
    __device__ bool next(int i, Unit& u) const {
        const long L = (long)i * G + c; if (L >= nwg) return false;
        int wgid = (int)L; { const int q = nwg / NXCD, r = nwg % NXCD, xcd = wgid % NXCD, off = wgid / NXCD; wgid = (xcd < r ? xcd * (q + 1) : r * (q + 1) + (xcd - r) * q) + off; }
        const int nig = WGM * nN, gid = wgid / nig, fm = gid * WGM, gsz = (nM - fm) < WGM ? (nM - fm) : WGM;
        u.pm = fm + ((wgid % nig) % gsz); u.pn = (wgid % nig) / gsz; return true;
    }
};

enum { EPI_SWIGLU = 0, EPI_F32 = 1, EPI_MIX = 2, EPI_BRA = 3, EPI_BRB = 4, EPI_PLEG = 5, EPI_PLEP = 6 };
struct Epi {
    int mode; unsigned char* ws; float* outp;
    __device__ __forceinline__ void operator()(const f32x4 (&acc)[2][2][4][2], const Unit& u, int wr, int wc, int fr, int fq) const {
        const int cb = wc * 32 + 8 * fq;
        const int row0 = u.pm * BM + wr * 64 + fr;
        h16* const o16 = (h16*)(ws + (mode == EPI_SWIGLU ? WS_HID : mode == EPI_PLEG ? WS_TMP : WS_XN));
        const int ldo = mode == EPI_SWIGLU ? FF : D;
        const h16* const g16 = mode == EPI_PLEP ? (const h16*)(ws + WS_TMP) : (const h16*)outp;
        h16* const qkva = (h16*)(ws + WS_QKVA); h16* const zs = (h16*)(ws + WS_ZS); h16* const qkvb = (h16*)(ws + WS_QKVB); h16* const qi = (h16*)(ws + WS_QI);
        h16* const gates = (h16*)outp; h16* const halo = (h16*)(ws + WS_HALO); float* const misc = (float*)(ws + WS_MISC); const float* const rope = (const float*)(ws + WS_ROPE);
        if (mode == EPI_SWIGLU) {
#pragma unroll
            for (int ai = 0; ai < 2; ++ai)
#pragma unroll
                for (int m = 0; m < 4; ++m) {
                    const int row = row0 + ai * HALF + m * 16;
                    f32x4 r0, r1;
#pragma unroll
                    for (int i = 0; i < 4; ++i) { r0[i] = siluf_(acc[ai][0][m][0][i]) * acc[ai][1][m][0][i]; r1[i] = siluf_(acc[ai][0][m][1][i]) * acc[ai][1][m][1][i]; }
                    *(u32x4*)(o16 + (size_t)row * ldo + u.pn * 128 + cb) = pack8(r0, r1);
                }
        } else if (mode == EPI_F32) {
#pragma unroll
            for (int ai = 0; ai < 2; ++ai)
#pragma unroll
                for (int m = 0; m < 4; ++m) {
                    const int row = row0 + ai * HALF + m * 16;
#pragma unroll
                    for (int bj = 0; bj < 2; ++bj) *(u32x4*)((h16*)outp + (size_t)row * D + u.pn * BM + bj * HALF + cb) = pack8(acc[ai][bj][m][0], acc[ai][bj][m][1]);
                }
        } else if (mode == EPI_BRA || mode == EPI_BRB || mode == EPI_PLEP) {
#pragma unroll
            for (int ai = 0; ai < 2; ++ai)
#pragma unroll
                for (int m = 0; m < 4; ++m) {
                    const int row = row0 + ai * HALF + m * 16;
#pragma unroll
                    for (int bj = 0; bj < 2; ++bj) {
                        const int col = u.pn * BM + bj * HALF + cb;
                        float g[8]; unpack8(*(const u32x4*)(g16 + (size_t)row * (mode == EPI_PLEP ? 1024 : 2048) + (mode == EPI_BRB ? 1024 : 0) + col), g);
                        f32x4 r0, r1;
#pragma unroll
                        for (int i = 0; i < 4; ++i) { r0[i] = g[i] * acc[ai][bj][m][0][i]; r1[i] = g[4 + i] * acc[ai][bj][m][1][i]; }
                        if (mode == EPI_PLEP) { *(u32x4*)((h16*)(ws + WS_E16) + (size_t)row * D + col) = pack8(r0, r1); }
                        else {
                            h16* p = o16 + (size_t)row * ldo + col;
                            if (mode == EPI_BRB) { float o[8]; unpack8(*(const u32x4*)p, o);
#pragma unroll
                                for (int i = 0; i < 4; ++i) { r0[i] += o[i]; r1[i] += o[4 + i]; } }
                            *(u32x4*)p = pack8(r0, r1);
                        }
                    }
                }
        } else if (mode == EPI_PLEG) {
#pragma unroll
            for (int ai = 0; ai < 2; ++ai)
#pragma unroll
                for (int m = 0; m < 4; ++m) {
                    const int row = row0 + ai * HALF + m * 16;
#pragma unroll
                    for (int bj = 0; bj < 2; ++bj) {
                        f32x4 r0, r1;
#pragma unroll
                        for (int i = 0; i < 4; ++i) { r0[i] = sigmoidf_(acc[ai][bj][m][0][i]); r1[i] = sigmoidf_(acc[ai][bj][m][1][i]); }
                        *(u32x4*)(o16 + (size_t)row * ldo + u.pn * BM + bj * HALF + cb) = pack8(r0, r1);
                    }
                }
        } else {
            const int pn = u.pn;
#pragma unroll
            for (int ai = 0; ai < 2; ++ai)
#pragma unroll
                for (int m = 0; m < 4; ++m) {
                    const int row = row0 + ai * HALF + m * 16;
#pragma unroll
                    for (int bj = 0; bj < 2; ++bj) {
                        const int tc = bj * HALF + cb;
                        f32x4 v0 = acc[ai][bj][m][0], v1 = acc[ai][bj][m][1];
                        if (pn < 6) {
                            const u32x4 w = pack8(v0, v1);
                            *(u32x4*)(qkva + (size_t)row * 1536 + pn * 256 + tc) = w;
                            if ((row & 63) >= 61) *(u32x4*)(halo + ((size_t)(row >> 6) * 3 + ((row & 63) - 61)) * 1536 + pn * 256 + tc) = w;
                        } else if (pn < 8) {
#pragma unroll
                            for (int i = 0; i < 4; ++i) { v0[i] = siluf_(v0[i]); v1[i] = siluf_(v1[i]); }
                            *(u32x4*)(zs + (size_t)row * 512 + (pn - 6) * 256 + tc) = pack8(v0, v1);
                        } else if (pn < 16) {
                            const bool rope_tile = (pn < 12) || (pn >= 14);
                            if (rope_tile && !(wc & 1)) {
                                f32x4 p0, p1;
#pragma unroll
                                for (int i = 0; i < 4; ++i) { p0[i] = __shfl_xor(v0[i], 16); p1[i] = __shfl_xor(v1[i], 16); }
                                if (fq < 2) {
                                    const float* rp = rope + (size_t)(row & (SEQ - 1)) * 16;
                                    const f32x4 c0 = *(const f32x4*)rp, c1 = *(const f32x4*)(rp + 4), s0 = *(const f32x4*)(rp + 8), s1 = *(const f32x4*)(rp + 12);
                                    const float sg = fq == 0 ? -1.f : 1.f;
#pragma unroll
                                    for (int i = 0; i < 4; ++i) { v0[i] = v0[i] * c0[i] + sg * p0[i] * s0[i]; v1[i] = v1[i] * c1[i] + sg * p1[i] * s1[i]; }
                                }
                            }
                            if (pn < 10) { v0 = v0 * 0.125f; v1 = v1 * 0.125f; }
                            h16* dst = pn < 14 ? qkvb + (size_t)row * 1536 + (pn - 8) * 256 + tc : qi + (size_t)row * 512 + (pn - 14) * 256 + tc;
                            *(u32x4*)dst = pack8(v0, v1);
                        } else if (pn < 24) {
#pragma unroll
                            for (int i = 0; i < 4; ++i) { v0[i] = sigmoidf_(v0[i]); v1[i] = sigmoidf_(v1[i]); }
                            *(u32x4*)(gates + (size_t)row * 2048 + (pn - 16) * 256 + tc) = pack8(v0, v1);
                        } else if (bj == 0) {
                            float* mp = misc + (size_t)row * 96;
                            if (wc < 2) { *(f32x4*)(mp + tc) = v0; *(f32x4*)(mp + tc + 4) = v1; }
                            else if (wc == 2 && fq < 3) {
                                float r[8] = {v0[0], v0[1], v0[2], v0[3], v1[0], v1[1], v1[2], v1[3]};
                                if (fq == 2) {
#pragma unroll
                                    for (int i = 0; i < 8; ++i) r[i] *= 0.04419417382415922f;
                                }
                                *(f32x4*)(mp + 64 + 8 * fq) = (f32x4){r[0], r[1], r[2], r[3]}; *(f32x4*)(mp + 68 + 8 * fq) = (f32x4){r[4], r[5], r[6], r[7]};
                            }
                        }
                    }
                }
        }
    }
};

__device__ __forceinline__ void gemm_phase(LAS unsigned char* lds, const Gemm g, const StaticOrder& S, const Epi& E, const int tid) {
    const int wid = __builtin_amdgcn_readfirstlane(tid >> 6), lane = tid & 63, wr = wid >> 2, wc = wid & 3, fr = lane & 15, fq = lane >> 4;
    const int K = g.K, nt = K / BK, lda = g.lda;
    unsigned voffA[2], voffB[2];
#pragma unroll
    for (int i = 0; i < 2; ++i) { int R, C; stage_rc(tid * 16 + i * 8192, R, C); const int Rb = (R & ~31) + perm32(R & 31);
        voffA[i] = (unsigned)(R * lda + C) * 2u; voffB[i] = (unsigned)(Rb * K + C) * 2u; }
    const size_t kstep = (size_t)(BK * 2);
    const size_t hstepA = (size_t)HALF * lda * 2, hstepB = (size_t)HALF * K * 2;
    const size_t tstepA = 2 * hstepA, tstepB = 2 * hstepB;
    const unsigned ldsw = (unsigned)wid * 1024u;
    const int aoff = lds_byte(wr * 64 + fr, fq * 8), boff = lds_byte(wc * 32 + fr, fq * 8);
#define PG8_SA(b, h) (((b) * 2 + (h)) * HTB)
#define PG8_SB(b, h) ((4 + (b) * 2 + (h)) * HTB)
#define PG8_STAGE(bufoff, gbase, voff) do { _Pragma("unroll") for (int _i = 0; _i < 2; ++_i) \
        __builtin_amdgcn_global_load_lds((const unsigned*)((const char*)(gbase) + (voff)[_i]), (LAS unsigned*)(lds + (bufoff) + ldsw + _i * 8192), 16, 0, 0); } while (0)
#define PG8_LDA(dst, b, h) do { _Pragma("unroll") for (int m = 0; m < 4; ++m) _Pragma("unroll") for (int k = 0; k < 2; ++k) dst[m][k] = *(const LAS s16x8*)(lds + PG8_SA(b, h) + aoff + m * 2048 + k * 1024); } while (0)
#define PG8_LDB(dst, b, h) do { _Pragma("unroll") for (int n = 0; n < 2; ++n) _Pragma("unroll") for (int k = 0; k < 2; ++k) dst[n][k] = *(const LAS s16x8*)(lds + PG8_SB(b, h) + boff + n * 2048 + k * 1024); } while (0)
#define PG8_MMA(ai, bj, At, Bt) do { __builtin_amdgcn_s_setprio(1); _Pragma("unroll") for (int m = 0; m < 4; ++m) _Pragma("unroll") for (int n = 0; n < 2; ++n) _Pragma("unroll") for (int k = 0; k < 2; ++k) \
        acc[ai][bj][m][n] = __builtin_amdgcn_mfma_f32_16x16x32_f16(__builtin_bit_cast(h16x8, Bt[n][k]), __builtin_bit_cast(h16x8, At[m][k]), acc[ai][bj][m][n], 0, 0, 0); __builtin_amdgcn_s_setprio(0); } while (0)
#define PG8_WAIT_V(n) asm volatile("s_waitcnt vmcnt(" #n ")" ::: "memory")
#define PG8_WAIT_L(n) asm volatile("s_waitcnt lgkmcnt(" #n ")" ::: "memory")
#define PG8_BAR __builtin_amdgcn_s_barrier()
#define PG8_SCHED __builtin_amdgcn_sched_barrier(0)
    Unit cur, nxt; int ui = 0;
    if (!S.next(0, cur)) return;
    f32x4 acc[2][2][4][2];
#pragma unroll
    for (int a = 0; a < 2; ++a)
#pragma unroll
        for (int b = 0; b < 2; ++b)
#pragma unroll
            for (int m = 0; m < 4; ++m)
#pragma unroll
                for (int n = 0; n < 2; ++n) acc[a][b][m][n] = (f32x4){0.f, 0.f, 0.f, 0.f};
    s16x8 At[4][2], B0[2][2], B1[2][2];
    const char* cA = (const char*)g.A + (size_t)cur.pm * tstepA; const char* cB = (const char*)g.Bt + (size_t)cur.pn * tstepB;
    PG8_STAGE(PG8_SB(0, 0), cB, voffB); PG8_STAGE(PG8_SB(0, 1), cB + hstepB, voffB); PG8_STAGE(PG8_SA(0, 0), cA, voffA); PG8_STAGE(PG8_SA(0, 1), cA + hstepA, voffA);
    if (wr == 1) PG8_BAR;
    PG8_WAIT_V(2); PG8_BAR;
    PG8_STAGE(PG8_SB(1, 0), cB + kstep, voffB); PG8_STAGE(PG8_SA(1, 0), cA + kstep, voffA); PG8_STAGE(PG8_SB(1, 1), cB + hstepB + kstep, voffB);
    PG8_WAIT_V(6); PG8_BAR;
    for (;;) {
        const bool has_next = S.next(ui + 1, nxt);
        const char* nA = has_next ? (const char*)g.A + (size_t)nxt.pm * tstepA : cA; const char* nB = has_next ? (const char*)g.Bt + (size_t)nxt.pn * tstepB : cB;
        for (int t = 0; t < nt; t += 2) {
            const bool last = (t == nt - 2);
            const char* a1 = cA + (size_t)(t + 1) * kstep;
            const char* a2 = last ? nA : cA + (size_t)(t + 2) * kstep; const char* b2 = last ? nB : cB + (size_t)(t + 2) * kstep;
            const char* a3 = a2 + kstep; const char* b3 = b2 + kstep;
            PG8_LDB(B0, 0, 0); PG8_LDB(B1, 0, 1); PG8_SCHED; PG8_LDA(At, 0, 0); PG8_STAGE(PG8_SA(1, 1), a1 + hstepA, voffA);
            PG8_WAIT_V(8); PG8_WAIT_L(0); PG8_BAR; PG8_MMA(0, 0, At, B0); PG8_MMA(0, 1, At, B1); PG8_BAR; PG8_SCHED;
            PG8_LDA(At, 0, 1); PG8_STAGE(PG8_SB(0, 0), b2, voffB); PG8_STAGE(PG8_SB(0, 1), b2 + hstepB, voffB); PG8_STAGE(PG8_SA(0, 0), a2, voffA);
            PG8_WAIT_V(8); PG8_WAIT_L(0); PG8_BAR; PG8_MMA(1, 0, At, B0); PG8_MMA(1, 1, At, B1); PG8_BAR; PG8_SCHED;
            PG8_LDB(B0, 1, 0); PG8_LDB(B1, 1, 1); PG8_SCHED; PG8_LDA(At, 1, 0); PG8_STAGE(PG8_SA(0, 1), a2 + hstepA, voffA);
            PG8_WAIT_V(8); PG8_WAIT_L(0); PG8_BAR; PG8_MMA(0, 0, At, B0); PG8_MMA(0, 1, At, B1); PG8_BAR; PG8_SCHED;
            PG8_LDA(At, 1, 1); PG8_STAGE(PG8_SB(1, 0), b3, voffB); PG8_STAGE(PG8_SB(1, 1), b3 + hstepB, voffB); PG8_STAGE(PG8_SA(1, 0), a3, voffA);
            PG8_WAIT_V(8); PG8_WAIT_L(0); PG8_BAR; PG8_MMA(1, 0, At, B0); PG8_MMA(1, 1, At, B1); PG8_BAR; PG8_SCHED;
        }
        if (wr == 0) PG8_BAR;
        E(acc, cur, wr, wc, fr, fq);
        if (!has_next) break;
#pragma unroll
        for (int a = 0; a < 2; ++a)
#pragma unroll
            for (int b = 0; b < 2; ++b)
#pragma unroll
                for (int m = 0; m < 4; ++m)
#pragma unroll
                    for (int n = 0; n < 2; ++n) acc[a][b][m][n] = (f32x4){0.f, 0.f, 0.f, 0.f};
        cur = nxt; cA = nA; cB = nB; ++ui;
        if (wr == 1) PG8_BAR;
    }
    PG8_WAIT_V(0);
    PG8_BAR;
#undef PG8_SA
#undef PG8_SB
#undef PG8_STAGE
#undef PG8_LDA
#undef PG8_LDB
#undef PG8_MMA
#undef PG8_WAIT_V
#undef PG8_WAIT_L
#undef PG8_BAR
#undef PG8_SCHED
}
}


#define XB_TMO      128
#define XB_XCNT(j)  (256  + 64 * (j))
#define XB_XSUB(j)  (1280 + 64 * (j))
#define XB_XGEN(j)  (2304 + 64 * (j))
#define XB_TOP      3328
#define XB_TOPGEN   3392
#define XCD_BAR_WORDS 3456
#define XB_SPIN_CAP (1u << 18)
__device__ __forceinline__ unsigned xb_ld(unsigned* p)              { return __hip_atomic_load(p, __ATOMIC_RELAXED, __HIP_MEMORY_SCOPE_AGENT); }
__device__ __forceinline__ unsigned xb_add(unsigned* p, unsigned v) { return __hip_atomic_fetch_add(p, v, __ATOMIC_RELAXED, __HIP_MEMORY_SCOPE_AGENT); }
__device__ __forceinline__ unsigned xb_xcc_id() { return (unsigned)__builtin_amdgcn_s_getreg((3 << 11) | 20) & 0xFu; }
#define XB_SPIN(cond, bar) do { unsigned _sp = 0; while (cond) { __builtin_amdgcn_s_sleep(1); \
    if ((++_sp & 255u) == 0u) { if (xb_ld(&(bar)[XB_TMO])) break; if (_sp > XB_SPIN_CAP) { atomicAdd(&(bar)[XB_TMO], 1u); break; } } } } while (0)
struct XcdBarrier { unsigned* bar; unsigned x; volatile LAS unsigned* st; };
__device__ __forceinline__ XcdBarrier xcd_barrier_post(unsigned* bar, volatile LAS unsigned* st) {
    XcdBarrier b; b.bar = bar; b.x = xb_xcc_id(); b.st = st;
    if (threadIdx.x == 0) (void)xb_add(&bar[XB_XCNT(b.x)], 1u);
    return b;
}
__device__ __forceinline__ void xcd_barrier_complete(unsigned* bar, unsigned x, unsigned& nloc, unsigned& nx) {
    const unsigned G = gridDim.x * gridDim.y * gridDim.z;
    unsigned sum, cnt, mine, sp = 0u;
    for (;;) {
        sum = 0u; cnt = 0u; mine = 0u;
#pragma unroll
        for (unsigned j = 0; j < 16; ++j) { const unsigned c = xb_ld(&bar[XB_XCNT(j)]); sum += c; cnt += (c > 0u) ? 1u : 0u; mine = (j == x) ? c : mine; }
        if (sum == G) break;
        __builtin_amdgcn_s_sleep(1);
        if ((++sp & 255u) == 0u) { if (xb_ld(&bar[XB_TMO])) break; if (sp > XB_SPIN_CAP) { atomicAdd(&bar[XB_TMO], 1u); break; } }
    }
    nloc = mine > 0u ? mine : 1u; nx = cnt > 0u ? cnt : 1u;
}
__device__ __forceinline__ void xcd_barrier(const XcdBarrier& b) {
    asm volatile("s_waitcnt vmcnt(0)" ::: "memory");
    __syncthreads();
    if (threadIdx.x == 0) {
        unsigned* bar = b.bar;
        __builtin_amdgcn_s_waitcnt(0);
        unsigned nloc = b.st[0], nx = b.st[1];
        if (nloc == 0u) { xcd_barrier_complete(bar, b.x, nloc, nx); b.st[0] = nloc; b.st[1] = nx; }
        const unsigned old = xb_add(&bar[XB_XSUB(b.x)], 1u);
        const unsigned gen = old / nloc;
        if (old + 1u == (gen + 1u) * nloc) {
            __builtin_amdgcn_fence(__ATOMIC_RELEASE, "agent");
            asm volatile("s_waitcnt vmcnt(0)" ::: "memory");
            const unsigned og = xb_add(&bar[XB_TOP], 1u);
            const unsigned tg = og / nx;
            if (og + 1u == (tg + 1u) * nx) xb_add(&bar[XB_TOPGEN], 1u);
            else XB_SPIN(xb_ld(&bar[XB_TOPGEN]) == tg, bar);
            __builtin_amdgcn_fence(__ATOMIC_ACQUIRE, "agent");
            xb_add(&bar[XB_XGEN(b.x)], 1u);
            asm volatile("s_waitcnt vmcnt(0)" ::: "memory");
        } else {
            XB_SPIN(xb_ld(&bar[XB_XGEN(b.x)]) == gen, bar);
            __builtin_amdgcn_fence(__ATOMIC_ACQUIRE, "agent");
            asm volatile("s_waitcnt vmcnt(0)" ::: "memory");
        }
    }
    __syncthreads();
}

struct Args { const float* in[25]; float* out; unsigned char* ws; int ph_lo, ph_hi; };
enum { I_X = 0, I_P, I_F1PRE, I_F1POST, I_F1WIN, I_F1WOUT, I_MPRE, I_MPOST, I_MWIN, I_CONVW, I_ALOG, I_DTB, I_DNG, I_IDXG, I_WBA, I_WBB, I_MWOUT,
       I_F2PRE, I_F2POST, I_F2WIN, I_F2WOUT, I_PPRE, I_PPOST, I_PWG, I_PWP };

__device__ __forceinline__ int srccol(int map, int n) {
    if (map == 0) return n;
    if (map == 1) { const int pn = n >> 8, tc = n & 255; return tc < 128 ? pn * 128 + tc : FF + pn * 128 + (tc - 128); }
    if (n < 2048) return n;
    if (n < 4096) return 2064 + (n - 2048);
    if (n < 6144) return 4184 + (n - 4096);
    const int tc = n - 6144;
    if (tc < 64) return 4112 + tc;
    if (tc < 72) return 2048 + (tc - 64);
    if (tc < 80) return 2056 + (tc - 72);
    if (tc < 88) return 4176 + (tc - 80);
    return -1;
}
__device__ __forceinline__ void transpose_item(const float* W, int K, int N, h16* WT, int NP, int map, float* scr, int item, int lane) {
    const int nblk = NP / 32, kb = item / nblk, nb = item % nblk, k0 = 64 * kb, n0 = 32 * nb;
    const int sc = srccol(map, n0 + (lane & 31));
#pragma unroll 8
    for (int i = 0; i < 32; ++i) { const int kk = 2 * i + (lane >> 5); scr[kk * 33 + (lane & 31)] = sc >= 0 ? W[(size_t)(k0 + kk) * N + sc] : 0.f; }
    LDS_WAIT();
    const int c = lane & 7;
#pragma unroll
    for (int j = 0; j < 4; ++j) { const int n = (lane >> 3) + 8 * j; const float* s = scr + (8 * c) * 33 + n;
        f32x4 a = {s[0], s[33], s[66], s[99]}, b = {s[132], s[165], s[198], s[231]};
        *(u32x4*)(WT + (size_t)(n0 + n) * K + k0 + 8 * c) = pack8(a, b); }
    LDS_WAIT();
}

__device__ __forceinline__ void load_row_f32(const float* p, int lane, f32x4 (&v)[4]) {
#pragma unroll
    for (int j = 0; j < 4; ++j) v[j] = *(const f32x4*)(p + 4 * lane + 256 * j);
}
__device__ __forceinline__ void load_row_h16(const h16* p, int lane, f32x4 (&v)[4]) {
#pragma unroll
    for (int j = 0; j < 4; ++j) { const h16x4 h = *(const h16x4*)(p + 4 * lane + 256 * j); v[j] = (f32x4){(float)h[0], (float)h[1], (float)h[2], (float)h[3]}; }
}
__device__ __forceinline__ float row_rms_scale(const f32x4 (&v)[4]) {
    float s = 0.f;
#pragma unroll
    for (int j = 0; j < 4; ++j) s += (v[j][0] * v[j][0] + v[j][1] * v[j][1]) + (v[j][2] * v[j][2] + v[j][3] * v[j][3]);
    return rsqrtf(wave_sum_dpp(s) * (1.0f / D) + EPS);
}
template <bool BASE_F32, bool FINAL>
__device__ __forceinline__ void resid_norm_phase(const float* xbase, h16* H, const h16* Y, float coef, const float* g_post, const float* g_pre, h16* XN, float* outp, int gw, int ngw, int lane) {
    for (int row = gw; row < T; row += 2 * ngw) {
        f32x4 y[2][4], b[2][4];
#pragma unroll
        for (int u = 0; u < 2; ++u) {
            const size_t ro = (size_t)(row + u * ngw) * D;
            load_row_h16(Y + ro, lane, y[u]);
            if (BASE_F32) load_row_f32(xbase + ro, lane, b[u]); else load_row_h16(H + ro, lane, b[u]);
        }
        f32x4 gp[4]; load_row_f32(g_post, lane, gp);
#pragma unroll
        for (int u = 0; u < 2; ++u) {
            const float r = row_rms_scale(y[u]) * coef;
#pragma unroll
            for (int j = 0; j < 4; ++j) b[u][j] = b[u][j] + y[u][j] * r * gp[j];
        }
        if (FINAL) {
#pragma unroll
            for (int u = 0; u < 2; ++u)
#pragma unroll
                for (int j = 0; j < 4; ++j) *(f32x4*)(outp + (size_t)(row + u * ngw) * D + 4 * lane + 256 * j) = b[u][j];
        } else {
            f32x4 g2[4]; load_row_f32(g_pre, lane, g2);
#pragma unroll
            for (int u = 0; u < 2; ++u) {
                const float r2 = row_rms_scale(b[u]);
                const size_t ro = (size_t)(row + u * ngw) * D;
#pragma unroll
                for (int j = 0; j < 4; ++j) {
                    *(u32x2*)(H + ro + 4 * lane + 256 * j) = pack4(b[u][j]);
                    *(u32x2*)(XN + ro + 4 * lane + 256 * j) = pack4(b[u][j] * r2 * g2[j]);
                }
            }
        }
    }
}

__global__ void __launch_bounds__(NTHREADS, 2) fwd_kernel(Args args) {
    extern __shared__ __attribute__((aligned(16))) unsigned char lds[];
    cg::grid_group grid = cg::this_grid();
    const int G = gridDim.x, bid = blockIdx.x;
    volatile LAS unsigned* xb_st = (volatile LAS unsigned*)((LAS unsigned char*)lds + 153616);
    if (threadIdx.x == 0) { xb_st[0] = 0u; xb_st[1] = 0u; }
    __syncthreads();
    unsigned* xb_words = (unsigned*)(args.ws + 16384);
    XcdBarrier xbar = xcd_barrier_post(xb_words, xb_st);
#ifdef DUP_PHASE
    bool dup_done = false;
#endif
    for (int ph = args.ph_lo; ph < args.ph_hi; ++ph) {
#ifdef PROBE_MASK
    unsigned long long probe_t0 = __builtin_amdgcn_s_memrealtime();
#endif
    int tid = threadIdx.x; asm volatile("" : "+v"(tid));
    __attribute__((address_space(1))) unsigned char* wsg_ = (__attribute__((address_space(1))) unsigned char*)args.ws; asm volatile("" : "+s"(wsg_));
    __attribute__((address_space(1))) float* outg_ = (__attribute__((address_space(1))) float*)args.out; asm volatile("" : "+s"(outg_));
    unsigned char* ws = (unsigned char*)wsg_;
    float* outp_ = (float*)outg_;
    const int lane = tid & 63, wave = __builtin_amdgcn_readfirstlane(tid >> 6);
    const int gw = bid * NWAVES + wave, ngw = G * NWAVES;
    float* ROPE = (float*)(ws + WS_ROPE);
    h16 *W1 = (h16*)(ws + WS_W1), *W2 = (h16*)(ws + WS_W2), *WM = (h16*)(ws + WS_WM), *WBA = (h16*)(ws + WS_WBA), *WBB = (h16*)(ws + WS_WBB), *WO = (h16*)(ws + WS_WO);
    h16 *W3 = (h16*)(ws + WS_W3), *W4 = (h16*)(ws + WS_W4), *WG = (h16*)(ws + WS_WG), *WP = (h16*)(ws + WS_WP);
    h16 *P16 = (h16*)(ws + WS_P16), *XN = (h16*)(ws + WS_XN), *H16 = (h16*)(ws + WS_H16), *HID = (h16*)(ws + WS_HID), *TMP = (h16*)(ws + WS_TMP);
    h16 *QKVA = (h16*)(ws + WS_QKVA), *ZS = (h16*)(ws + WS_ZS), *QKVB = (h16*)(ws + WS_QKVB), *QI = (h16*)(ws + WS_QI), *HALO = (h16*)(ws + WS_HALO), *KI = (h16*)(ws + WS_KI);
    float* MISC = (float*)(ws + WS_MISC);
    unsigned long long* MASK = (unsigned long long*)(ws + WS_MASK);
    const h16* Y = (const h16*)outp_;
    h16* GATES = (h16*)outp_;

        pg8::Gemm g{nullptr, nullptr, T, 0, 0, 0};
        pg8::Epi E; E.mode = -1; E.ws = ws; E.outp = outp_;
        switch (ph) {
        case 0: {
            float* scr = (float*)lds + wave * (64 * 33);
            constexpr int I1 = 16 * (5632 / 32), I2 = 44 * 32, IM = 16 * (NMIX / 32), IB = 8 * 32, IO = 16 * 32, IP = 4 * 32;
            constexpr int NIT = 2 * I1 + 2 * I2 + IM + 2 * IB + 2 * IO + IP;
            for (int it = gw; it < NIT; it += ngw) {
                int r = it;
                if (r < I1) { transpose_item(args.in[I_F1WIN], D, 2 * FF, W1, 2 * FF, 1, scr, r, lane); continue; } r -= I1;
                if (r < I1) { transpose_item(args.in[I_F2WIN], D, 2 * FF, W3, 2 * FF, 1, scr, r, lane); continue; } r -= I1;
                if (r < I2) { transpose_item(args.in[I_F1WOUT], FF, D, W2, D, 0, scr, r, lane); continue; } r -= I2;
                if (r < I2) { transpose_item(args.in[I_F2WOUT], FF, D, W4, D, 0, scr, r, lane); continue; } r -= I2;
                if (r < IM) { transpose_item(args.in[I_MWIN], D, 6232, WM, NMIX, 2, scr, r, lane); continue; } r -= IM;
                if (r < IB) { transpose_item(args.in[I_WBA], 512, D, WBA, D, 0, scr, r, lane); continue; } r -= IB;
                if (r < IB) { transpose_item(args.in[I_WBB], 512, D, WBB, D, 0, scr, r, lane); continue; } r -= IB;
                if (r < IO) { transpose_item(args.in[I_MWOUT], D, D, WO, D, 0, scr, r, lane); continue; } r -= IO;
                if (r < IO) { transpose_item(args.in[I_PWG], D, D, WG, D, 0, scr, r, lane); continue; } r -= IO;
                transpose_item(args.in[I_PWP], PLE, D, WP, D, 0, scr, r, lane);
            }
            { const float* p = args.in[I_P]; const size_t n8 = (size_t)T * PLE / 8;
              for (size_t i = (size_t)bid * NTHREADS + tid; i < n8; i += (size_t)G * NTHREADS) { const f32x4 a = *(const f32x4*)(p + 8 * i), b = *(const f32x4*)(p + 8 * i + 4); *(u32x4*)(P16 + 8 * i) = pack8(a, b); } }
            for (int i = bid * NTHREADS + tid; i < SEQ * 8; i += G * NTHREADS) {
                const int pos = i >> 3, f = i & 7;
                const float invt[8] = {1.0f, 0.1939227432012558f, 0.03760603070259094f, 0.007292664609849453f, 0.0014142135623842478f, 0.00027424818836152554f, 5.3182957344688475e-05f, 1.0313385246263351e-05f};
                float inv = invt[0];
#pragma unroll
                for (int q = 1; q < 8; ++q) inv = (f == q) ? invt[q] : inv;
                const float ang = (float)pos * inv;
                ROPE[pos * 16 + f] = cosf(ang); ROPE[pos * 16 + 8 + f] = sinf(ang);
            }
            { const float* x = args.in[I_X]; const float* gp = args.in[I_F1PRE];
              for (int row = gw; row < T; row += ngw) { f32x4 v[4], gg[4]; load_row_f32(x + (size_t)row * D, lane, v); load_row_f32(gp, lane, gg); const float r = row_rms_scale(v);
#pragma unroll
                  for (int j = 0; j < 4; ++j) *(u32x2*)(XN + (size_t)row * D + 4 * lane + 256 * j) = pack4(v[j] * r * gg[j]); } }
        } break;
        case 1: g = pg8::Gemm{XN, W1, T, 2 * FF, D, D}; E.mode = pg8::EPI_SWIGLU; break;
        case 2: g = pg8::Gemm{HID, W2, T, D, FF, FF}; E.mode = pg8::EPI_F32; break;
        case 3: resid_norm_phase<true, false>(args.in[I_X], H16, Y, 0.5f, args.in[I_F1POST], args.in[I_MPRE], XN, nullptr, gw, ngw, lane); break;
        case 4: g = pg8::Gemm{XN, WM, T, NMIX, D, D}; E.mode = pg8::EPI_MIX; break;
        case 5: {
            const float* cw = args.in[I_CONVW];
            for (int unit = gw; unit < 512 * 3; unit += ngw) {
                const int c = unit / 3, sidx = unit % 3, ch0 = sidx * 512 + 8 * lane;
                float w[4][8];
#pragma unroll
                for (int k = 0; k < 4; ++k) { const f32x4 a = *(const f32x4*)(cw + k * 1536 + ch0), b2 = *(const f32x4*)(cw + k * 1536 + ch0 + 4);
#pragma unroll
                    for (int i = 0; i < 4; ++i) { w[k][i] = a[i]; w[k][4 + i] = b2[i]; } }
                float x3[8], x2[8], x1[8];
#pragma unroll
                for (int i = 0; i < 8; ++i) { x3[i] = 0.f; x2[i] = 0.f; x1[i] = 0.f; }
                if (c & 63) { const h16* hp = HALO + (size_t)(c - 1) * 3 * 1536 + ch0; unpack8(*(const u32x4*)hp, x3); unpack8(*(const u32x4*)(hp + 1536), x2); unpack8(*(const u32x4*)(hp + 2 * 1536), x1); }
                h16* base = QKVA + (size_t)c * 64 * 1536 + ch0;
#pragma unroll 1
                for (int r0 = 0; r0 < 64; r0 += 8) {
                    u32x4 raw[8];
#pragma unroll
                    for (int r = 0; r < 8; ++r) raw[r] = *(const u32x4*)(base + (size_t)(r0 + r) * 1536);
#pragma unroll
                    for (int r = 0; r < 8; ++r) {
                        float x0[8], y[8]; unpack8(raw[r], x0);
                        float ss = 0.f;
#pragma unroll
                        for (int i = 0; i < 8; ++i) { y[i] = siluf_(w[0][i] * x3[i] + w[1][i] * x2[i] + w[2][i] * x1[i] + w[3][i] * x0[i]); ss += y[i] * y[i]; x3[i] = x2[i]; x2[i] = x1[i]; x1[i] = x0[i]; }
                        if (sidx < 2) { ss += __shfl_xor(ss, 1); ss += __shfl_xor(ss, 2); ss += __shfl_xor(ss, 4); const float sc_ = rsqrtf(ss + EPS) * (sidx == 0 ? 0.125f : 1.0f);
#pragma unroll
                            for (int i = 0; i < 8; ++i) y[i] *= sc_; }
                        *(u32x4*)(base + (size_t)(r0 + r) * 1536) = pack8((f32x4){y[0], y[1], y[2], y[3]}, (f32x4){y[4], y[5], y[6], y[7]});
                    }
                }
            }
            { h16* VT = (h16*)(ws + WS_XN);
              h16* tl = (h16*)lds + wave * (64 * 66);
              for (int unit = gw; unit < 64 * 64; unit += ngw) {
                  const int bh = unit >> 6, tt = unit & 63, b = bh >> 3, h = bh & 7;
                  const h16* src = QKVB + ((size_t)b * SEQ + tt * 64 + (lane >> 3)) * 1536 + 1024 + h * 64 + 8 * (lane & 7);
#pragma unroll
                  for (int i = 0; i < 8; ++i) { const h16x8 v = *(const h16x8*)(src + (size_t)(8 * i) * 1536); h16* d = tl + ((lane >> 3) + 8 * i) * 66 + 8 * (lane & 7);
#pragma unroll
                      for (int j = 0; j < 8; j += 2) *(unsigned*)(d + j) = __builtin_bit_cast(unsigned, (__attribute__((ext_vector_type(2))) _Float16){v[j], v[j + 1]}); }
                  LDS_WAIT();
                  h16* dst = VT + ((size_t)bh * 64 + lane) * SEQ + tt * 64;
#pragma unroll
                  for (int c8 = 0; c8 < 8; ++c8) { h16x8 v;
#pragma unroll
                      for (int i = 0; i < 8; ++i) v[i] = tl[(8 * c8 + i) * 66 + lane];
                      *(h16x8*)(dst + 8 * c8) = v; }
                  LDS_WAIT();
              } }
            const float* ig = args.in[I_IDXG];
            for (int row = gw; row < T; row += ngw) {
                float v = MISC[(size_t)row * 96 + lane];
                const float ss = wave_sum(v * v);
                v = v * rsqrtf(ss * (1.0f / 64.0f) + EPS) * ig[lane];
                const float pr = __shfl_xor(v, 8);
                if (lane < 16) { const float* rp = ROPE + (size_t)(row & (SEQ - 1)) * 16; const float c = rp[lane & 7], s = rp[8 + (lane & 7)]; v = lane < 8 ? v * c - pr * s : v * c + pr * s; }
                KI[(size_t)(row >> 5) * 2048 + (lane >> 4) * 512 + ((((lane >> 3) & 1) * 32 + (row & 31)) * 8) + (lane & 7)] = (h16)v;
            }
        } break;
        case 6: {
            typedef float f32x16 __attribute__((ext_vector_type(16)));
            unsigned* sc = (unsigned*)lds;
            const int r32 = lane & 31, hi = lane >> 5;
            u32x4 qnext = {0u, 0u, 0u, 0u}; float wv[2][2][8];
#define IDX_FETCH(kk) do { const int b_ = (kk) & 7, row0_ = b_ * SEQ + (511 - ((kk) >> 3)) * 8; const int R_ = tid >> 3, cq_ = tid & 7; \
                qnext = *(const u32x4*)(QI + (size_t)(row0_ + (R_ >> 3)) * 512 + (R_ & 7) * 64 + 8 * cq_); \
                _Pragma("unroll") for (int mt = 0; mt < 2; ++mt) _Pragma("unroll") for (int qq = 0; qq < 2; ++qq) { const float* wp = MISC + (size_t)(row0_ + 4 * mt + 2 * hi + qq) * 96 + 80; const f32x4 a = *(const f32x4*)wp, c = *(const f32x4*)(wp + 4); \
                    wv[mt][qq][0] = a[0]; wv[mt][qq][1] = a[1]; wv[mt][qq][2] = a[2]; wv[mt][qq][3] = a[3]; wv[mt][qq][4] = c[0]; wv[mt][qq][5] = c[1]; wv[mt][qq][6] = c[2]; wv[mt][qq][7] = c[3]; } } while (0)
#define IDX_STAGE_Q() do { const int R = tid >> 3, cq = tid & 7; *(u32x4*)(lds + 131072 + R * 128 + ((cq ^ (R & 7)) * 16)) = qnext; } while (0)
            IDX_FETCH(bid);
            IDX_STAGE_Q();
            __syncthreads();
            for (int k = bid; k < T / 8; k += G) {
                const int b = k & 7, t0 = (511 - (k >> 3)) * 8, row0 = b * SEQ + t0;
                const int g_ = r32 >> 3, hi_ = (r32 >> 2) & 1, head_ = 4 * (g_ & 1) + (r32 & 3);
                const unsigned char* qrow0 = lds + 131072 + ((2 * hi_ + (g_ >> 1)) * 8 + head_) * 128;
                const int nkt = 2 * ((t0 + 8 + 63) >> 6);
                {
                    const h16* kp0 = KI + (size_t)b * SEQ * 64 + lane * 8;
                    h16x8 kb[4];
#pragma unroll
                    for (int ks = 0; ks < 4; ++ks) kb[ks] = (h16x8){0, 0, 0, 0, 0, 0, 0, 0};
                    if (wave < nkt) {
#pragma unroll
                        for (int ks = 0; ks < 4; ++ks) kb[ks] = *(const h16x8*)(kp0 + (size_t)wave * 2048 + 512 * ks);
                    }
                    h16x8 qa[2][4];
#pragma unroll
                    for (int mt = 0; mt < 2; ++mt)
#pragma unroll
                        for (int ks = 0; ks < 4; ++ks) qa[mt][ks] = *(const h16x8*)(qrow0 + mt * 4096 + (((2 * ks + hi) ^ head_) * 16));
                    for (int kt = wave; kt < nkt; kt += NWAVES) {
                        h16x8 kn[4];
#pragma unroll
                        for (int ks = 0; ks < 4; ++ks) kn[ks] = kb[ks];
                        if (kt + NWAVES < nkt) {
#pragma unroll
                            for (int ks = 0; ks < 4; ++ks) kn[ks] = *(const h16x8*)(kp0 + (size_t)(kt + NWAVES) * 2048 + 512 * ks);
                        }
                        const int key = 32 * kt + r32;
                        f32x16 acc[2];
                        acc[0] = (f32x16){0.f, 0.f, 0.f, 0.f, 0.f, 0.f, 0.f, 0.f, 0.f, 0.f, 0.f, 0.f, 0.f, 0.f, 0.f, 0.f}; acc[1] = acc[0];
#pragma unroll
                        for (int ks = 0; ks < 4; ++ks) {
                            acc[0] = __builtin_amdgcn_mfma_f32_32x32x16_f16(qa[0][ks], kb[ks], acc[0], 0, 0, 0);
                            acc[1] = __builtin_amdgcn_mfma_f32_32x32x16_f16(qa[1][ks], kb[ks], acc[1], 0, 0, 0);
                        }
#pragma unroll
                        for (int mt = 0; mt < 2; ++mt) {
#pragma unroll
                            for (int qq = 0; qq < 2; ++qq) {
                                float sv = 0.f;
#pragma unroll
                                for (int h = 0; h < 8; ++h) {
                                    const int ab = __float_as_int(acc[mt][8 * qq + h]);
                                    sv = fmaf(wv[mt][qq][h], __int_as_float(ab > 0 ? ab : 0), sv);
                                }
                                const int ql = 4 * mt + 2 * hi + qq;
                                unsigned u = __float_as_uint(sv); u = (u & 0x80000000u) ? ~u : (u | 0x80000000u);
                                sc[ql * 4096 + key] = (key <= t0 + ql) ? u : 0u;
                            }
                        }
#pragma unroll
                        for (int ks = 0; ks < 4; ++ks) kb[ks] = kn[ks];
                    }
                }
                __syncthreads();
                if (k + G < T / 8) IDX_FETCH(k + G);
                {
                    const int wave_s = __builtin_amdgcn_readfirstlane(wave);
                    const int t = t0 + wave_s, n = t + 1, nw = (n + 63) >> 6;
                    const unsigned* scq = sc + wave_s * 4096;
                    unsigned uk[64];
#pragma unroll
                    for (int i = 0; i < 64; ++i) uk[i] = (i < nw) ? scq[i * 64 + lane] : 0u;
                    unsigned thr = 1u; int need = 0; bool exact = true;
                    if (n > 256) {
                        unsigned prefix = 0u; exact = false;
                        int bit = 31, stage = 0;
#pragma unroll 1
                        for (;;) {
                            const unsigned cand = stage == 0 ? 0xBE000000u : stage == 1 ? 0xC0000000u : (prefix | (1u << bit));
                            const unsigned cm1 = cand - 1u;
                            unsigned c0_ = 0u, c1_ = 0u, c2_ = 0u, c3_ = 0u;
                            int nwl = nw; asm volatile("" : "+s"(nwl));
#define TK_CNT8(i) do { unsigned t0_, t1_, t2_, t3_, t4_, t5_, t6_, t7_; \
                                asm volatile("v_sub_u32_e64 %4, %12, %20 clamp\n\tv_sub_u32_e64 %5, %13, %20 clamp\n\tv_sub_u32_e64 %6, %14, %20 clamp\n\tv_sub_u32_e64 %7, %15, %20 clamp\n\t" \
                                             "v_sub_u32_e64 %8, %16, %20 clamp\n\tv_sub_u32_e64 %9, %17, %20 clamp\n\tv_sub_u32_e64 %10, %18, %20 clamp\n\tv_sub_u32_e64 %11, %19, %20 clamp\n\t" \
                                             "v_min_u32_e32 %4, 1, %4\n\tv_min_u32_e32 %5, 1, %5\n\tv_min_u32_e32 %6, 1, %6\n\tv_min_u32_e32 %7, 1, %7\n\t" \
                                             "v_min_u32_e32 %8, 1, %8\n\tv_min_u32_e32 %9, 1, %9\n\tv_min_u32_e32 %10, 1, %10\n\tv_min_u32_e32 %11, 1, %11\n\t" \
                                             "v_add3_u32 %0, %0, %4, %5\n\tv_add3_u32 %1, %1, %6, %7\n\tv_add3_u32 %2, %2, %8, %9\n\tv_add3_u32 %3, %3, %10, %11" \
                                             : "+v"(c0_), "+v"(c1_), "+v"(c2_), "+v"(c3_), "=&v"(t0_), "=&v"(t1_), "=&v"(t2_), "=&v"(t3_), "=&v"(t4_), "=&v"(t5_), "=&v"(t6_), "=&v"(t7_) \
                                             : "v"(uk[i]), "v"(uk[(i) + 1]), "v"(uk[(i) + 2]), "v"(uk[(i) + 3]), "v"(uk[(i) + 4]), "v"(uk[(i) + 5]), "v"(uk[(i) + 6]), "v"(uk[(i) + 7]), "s"(cm1)); } while (0)
#pragma unroll
                            for (int g8 = 0; g8 < 64; g8 += 8) if (nwl > g8) TK_CNT8(g8);
#undef TK_CNT8
                            const unsigned cl = (c0_ + c1_) + (c2_ + c3_);
                            const int cnt = wave_sum_dpp_i((int)cl);
                            if (cnt == 256) { thr = cand; exact = true; break; }
                            if (stage == 0) { stage = cnt > 256 ? 1 : 2; continue; }
                            if (stage == 1) { stage = 2; if (cnt < 256) { prefix = 0xBE000000u; bit = 24; } continue; }
                            if (cnt > 256) prefix = cand;
                            if (--bit < 0) break;
                        }
                        if (!exact) {
                            thr = prefix;
                            int cg_ = 0;
#pragma unroll
                            for (int i = 0; i < 64; ++i) cg_ += __popcll(__ballot(uk[i] > thr));
                            need = 256 - cg_;
                        }
                    }
                    unsigned long long* mrow = MASK + (size_t)b * 64 * SEQ + (t0 + wave);
                    unsigned long long mine = 0ull;
                    if (exact) {
                        int mlo = 0, mhi = 0;
#pragma unroll
                        for (int i = 0; i < 64; i += 4) if (nw > (i & ~7)) {
                            unsigned long long m0_, m1_, m2_, m3_;
                            asm volatile("v_cmp_le_u32_e64 %0, %4, %5\n\tv_cmp_le_u32_e64 %1, %4, %6\n\tv_cmp_le_u32_e64 %2, %4, %7\n\tv_cmp_le_u32_e64 %3, %4, %8"
                                         : "=&s"(m0_), "=&s"(m1_), "=&s"(m2_), "=&s"(m3_) : "s"(thr), "v"(uk[i]), "v"(uk[i + 1]), "v"(uk[i + 2]), "v"(uk[i + 3]));
                            asm volatile("s_nop 3\n\tv_writelane_b32 %0, %2, %10\n\tv_writelane_b32 %1, %3, %10\n\tv_writelane_b32 %0, %4, %11\n\tv_writelane_b32 %1, %5, %11\n\t"
                                         "v_writelane_b32 %0, %6, %12\n\tv_writelane_b32 %1, %7, %12\n\tv_writelane_b32 %0, %8, %13\n\tv_writelane_b32 %1, %9, %13"
                                         : "+v"(mlo), "+v"(mhi)
                                         : "s"((unsigned)m0_), "s"((unsigned)(m0_ >> 32)), "s"((unsigned)m1_), "s"((unsigned)(m1_ >> 32)), "s"((unsigned)m2_), "s"((unsigned)(m2_ >> 32)), "s"((unsigned)m3_), "s"((unsigned)(m3_ >> 32)),
                                           "i"(i), "i"(i + 1), "i"(i + 2), "i"(i + 3));
                        }
                        mine = ((unsigned long long)(unsigned)mhi << 32) | (unsigned)mlo;
                    } else {
                        int running = 0;
#pragma unroll
                        for (int i = 0; i < 64; ++i) {
                            const bool gt = uk[i] > thr, eq = uk[i] == thr;
                            const unsigned long long beq = __ballot(eq);
                            const int rank = running + __popcll(beq & ((1ull << lane) - 1ull));
                            const bool take = gt || (eq && rank < need);
                            running += __popcll(beq);
                            const unsigned long long mm = __ballot(take);
                            if (lane == i) mine = mm;
                        }
                    }
                    mrow[(size_t)lane * SEQ] = mine;
                }
                if (k + G < T / 8) IDX_STAGE_Q();
                __syncthreads();
            }
#undef IDX_STAGE_Q
        } break;
#undef IDX_FETCH
        case 7: {
            typedef float f32x16 __attribute__((ext_vector_type(16)));
            h16* Lw = (h16*)((float*)lds + wave * (2048 + 128));
            float* sg = (float*)lds + wave * (2048 + 128) + 2048; float* sb = sg + 64;
            h16* WB = (h16*)(ws + WS_XN + 32 * MiB); h16* KDT = (h16*)(ws + WS_QI);
            const int lane_p = lane;
            for (int unit = gw; unit < 4096; unit += ngw) {
                int lane = lane_p; asm volatile("" : "+v"(lane));
                const int r32 = lane & 31, hi = lane >> 5;
                const int c = unit >> 3, h = unit & 7; const size_t row0 = (size_t)c * 64;
                float* mg = MISC + (row0 + lane) * 96 + 64 + h;
                float gc, bt;
                {
                    const float xx_ = mg[0] + args.in[I_DTB][h];
                    const float sp = xx_ > 20.f ? xx_ : log1pf(expf(xx_));
                    gc = -expf(args.in[I_ALOG][h]) * sp;
                    bt = 1.0f / (1.0f + expf(-mg[8]));
                }
#pragma unroll
                for (int o = 1; o < 64; o <<= 1) { const float v = __shfl_up(gc, o); if (lane >= o) gc += v; }
                sg[lane] = gc; sb[lane] = bt;
                const float gc63 = __shfl(gc, 63);
                h16* qbase = QKVA + row0 * 1536 + h * 64;
                h16x8 ak[2][4], bq[2][4];
                { const h16* fp = qbase + (size_t)r32 * 1536 + 8 * hi;
#pragma unroll
                  for (int rt = 0; rt < 2; ++rt)
#pragma unroll
                      for (int ks = 0; ks < 4; ++ks) { ak[rt][ks] = *(const h16x8*)(fp + (size_t)rt * 32 * 1536 + 512 + 16 * ks); bq[rt][ks] = *(const h16x8*)(fp + (size_t)rt * 32 * 1536 + 16 * ks); } }
                LDS_WAIT();
#pragma unroll
                for (int tile = 0; tile < 3; ++tile) {
                    const int rt = tile == 0 ? 0 : 1, ct = tile == 2 ? 1 : 0;
                    f32x16 acc;
#pragma unroll
                    for (int i = 0; i < 16; ++i) acc[i] = 0.f;
#pragma unroll
                    for (int ks = 0; ks < 4; ++ks) acc = __builtin_amdgcn_mfma_f32_32x32x16_f16(ak[rt][ks], ak[ct][ks], acc, 0, 0, 0);
                    const int tp = 32 * ct + r32; const float gcol = sg[tp];
#pragma unroll
                    for (int i = 0; i < 16; ++i) { const int t = 32 * rt + (i & 3) + 8 * (i >> 2) + 4 * hi;
                        Lw[t * 64 + tp] = (h16)((t > tp) ? sb[t] * acc[i] * __expf(sg[t] - gcol) : 0.f); }
                }
                u32x2 xt[3][4];
#pragma unroll
                for (int tile = 0; tile < 3; ++tile) {
                    const int rt = tile == 2 ? 1 : 0, ct = tile == 0 ? 0 : 1;
                    f32x16 acc;
#pragma unroll
                    for (int i = 0; i < 16; ++i) acc[i] = 0.f;
#pragma unroll
                    for (int ks = 0; ks < 4; ++ks) acc = __builtin_amdgcn_mfma_f32_32x32x16_f16(ak[rt][ks], bq[ct][ks], acc, 0, 0, 0);
                    const int t = 32 * ct + r32; const float gcol = sg[t];
#pragma unroll
                    for (int g4 = 0; g4 < 4; ++g4) { f32x4 v4;
#pragma unroll
                        for (int i = 0; i < 4; ++i) { const int tp = 32 * rt + i + 8 * g4 + 4 * hi; v4[i] = (t >= tp) ? acc[4 * g4 + i] * __expf(gcol - sg[tp]) : 0.f; }
                        xt[tile][g4] = pack4(v4); }
                }
                {
                    h16* qw = qbase + (size_t)r32 * 1536 + 8 * hi;
#pragma unroll
                    for (int rt = 0; rt < 2; ++rt) { const float sc_ = __expf(sg[32 * rt + r32]);
#pragma unroll
                        for (int ks = 0; ks < 4; ++ks) { h16x8 v;
#pragma unroll
                            for (int i = 0; i < 8; ++i) v[i] = (h16)((float)bq[rt][ks][i] * sc_);
                            *(h16x8*)(qw + (size_t)rt * 32 * 1536 + 16 * ks) = v; } }
                }
                float xx[64];
                { const gh16* kp = (const gh16*)(qbase + 512 + lane);
#pragma unroll
                  for (int t = 0; t < 64; ++t) { xx[t] = (float)*kp; kp += 1536; asm volatile("" : "+v"(kp)); } }
                {
                    h16* kd = KDT + ((size_t)unit * 64 + lane) * 64;
#pragma unroll
                    for (int c8 = 0; c8 < 8; ++c8) { f32x4 a, b2;
#pragma unroll
                        for (int i = 0; i < 4; ++i) { a[i] = xx[8 * c8 + i] * __expf(gc63 - sg[8 * c8 + i]); b2[i] = xx[8 * c8 + 4 + i] * __expf(gc63 - sg[8 * c8 + 4 + i]); }
                        *(u32x4*)(kd + 8 * c8) = pack8(a, b2); }
                }
#pragma unroll
                for (int tile = 0; tile < 3; ++tile) {
                    const int rt = tile == 2 ? 1 : 0, ct = tile == 0 ? 0 : 1;
                    h16* xp = qbase + (size_t)(32 * ct + r32) * 1536 + 512 + 32 * rt + 4 * hi;
#pragma unroll
                    for (int g4 = 0; g4 < 4; ++g4) *(u32x2*)(xp + 8 * g4) = xt[tile][g4];
                }
#define FWD_SUBST(X) do { _Pragma("unroll") for (int i = 1; i < 64; ++i) { float a_ = X[i]; \
                    _Pragma("unroll") for (int j4 = 0; j4 < (i + 3) / 4; ++j4) { const h16x4 l4 = *(const h16x4*)(Lw + i * 64 + 4 * j4); \
                        _Pragma("unroll") for (int jj = 0; jj < 4; ++jj) if (4 * j4 + jj < i) a_ -= (float)l4[jj] * X[4 * j4 + jj]; } \
                    X[i] = a_; if ((i & 3) == 3) asm volatile("" ::: "memory"); } } while (0)
#pragma unroll
                for (int t = 0; t < 64; ++t) xx[t] *= sb[t] * __expf(sg[t]);
                FWD_SUBST(xx);
                { gh16* wp = (gh16*)(WB + (size_t)unit * 4096 + lane);
#pragma unroll
                  for (int t = 0; t < 64; ++t) { *wp = (h16)xx[t]; wp += 64; asm volatile("" : "+v"(wp)); } }
                { const gh16* vp = (const gh16*)(qbase + 1024 + lane);
#pragma unroll
                  for (int t = 0; t < 64; ++t) { xx[t] = (float)*vp * sb[t]; vp += 1536; asm volatile("" : "+v"(vp)); } }
                FWD_SUBST(xx);
#undef FWD_SUBST
                {
                    h16* up = qbase + (size_t)lane * 1536 + 1024;
#pragma unroll
                    for (int c8 = 0; c8 < 8; ++c8) { const f32x4 a = {xx[8 * c8], xx[8 * c8 + 1], xx[8 * c8 + 2], xx[8 * c8 + 3]}, b2 = {xx[8 * c8 + 4], xx[8 * c8 + 5], xx[8 * c8 + 6], xx[8 * c8 + 7]};
                        *(u32x4*)(up + 8 * c8) = pack8(a, b2); }
                }
                mg[0] = gc;
                LDS_WAIT();
            }
        } break;
        case 8: {
            typedef float f32x16 __attribute__((ext_vector_type(16)));
            const int r32 = lane & 31, hi = lane >> 5;
            const int srow = tid >> 3, sch = tid & 7;
            if (bid < 64) {
                constexpr int MB = 8704, BUFB = 5 * MB;
                const int b = bid >> 3, h = bid & 7;
                const h16* WB = (const h16*)(ws + WS_XN + 32 * MiB); const h16* KDT = (const h16*)(ws + WS_QI);
                if (wave < 2) {
                    __syncthreads();
                    f32x16 St[2];
#pragma unroll
                    for (int i = 0; i < 16; ++i) { St[0][i] = 0.f; St[1][i] = 0.f; }
#pragma unroll 1
                    for (int c = 0; c < 64; ++c) {
                        const int cur = c & 1;
                        const float e63 = __expf(MISC[((size_t)b * SEQ + c * 64 + 63) * 96 + 64 + h]);
                        const unsigned char* B_ = lds + cur * BUFB;
                        const int koff = 8 * hi;
                        h16x8 sf[2][2];
#pragma unroll
                        for (int rt = 0; rt < 2; ++rt)
#pragma unroll
                            for (int s2 = 0; s2 < 2; ++s2)
#pragma unroll
                                for (int j = 0; j < 8; ++j) sf[rt][s2][j] = (h16)St[rt][8 * s2 + j];
                        f32x16 P[2], O[2];
#pragma unroll
                        for (int i = 0; i < 16; ++i) { P[0][i] = 0.f; P[1][i] = 0.f; O[0][i] = 0.f; O[1][i] = 0.f; }
#define FRAG(mI, row, kel) ({ const unsigned char* fp_ = B_ + (mI) * MB + (row) * 136 + (kel) * 2 + koff; const h16x4 lo_ = *(const h16x4*)fp_, hi_ = *(const h16x4*)(fp_ + 16); \
                              (h16x8){lo_[0], lo_[1], lo_[2], lo_[3], hi_[0], hi_[1], hi_[2], hi_[3]}; })
#pragma unroll
                        for (int tt = 0; tt < 2; ++tt)
#pragma unroll
                            for (int rt = 0; rt < 2; ++rt)
#pragma unroll
                                for (int s2 = 0; s2 < 2; ++s2) {
                                    const h16x8 aw = FRAG(1, 32 * tt + r32, 32 * rt + 16 * s2), aq = FRAG(0, 32 * tt + r32, 32 * rt + 16 * s2);
                                    P[tt] = __builtin_amdgcn_mfma_f32_32x32x16_f16(aw, sf[rt][s2], P[tt], 0, 0, 0);
                                    O[tt] = __builtin_amdgcn_mfma_f32_32x32x16_f16(aq, sf[rt][s2], O[tt], 0, 0, 0);
                                }
                        f32x16 Vn[2];
#pragma unroll
                        for (int tt = 0; tt < 2; ++tt)
#pragma unroll
                            for (int g4 = 0; g4 < 4; ++g4) { const h16x4 u4 = *(const h16x4*)(B_ + 4 * MB + (32 * wave + r32) * 136 + (32 * tt + 8 * g4) * 2 + koff);
#pragma unroll
                                for (int i = 0; i < 4; ++i) Vn[tt][4 * g4 + i] = (float)u4[i] - P[tt][4 * g4 + i]; }
                        h16x8 vf[2][2];
#pragma unroll
                        for (int tt = 0; tt < 2; ++tt)
#pragma unroll
                            for (int s2 = 0; s2 < 2; ++s2)
#pragma unroll
                                for (int j = 0; j < 8; ++j) vf[tt][s2][j] = (h16)Vn[tt][8 * s2 + j];
#pragma unroll
                        for (int tt = 0; tt < 2; ++tt)
#pragma unroll
                            for (int t2 = 0; t2 <= tt; ++t2)
#pragma unroll
                                for (int s2 = 0; s2 < 2; ++s2) { const h16x8 ax = FRAG(2, 32 * tt + r32, 32 * t2 + 16 * s2); O[tt] = __builtin_amdgcn_mfma_f32_32x32x16_f16(ax, vf[t2][s2], O[tt], 0, 0, 0); }
#pragma unroll
                        for (int rt = 0; rt < 2; ++rt) {
#pragma unroll
                            for (int i = 0; i < 16; ++i) St[rt][i] *= e63;
#pragma unroll
                            for (int t2 = 0; t2 < 2; ++t2)
#pragma unroll
                                for (int s2 = 0; s2 < 2; ++s2) { const h16x8 akd = FRAG(3, 32 * rt + r32, 32 * t2 + 16 * s2); St[rt] = __builtin_amdgcn_mfma_f32_32x32x16_f16(akd, vf[t2][s2], St[rt], 0, 0, 0); }
                        }
#undef FRAG
                        h16* op = QKVA + ((size_t)b * SEQ + c * 64 + 4 * hi) * 1536 + 1024 + h * 64 + 32 * wave + r32;
#pragma unroll
                        for (int tt = 0; tt < 2; ++tt)
#pragma unroll
                            for (int i = 0; i < 16; ++i) op[(size_t)(32 * tt + (i & 3) + 8 * (i >> 2)) * 1536] = (h16)O[tt][i];
                                            __syncthreads();
                    }
                } else {
                    const int mI = wave - 2;
                    const bool slot = (mI & 1) == 0;
                    const h16* gb = slot ? QKVA + (size_t)b * SEQ * 1536 + h * 64 + (mI >> 1) * 512 : (mI == 1 ? WB : KDT) + ((size_t)(b * 64) * 8 + h) * 4096;
                    const size_t rstr = slot ? 1536 : 64, cstr = slot ? (size_t)64 * 1536 : (size_t)8 * 4096;
                    gb += (size_t)(lane >> 3) * rstr + 8 * (lane & 7);
                    unsigned char* lw = lds + (mI < 5 ? mI : 0) * MB + (lane >> 3) * 136 + (lane & 7) * 16;
                    u32x4 rA[8], rB[8], rC[8];
#define SCAN_LOAD(R, cc) do { const h16* p_ = gb + (size_t)(cc) * cstr; _Pragma("unroll") for (int i_ = 0; i_ < 8; ++i_) R[i_] = *(const u32x4*)(p_ + (size_t)(8 * i_) * rstr); } while (0)
#define SCAN_WRITE(R, bufi) do { _Pragma("unroll") for (int i_ = 0; i_ < 8; ++i_) { unsigned char* d_ = lw + (bufi) * BUFB + i_ * (8 * 136); *(u32x2*)d_ = (u32x2){R[i_][0], R[i_][1]}; *(u32x2*)(d_ + 8) = (u32x2){R[i_][2], R[i_][3]}; } } while (0)
#pragma unroll
                    for (int i_ = 0; i_ < 8; ++i_) { rA[i_] = (u32x4){0u, 0u, 0u, 0u}; rB[i_] = rA[i_]; rC[i_] = rA[i_]; }
                    if (mI < 5) { SCAN_LOAD(rA, 0); SCAN_LOAD(rB, 1); SCAN_LOAD(rC, 2); SCAN_WRITE(rA, 0); SCAN_LOAD(rA, 3); }
                    __syncthreads();
#pragma unroll 1
                    for (int c3 = 0; c3 < 66; c3 += 3) {
#pragma unroll
                        for (int cs = 0; cs < 3; ++cs) {
                            const int c = c3 + cs;
                            if (c < 64) {
                                if (mI < 5) {
                                    if (cs == 0) { if (c + 1 < 64) SCAN_WRITE(rB, (c + 1) & 1); if (c + 4 < 64) SCAN_LOAD(rB, c + 4); }
                                    else if (cs == 1) { if (c + 1 < 64) SCAN_WRITE(rC, (c + 1) & 1); if (c + 4 < 64) SCAN_LOAD(rC, c + 4); }
                                    else { if (c + 1 < 64) SCAN_WRITE(rA, (c + 1) & 1); if (c + 4 < 64) SCAN_LOAD(rA, c + 4); }
                                }
                                __syncthreads();
                            }
                        }
                    }
#undef SCAN_LOAD
#undef SCAN_WRITE
                }
                asm volatile("s_waitcnt vmcnt(0)" ::: "memory");
                __syncthreads();
                __builtin_amdgcn_fence(__ATOMIC_ACQUIRE, "agent");
                asm volatile("s_waitcnt vmcnt(0)" ::: "memory");
                {
                    const float* dg = args.in[I_DNG];
                    float gg[8];
#pragma unroll
                    for (int i = 0; i < 8; ++i) gg[i] = dg[(lane & 7) * 8 + i];
                    for (int t0 = wave * 8 + (lane >> 3); t0 < SEQ; t0 += 256) {
                        u32x4 ov[4], zv[4];
#pragma unroll
                        for (int u = 0; u < 4; ++u) { const size_t rw = (size_t)b * SEQ + t0 + 64 * u;
                            ov[u] = *(const u32x4*)(QKVA + rw * 1536 + 1024 + h * 64 + (lane & 7) * 8); zv[u] = *(const u32x4*)(ZS + rw * 512 + h * 64 + (lane & 7) * 8); }
#pragma unroll
                        for (int u = 0; u < 4; ++u) {
                            float o[8], z[8]; unpack8(ov[u], o); unpack8(zv[u], z);
                            float ss = 0.f;
#pragma unroll
                            for (int i = 0; i < 8; ++i) ss += o[i] * o[i];
                            ss = sum8_dpp(ss);
                            const float r = rsqrtf(ss * (1.0f / 64.0f) + EPS);
                            f32x4 a0, a1;
#pragma unroll
                            for (int i = 0; i < 4; ++i) { a0[i] = o[i] * r * gg[i] * z[i]; a1[i] = o[4 + i] * r * gg[4 + i] * z[4 + i]; }
                            *(u32x4*)(QKVA + ((size_t)b * SEQ + t0 + 64 * u) * 1536 + 1024 + h * 64 + (lane & 7) * 8) = pack8(a0, a1);
                        }
                    }
                }
            }
            {
                unsigned char* kbuf = lds;
                unsigned char* vbuf = lds + 32768;
                volatile int* qslot = (volatile int*)(lds + 153600);
                unsigned* qctr = (unsigned*)ws;
                const unsigned* MASK32 = (const unsigned*)MASK;
                const h16* VT = (const h16*)(ws + WS_XN);
                const int kws = srow * 128 + ((sch ^ (srow & 7)) * 16), vws = srow * 136 + sch * 16;
                for (;;) {
                    __syncthreads();
                    if (tid == 0) *qslot = (int)__hip_atomic_fetch_add(qctr, 1u, __ATOMIC_RELAXED, __HIP_MEMORY_SCOPE_AGENT);
                    __syncthreads();
                    const int u = __builtin_amdgcn_readfirstlane(*qslot);
                    if (u >= 1024) break;
                    {
                        const int qb = 15 - (u >> 6), bh = u & 63, b = bh >> 3, h = bh & 7, q0 = qb * 256;
                        const int qrow = b * SEQ + q0 + 32 * wave + r32;
                        h16x8 qf[4];
                        { const h16* qp = QKVB + (size_t)qrow * 1536 + h * 64 + 8 * hi;
#pragma unroll
                          for (int ks = 0; ks < 4; ++ks) { const h16x8 t8 = *(const h16x8*)(qp + 16 * ks);
#pragma unroll
                              for (int i = 0; i < 8; ++i) qf[ks][i] = (h16)((float)t8[i] * 1.4426950408889634f); } }
                        f32x16 o[2];
#pragma unroll
                        for (int i = 0; i < 16; ++i) { o[0][i] = 0.f; o[1][i] = 0.f; }
                        float mref = 0.f, l = 0.f; f32x16 negm;
#pragma unroll
                        for (int i = 0; i < 16; ++i) negm[i] = 0.f;
                        const int nkt = 4 * qb + 4;
                        const h16* kg = QKVB + ((size_t)b * SEQ + srow) * 1536 + 512 + h * 64 + 8 * sch;
                        const h16* vg = VT + ((size_t)bh * 64 + srow) * SEQ + 8 * sch;
                        const h16* kgs = QKVB + ((size_t)b * SEQ + srow) * 1536 + 512 + h * 64 + 8 * (sch ^ ((srow >> 1) & 7));
#define ATT_KDMA(tile, slot) __builtin_amdgcn_global_load_lds((const unsigned*)(kgs + (size_t)(tile) * 64 * 1536), (LAS unsigned*)((LAS unsigned char*)lds + (slot) * 8192 + wave * 1024), 16, 0, 0)
                        u32x4 vreg[2];
#pragma unroll
                        for (int j = 0; j < 2; ++j) vreg[j] = *(const u32x4*)(vg + j * 64);
                        __syncthreads();
                        ATT_KDMA(0, 0); ATT_KDMA(1, 1);
#pragma unroll
                        for (int j = 0; j < 2; ++j) { unsigned char* vd = vbuf + j * 8704 + vws; *(u32x2*)vd = (u32x2){vreg[j][0], vreg[j][1]}; *(u32x2*)(vd + 8) = (u32x2){vreg[j][2], vreg[j][3]}; }
                        asm volatile("s_waitcnt vmcnt(0)" ::: "memory");
                        __syncthreads();
                        const int wq_last = q0 + 32 * wave + 31;
                        const int npair = nkt >> 1;
                        const unsigned* mq = MASK32 + ((size_t)b * 64 * SEQ + (q0 + 32 * wave + r32)) * 2;
                        u32x4 mnext; { const u32x2 ta = *(const u32x2*)mq, tb = *(const u32x2*)(mq + 2 * SEQ); mnext = (u32x4){ta[0], ta[1], tb[0], tb[1]}; }
                        for (int kp = 0; kp < npair; ++kp) {
                            const int cur = kp & 1;
                            if (kp + 1 < npair) {
                                ATT_KDMA(2 * kp + 2, 2 * (cur ^ 1)); ATT_KDMA(2 * kp + 3, 2 * (cur ^ 1) + 1);
#pragma unroll
                                for (int j = 0; j < 2; ++j) vreg[j] = *(const u32x4*)(vg + (2 * kp + 2 + j) * 64);
                            }
                            if (128 * kp <= wq_last) {
                                const unsigned mw[4] = {mnext[0] >> (4 * hi), mnext[1] >> (4 * hi), mnext[2] >> (4 * hi), mnext[3] >> (4 * hi)};
                                if (128 * (kp + 1) <= wq_last) { const u32x2 ta = *(const u32x2*)(mq + (size_t)(2 * kp + 2) * 2 * SEQ), tb = *(const u32x2*)(mq + (size_t)(2 * kp + 3) * 2 * SEQ); mnext = (u32x4){ta[0], ta[1], tb[0], tb[1]}; }
                                f32x16 S[4];
#pragma unroll
                                for (int j = 0; j < 2; ++j) {
                                    const unsigned char* kb_ = kbuf + (2 * cur + j) * 8192 + r32 * 128;
#pragma unroll
                                    for (int ks = 0; ks < 4; ++ks) {
                                        const int off = ((2 * ks + hi) ^ ((r32 >> 1) & 7)) * 16;
                                        const h16x8 a0 = *(const h16x8*)(kb_ + off), a1 = *(const h16x8*)(kb_ + 4096 + off);
                                        S[2 * j] = __builtin_amdgcn_mfma_f32_32x32x16_f16(a0, qf[ks], ks == 0 ? negm : S[2 * j], 0, 0, 0);
                                        S[2 * j + 1] = __builtin_amdgcn_mfma_f32_32x32x16_f16(a1, qf[ks], ks == 0 ? negm : S[2 * j + 1], 0, 0, 0);
                                    }
                                    __builtin_amdgcn_sched_barrier(0);
                                }

                                float mx = S[0][0];
#pragma unroll
                                for (int i = 0; i < 16; ++i) { mx = fmaxf(mx, fmaxf(S[0][i], S[1][i])); mx = fmaxf(mx, fmaxf(S[2][i], S[3][i])); }
                                mx = fmaxf(mx, __shfl_xor(mx, 32));
                                if (kp == 0 || __any(mx > 8.0f)) {
                                    const float d = kp == 0 ? mx : fmaxf(mx, 0.f), alpha = __builtin_amdgcn_exp2f(-d);
                                    mref += d; l *= alpha;
#pragma unroll
                                    for (int i = 0; i < 16; ++i) { S[0][i] -= d; S[1][i] -= d; S[2][i] -= d; S[3][i] -= d; o[0][i] *= alpha; o[1][i] *= alpha; negm[i] = -mref; }
                                }
                                float ps = 0.f;
#pragma unroll
                                for (int rt = 0; rt < 4; ++rt)
#pragma unroll
                                    for (int i = 0; i < 16; ++i) {
                                        float e = __builtin_amdgcn_exp2f(S[rt][i]);
                                        int bm;
                                        asm("v_bfe_i32 %0, %1, %2, 1" : "=v"(bm) : "v"(mw[rt]), "i"((i & 3) + 8 * (i >> 2)));
                                        e = __uint_as_float(__float_as_uint(e) & (unsigned)bm);
                                        ps += e; S[rt][i] = e;
                                    }
                                l += ps;
#pragma unroll
                                for (int j = 0; j < 2; ++j) {
                                    const unsigned char* vb_ = vbuf + (2 * cur + j) * 8704 + r32 * 136 + 8 * hi;
#pragma unroll
                                    for (int rt = 0; rt < 2; ++rt)
#pragma unroll
                                        for (int s2 = 0; s2 < 2; ++s2) {
                                            h16x8 pb;
#pragma unroll
                                            for (int jj = 0; jj < 8; ++jj) pb[jj] = (h16)S[2 * j + rt][8 * s2 + jj];
#pragma unroll
                                            for (int dt = 0; dt < 2; ++dt) {
                                                const unsigned char* vp = vb_ + dt * (32 * 136) + (32 * rt + 16 * s2) * 2;
                                                const h16x4 lo = *(const h16x4*)vp, hi4 = *(const h16x4*)(vp + 16);
                                                const h16x8 va = {lo[0], lo[1], lo[2], lo[3], hi4[0], hi4[1], hi4[2], hi4[3]};
                                                o[dt] = __builtin_amdgcn_mfma_f32_32x32x16_f16(va, pb, o[dt], 0, 0, 0);
                                            }
                                        }
                                }
                            }
                            if (kp + 1 < npair) {
#pragma unroll
                                for (int j = 0; j < 2; ++j) { unsigned char* vd = vbuf + (2 * (cur ^ 1) + j) * 8704 + vws;
                                    *(u32x2*)vd = (u32x2){vreg[j][0], vreg[j][1]}; *(u32x2*)(vd + 8) = (u32x2){vreg[j][2], vreg[j][3]}; }
                            }
                            asm volatile("s_waitcnt vmcnt(0)" ::: "memory");
                            __syncthreads();
                        }
#undef ATT_KDMA
                        l += __shfl_xor(l, 32);
                        const float inv = 1.0f / l;
                        h16* op = QKVB + (size_t)qrow * 1536 + h * 64 + 4 * hi;
#pragma unroll
                        for (int dt = 0; dt < 2; ++dt)
#pragma unroll
                            for (int g4 = 0; g4 < 4; ++g4) {
                                const f32x4 v4 = {o[dt][4 * g4] * inv, o[dt][4 * g4 + 1] * inv, o[dt][4 * g4 + 2] * inv, o[dt][4 * g4 + 3] * inv};
                                *(u32x2*)(op + 32 * dt + 8 * g4) = pack4(v4);
                            }
                    }
                }
            }
        } break;
        case 9: g = pg8::Gemm{QKVA + 1024, WBA, T, D, 512, 1536}; E.mode = pg8::EPI_BRA; break;
        case 10: g = pg8::Gemm{QKVB, WBB, T, D, 512, 1536}; E.mode = pg8::EPI_BRB; break;
        case 11: g = pg8::Gemm{XN, WO, T, D, D, D}; E.mode = pg8::EPI_F32; break;
        case 12: resid_norm_phase<false, false>(nullptr, H16, Y, 1.0f, args.in[I_MPOST], args.in[I_F2PRE], XN, nullptr, gw, ngw, lane); break;
        case 13: g = pg8::Gemm{XN, W3, T, 2 * FF, D, D}; E.mode = pg8::EPI_SWIGLU; break;
        case 14: g = pg8::Gemm{HID, W4, T, D, FF, FF}; E.mode = pg8::EPI_F32; break;
        case 15: resid_norm_phase<false, false>(nullptr, H16, Y, 0.5f, args.in[I_F2POST], args.in[I_PPRE], XN, nullptr, gw, ngw, lane); break;
        case 16: g = pg8::Gemm{XN, WG, T, D, D, D}; E.mode = pg8::EPI_PLEG; break;
        case 17: g = pg8::Gemm{P16, WP, T, D, PLE, PLE}; E.mode = pg8::EPI_PLEP; break;
        case 18: resid_norm_phase<false, true>(nullptr, H16, (const h16*)(ws + WS_E16), 1.0f, args.in[I_PPOST], nullptr, nullptr, outp_, gw, ngw, lane); break;
        default: break;
        }
        if (E.mode >= 0) { pg8::StaticOrder S; S.init(T, g.N, G, bid); pg8::gemm_phase((LAS unsigned char*)lds, g, S, E, tid); }
#ifdef DUP_PHASE
        if (ph == DUP_PHASE && !dup_done) { dup_done = true; --ph; }
#endif
        if (ph + 1 < args.ph_hi) {
            if (args.ph_lo < 0) grid.sync();
            if (ph == 9 || ph == 16) { asm volatile("s_waitcnt vmcnt(0)" ::: "memory"); __syncthreads(); }
            else xcd_barrier(xbar);
        }
#ifdef PROBE_MASK
        if (((PROBE_MASK >> ph) & 1) && bid == 0) { __syncthreads(); if (tid == 0) { const unsigned long long t1 = __builtin_amdgcn_s_memrealtime(); const unsigned long long dt = (t1 - probe_t0) * PROBE_MULT;
            while (__builtin_amdgcn_s_memrealtime() - t1 < dt) __builtin_amdgcn_s_sleep(32); } __syncthreads(); }
#endif
    }
}

constexpr int NPHASES = 19;

extern "C" void kernel_launch(void* const* d_in, const int* in_sizes, int n_in, void* d_out, int out_size, void* d_ws, size_t ws_size, hipStream_t stream) {
    static int grid = 0;
    if (grid == 0) {
        if (n_in != 25 || in_sizes[0] != T * D || out_size != T * D || ws_size < WS_END || ws_size < WS_HID + (size_t)T * FF * 2) {
            fprintf(stderr, "kernel_launch: unexpected shapes / workspace (n_in %d, in0 %d, out %d, ws %zu); nothing launched\n", n_in, n_in > 0 ? in_sizes[0] : -1, out_size, ws_size); grid = -1; return; }
        int dev = 0, cus = 0, per_cu = 0;
        hipGetDevice(&dev);
        hipDeviceGetAttribute(&cus, hipDeviceAttributeMultiprocessorCount, dev);
        hipFuncSetAttribute((const void*)fwd_kernel, hipFuncAttributeMaxDynamicSharedMemorySize, LDS_BYTES);
        hipOccupancyMaxActiveBlocksPerMultiprocessor(&per_cu, (const void*)fwd_kernel, NTHREADS, LDS_BYTES);
        if (per_cu < 1) { fprintf(stderr, "kernel_launch: occupancy query says %d blocks per CU\n", per_cu); per_cu = 1; }
        if (per_cu > 1) per_cu = 1;
        grid = cus * per_cu;
        (void)hipGetLastError();
    }
    if (grid < 0) return;
    if (hipMemsetAsync(d_ws, 0, 65536, stream) != hipSuccess) { fprintf(stderr, "kernel_launch: hipMemsetAsync of the control words failed\n"); return; }
    Args a{};
    for (int i = 0; i < 25; ++i) a.in[i] = (const float*)d_in[i];
    a.out = (float*)d_out; a.ws = (unsigned char*)d_ws;
#if MK_PER_PHASE
    for (int ph = 0; ph < NPHASES; ++ph) {
        a.ph_lo = ph; a.ph_hi = ph + 1;
        void* kargs[] = {&a};
        hipError_t e = hipLaunchCooperativeKernel((const void*)fwd_kernel, dim3(grid), dim3(NTHREADS), kargs, LDS_BYTES, stream);
        if (e != hipSuccess) { fprintf(stderr, "launch failed: %s\n", hipGetErrorString(e)); break; }
    }
#else
    a.ph_lo = 0; a.ph_hi = NPHASES;
    void* kargs[] = {&a};
    hipError_t e = hipLaunchCooperativeKernel((const void*)fwd_kernel, dim3(grid), dim3(NTHREADS), kargs, LDS_BYTES, stream);
    if (e != hipSuccess) fprintf(stderr, "cooperative launch failed: %s (grid %d)\n", hipGetErrorString(e), grid);
#endif
}
```

```cpp
#include <hip/hip_runtime.h>
#include <hip/hip_cooperative_groups.h>
#include <cstdio>
#include <cstdint>
namespace cg = cooperative_groups;

#ifndef MK_PER_PHASE
#define MK_PER_PHASE 0
#endif

constexpr int T = 32768, D = 1024, FF = 2816, SEQ = 4096, NBATCH = 8, PLE = 256;
constexpr int NMIX = 6400;
constexpr float EPS = 1e-6f;
constexpr int NWAVES = 8, NTHREADS = 512;
constexpr int LDS_BYTES = 155648;

typedef _Float16 h16;
typedef _Float16 h16x8 __attribute__((ext_vector_type(8)));
typedef _Float16 h16x4 __attribute__((ext_vector_type(4)));
typedef short s16x8 __attribute__((ext_vector_type(8)));
typedef float f32x4 __attribute__((ext_vector_type(4)));
typedef unsigned u32x4 __attribute__((ext_vector_type(4)));
typedef unsigned u32x2 __attribute__((ext_vector_type(2)));
typedef __attribute__((address_space(1))) _Float16 gh16;
#define LAS __attribute__((address_space(3)))

constexpr size_t MiB = 1u << 20;
constexpr size_t WS_ROPE = 1 * MiB;
constexpr size_t WS_W1 = 2 * MiB;
constexpr size_t WS_W2 = WS_W1 + 11 * MiB;
constexpr size_t WS_WM = WS_W2 + 11 * MiB / 2;
constexpr size_t WS_WBA = WS_WM + 25 * MiB / 2;
constexpr size_t WS_WBB = WS_WBA + 1 * MiB;
constexpr size_t WS_WO = WS_WBB + 1 * MiB;
constexpr size_t WS_W3 = WS_WO + 2 * MiB;
constexpr size_t WS_W4 = WS_W3 + 11 * MiB;
constexpr size_t WS_WG = WS_W4 + 11 * MiB / 2;
constexpr size_t WS_WP = WS_WG + 2 * MiB;
constexpr size_t WS_P16 = 54 * MiB;
constexpr size_t WS_XN = 70 * MiB;
constexpr size_t WS_H16 = 134 * MiB;
constexpr size_t WS_ARENA = 198 * MiB;
constexpr size_t WS_HID = WS_ARENA;
constexpr size_t WS_TMP = WS_ARENA;
constexpr size_t WS_E16 = WS_ARENA + 64 * MiB;
constexpr size_t WS_QKVA = WS_ARENA;
constexpr size_t WS_ZS = WS_QKVA + 96 * MiB;
constexpr size_t WS_QKVB = WS_ZS + 32 * MiB;
constexpr size_t WS_QI = WS_QKVB + 96 * MiB;
constexpr size_t WS_MISC = WS_QI + 32 * MiB;
constexpr size_t WS_MASK = WS_MISC + 12 * MiB;
constexpr size_t WS_HALO = WS_MASK + 16 * MiB;
constexpr size_t WS_KI = WS_HALO + 5 * MiB;
constexpr size_t WS_END = WS_KI + 4 * MiB;
static_assert(WS_WP + MiB / 2 <= WS_P16 && WS_END <= 512 * MiB && WS_HID + (size_t)T * FF * 2 <= 512 * MiB, "ws map");

__device__ __forceinline__ float sigmoidf_(float x) { return __builtin_amdgcn_rcpf(1.0f + __builtin_amdgcn_exp2f(-1.4426950408889634f * x)); }
__device__ __forceinline__ float siluf_(float x) { return x * __builtin_amdgcn_rcpf(1.0f + __builtin_amdgcn_exp2f(-1.4426950408889634f * x)); }
__device__ __forceinline__ u32x4 pack8(f32x4 a, f32x4 b) {
    h16x8 h = {(h16)a[0], (h16)a[1], (h16)a[2], (h16)a[3], (h16)b[0], (h16)b[1], (h16)b[2], (h16)b[3]};
    return __builtin_bit_cast(u32x4, h);
}
__device__ __forceinline__ u32x2 pack4(f32x4 a) {
    h16x4 h = {(h16)a[0], (h16)a[1], (h16)a[2], (h16)a[3]};
    return __builtin_bit_cast(u32x2, h);
}
__device__ __forceinline__ void unpack8(u32x4 w, float (&f)[8]) {
    h16x8 h = __builtin_bit_cast(h16x8, w);
#pragma unroll
    for (int i = 0; i < 8; ++i) f[i] = (float)h[i];
}
__device__ __forceinline__ float wave_sum(float v) {
#pragma unroll
    for (int o = 1; o < 64; o <<= 1) v += __shfl_xor(v, o);
    return v;
}
__device__ __forceinline__ float wave_sum_dpp(float v) {
#define DPP_ADD(ctrl, rmask) v += __builtin_bit_cast(float, __builtin_amdgcn_update_dpp(0, __builtin_bit_cast(int, v), ctrl, rmask, 0xF, false))
    DPP_ADD(0xB1, 0xF);
    DPP_ADD(0x4E, 0xF);
    DPP_ADD(0x141, 0xF);
    DPP_ADD(0x140, 0xF);
    DPP_ADD(0x142, 0xA);
    DPP_ADD(0x143, 0xC);
#undef DPP_ADD
    return __builtin_bit_cast(float, __builtin_amdgcn_readlane(__builtin_bit_cast(int, v), 63));
}
__device__ __forceinline__ int wave_sum_dpp_i(int v) {
#define DPP_ADDI(ctrl, rmask) v += __builtin_amdgcn_update_dpp(0, v, ctrl, rmask, 0xF, false)
    DPP_ADDI(0xB1, 0xF); DPP_ADDI(0x4E, 0xF); DPP_ADDI(0x141, 0xF); DPP_ADDI(0x140, 0xF); DPP_ADDI(0x142, 0xA); DPP_ADDI(0x143, 0xC);
#undef DPP_ADDI
    return __builtin_amdgcn_readlane(v, 63);
}
__device__ __forceinline__ float sum8_dpp(float v) {
    v += __builtin_bit_cast(float, __builtin_amdgcn_update_dpp(0, __builtin_bit_cast(int, v), 0xB1, 0xF, 0xF, false));
    v += __builtin_bit_cast(float, __builtin_amdgcn_update_dpp(0, __builtin_bit_cast(int, v), 0x4E, 0xF, 0xF, false));
    v += __builtin_bit_cast(float, __builtin_amdgcn_update_dpp(0, __builtin_bit_cast(int, v), 0x141, 0xF, 0xF, false));
    return v;
}
__device__ __forceinline__ int wave_sum_i(int v) {
#pragma unroll
    for (int o = 1; o < 64; o <<= 1) v += __shfl_xor(v, o);
    return v;
}
#define LDS_WAIT() asm volatile("s_waitcnt lgkmcnt(0)" ::: "memory")

namespace pg8 {
constexpr int BM = 256, BK = 64, HALF = 128, HTB = HALF * BK * 2, STAGE_BYTES = 8 * HTB, NXCD = 8, WGM = 4;
__host__ __device__ __forceinline__ int lds_byte(int r, int c) { const int st = (r >> 4) * 2 + (c >> 5), rr = r & 15, cc = c & 31, ob = rr * 64 + cc * 2; return st * 1024 + (ob ^ (((ob >> 9) & 1) << 5)); }
__host__ __device__ __forceinline__ void stage_rc(int b, int& R, int& C) { const int st = b / 1024, sb = b % 1024, swz = sb ^ (((sb >> 9) & 1) << 5); R = (st >> 1) * 16 + swz / 64; C = (st & 1) * 32 + (swz % 64) / 2; }
__host__ __device__ __forceinline__ int perm32(int rho) { const int n = rho >> 4, i = rho & 15; return 8 * (i >> 2) + 4 * n + (i & 3); }
struct Unit { int pm, pn; };
struct Gemm { const h16* A; const h16* Bt; int M, N, K, lda; };
struct StaticOrder {
    int nM, nN, nwg, G, c;
    __device__ void init(int M, int N, int G_, int c_) { nM = M / BM; nN = N / BM; nwg = nM * nN; G = G_; c = c_; }
    __device__ bool next(int i, Unit& u) const {
        const long L = (long)i * G + c; if (L >= nwg) return false;
        int wgid = (int)L; { const int q = nwg / NXCD, r = nwg % NXCD, xcd = wgid % NXCD, off = wgid / NXCD; wgid = (xcd < r ? xcd * (q + 1) : r * (q + 1) + (xcd - r) * q) + off; }
        const int nig = WGM * nN, gid = wgid / nig, fm = gid * WGM, gsz = (nM - fm) < WGM ? (nM - fm) : WGM;
        u.pm = fm + ((wgid % nig) % gsz); u.pn = (wgid % nig) / gsz; return true;
    }
};

enum { EPI_SWIGLU = 0, EPI_F32 = 1, EPI_MIX = 2, EPI_BRA = 3, EPI_BRB = 4, EPI_PLEG = 5, EPI_PLEP = 6 };
struct Epi {
    int mode; unsigned char* ws; float* outp;
    __device__ __forceinline__ void operator()(const f32x4 (&acc)[2][2][4][2], const Unit& u, int wr, int wc, int fr, int fq) const {
        const int cb = wc * 32 + 8 * fq;
        const int row0 = u.pm * BM + wr * 64 + fr;
        h16* const o16 = (h16*)(ws + (mode == EPI_SWIGLU ? WS_HID : mode == EPI_PLEG ? WS_TMP : WS_XN));
        const int ldo = mode == EPI_SWIGLU ? FF : D;
        const h16* const g16 = mode == EPI_PLEP ? (const h16*)(ws + WS_TMP) : (const h16*)outp;
        h16* const qkva = (h16*)(ws + WS_QKVA); h16* const zs = (h16*)(ws + WS_ZS); h16* const qkvb = (h16*)(ws + WS_QKVB); h16* const qi = (h16*)(ws + WS_QI);
        h16* const gates = (h16*)outp; h16* const halo = (h16*)(ws + WS_HALO); float* const misc = (float*)(ws + WS_MISC); const float* const rope = (const float*)(ws + WS_ROPE);
        if (mode == EPI_SWIGLU) {
#pragma unroll
            for (int ai = 0; ai < 2; ++ai)
#pragma unroll
                for (int m = 0; m < 4; ++m) {
                    const int row = row0 + ai * HALF + m * 16;
                    f32x4 r0, r1;
#pragma unroll
                    for (int i = 0; i < 4; ++i) { r0[i] = siluf_(acc[ai][0][m][0][i]) * acc[ai][1][m][0][i]; r1[i] = siluf_(acc[ai][0][m][1][i]) * acc[ai][1][m][1][i]; }
                    *(u32x4*)(o16 + (size_t)row * ldo + u.pn * 128 + cb) = pack8(r0, r1);
                }
        } else if (mode == EPI_F32) {
#pragma unroll
            for (int ai = 0; ai < 2; ++ai)
#pragma unroll
                for (int m = 0; m < 4; ++m) {
                    const int row = row0 + ai * HALF + m * 16;
#pragma unroll
                    for (int bj = 0; bj < 2; ++bj) *(u32x4*)((h16*)outp + (size_t)row * D + u.pn * BM + bj * HALF + cb) = pack8(acc[ai][bj][m][0], acc[ai][bj][m][1]);
                }
        } else if (mode == EPI_BRA || mode == EPI_BRB || mode == EPI_PLEP) {
#pragma unroll
            for (int ai = 0; ai < 2; ++ai)
#pragma unroll
                for (int m = 0; m < 4; ++m) {
                    const int row = row0 + ai * HALF + m * 16;
#pragma unroll
                    for (int bj = 0; bj < 2; ++bj) {
                        const int col = u.pn * BM + bj * HALF + cb;
                        float g[8]; unpack8(*(const u32x4*)(g16 + (size_t)row * (mode == EPI_PLEP ? 1024 : 2048) + (mode == EPI_BRB ? 1024 : 0) + col), g);
                        f32x4 r0, r1;
#pragma unroll
                        for (int i = 0; i < 4; ++i) { r0[i] = g[i] * acc[ai][bj][m][0][i]; r1[i] = g[4 + i] * acc[ai][bj][m][1][i]; }
                        if (mode == EPI_PLEP) { *(u32x4*)((h16*)(ws + WS_E16) + (size_t)row * D + col) = pack8(r0, r1); }
                        else {
                            h16* p = o16 + (size_t)row * ldo + col;
                            if (mode == EPI_BRB) { float o[8]; unpack8(*(const u32x4*)p, o);
#pragma unroll
                                for (int i = 0; i < 4; ++i) { r0[i] += o[i]; r1[i] += o[4 + i]; } }
                            *(u32x4*)p = pack8(r0, r1);
                        }
                    }
                }
        } else if (mode == EPI_PLEG) {
#pragma unroll
            for (int ai = 0; ai < 2; ++ai)
#pragma unroll
                for (int m = 0; m < 4; ++m) {
                    const int row = row0 + ai * HALF + m * 16;
#pragma unroll
                    for (int bj = 0; bj < 2; ++bj) {
                        f32x4 r0, r1;
#pragma unroll
                        for (int i = 0; i < 4; ++i) { r0[i] = sigmoidf_(acc[ai][bj][m][0][i]); r1[i] = sigmoidf_(acc[ai][bj][m][1][i]); }
                        *(u32x4*)(o16 + (size_t)row * ldo + u.pn * BM + bj * HALF + cb) = pack8(r0, r1);
                    }
                }
        } else {
            const int pn = u.pn;
#pragma unroll
            for (int ai = 0; ai < 2; ++ai)
#pragma unroll
                for (int m = 0; m < 4; ++m) {
                    const int row = row0 + ai * HALF + m * 16;
#pragma unroll
                    for (int bj = 0; bj < 2; ++bj) {
                        const int tc = bj * HALF + cb;
                        f32x4 v0 = acc[ai][bj][m][0], v1 = acc[ai][bj][m][1];
                        if (pn < 6) {
                            const u32x4 w = pack8(v0, v1);
                            *(u32x4*)(qkva + (size_t)row * 1536 + pn * 256 + tc) = w;
                            if ((row & 63) >= 61) *(u32x4*)(halo + ((size_t)(row >> 6) * 3 + ((row & 63) - 61)) * 1536 + pn * 256 + tc) = w;
                        } else if (pn < 8) {
#pragma unroll
                            for (int i = 0; i < 4; ++i) { v0[i] = siluf_(v0[i]); v1[i] = siluf_(v1[i]); }
                            *(u32x4*)(zs + (size_t)row * 512 + (pn - 6) * 256 + tc) = pack8(v0, v1);
                        } else if (pn < 16) {
                            const bool rope_tile = (pn < 12) || (pn >= 14);
                            if (rope_tile && !(wc & 1)) {
                                f32x4 p0, p1;
#pragma unroll
                                for (int i = 0; i < 4; ++i) { p0[i] = __shfl_xor(v0[i], 16); p1[i] = __shfl_xor(v1[i], 16); }
                                if (fq < 2) {
                                    const float* rp = rope + (size_t)(row & (SEQ - 1)) * 16;
                                    const f32x4 c0 = *(const f32x4*)rp, c1 = *(const f32x4*)(rp + 4), s0 = *(const f32x4*)(rp + 8), s1 = *(const f32x4*)(rp + 12);
                                    const float sg = fq == 0 ? -1.f : 1.f;
#pragma unroll
                                    for (int i = 0; i < 4; ++i) { v0[i] = v0[i] * c0[i] + sg * p0[i] * s0[i]; v1[i] = v1[i] * c1[i] + sg * p1[i] * s1[i]; }
                                }
                            }
                            if (pn < 10) { v0 = v0 * 0.125f; v1 = v1 * 0.125f; }
                            h16* dst = pn < 14 ? qkvb + (size_t)row * 1536 + (pn - 8) * 256 + tc : qi + (size_t)row * 512 + (pn - 14) * 256 + tc;
                            *(u32x4*)dst = pack8(v0, v1);
                        } else if (pn < 24) {
#pragma unroll
                            for (int i = 0; i < 4; ++i) { v0[i] = sigmoidf_(v0[i]); v1[i] = sigmoidf_(v1[i]); }
                            *(u32x4*)(gates + (size_t)row * 2048 + (pn - 16) * 256 + tc) = pack8(v0, v1);
                        } else if (bj == 0) {
                            float* mp = misc + (size_t)row * 96;
                            if (wc < 2) { *(f32x4*)(mp + tc) = v0; *(f32x4*)(mp + tc + 4) = v1; }
                            else if (wc == 2 && fq < 3) {
                                float r[8] = {v0[0], v0[1], v0[2], v0[3], v1[0], v1[1], v1[2], v1[3]};
                                if (fq == 2) {
#pragma unroll
                                    for (int i = 0; i < 8; ++i) r[i] *= 0.04419417382415922f;
                                }
                                *(f32x4*)(mp + 64 + 8 * fq) = (f32x4){r[0], r[1], r[2], r[3]}; *(f32x4*)(mp + 68 + 8 * fq) = (f32x4){r[4], r[5], r[6], r[7]};
                            }
                        }
                    }
                }
        }
    }
};

__device__ __forceinline__ void gemm_phase(LAS unsigned char* lds, const Gemm g, const StaticOrder& S, const Epi& E, const int tid) {
    const int wid = __builtin_amdgcn_readfirstlane(tid >> 6), lane = tid & 63, wr = wid >> 2, wc = wid & 3, fr = lane & 15, fq = lane >> 4;
    const int K = g.K, nt = K / BK, lda = g.lda;
    unsigned voffA[2], voffB[2];
#pragma unroll
    for (int i = 0; i < 2; ++i) { int R, C; stage_rc(tid * 16 + i * 8192, R, C); const int Rb = (R & ~31) + perm32(R & 31);
        voffA[i] = (unsigned)(R * lda + C) * 2u; voffB[i] = (unsigned)(Rb * K + C) * 2u; }
    const size_t kstep = (size_t)(BK * 2);
    const size_t hstepA = (size_t)HALF * lda * 2, hstepB = (size_t)HALF * K * 2;
    const size_t tstepA = 2 * hstepA, tstepB = 2 * hstepB;
    const unsigned ldsw = (unsigned)wid * 1024u;
    const int aoff = lds_byte(wr * 64 + fr, fq * 8), boff = lds_byte(wc * 32 + fr, fq * 8);
#define PG8_SA(b, h) (((b) * 2 + (h)) * HTB)
#define PG8_SB(b, h) ((4 + (b) * 2 + (h)) * HTB)
#define PG8_STAGE(bufoff, gbase, voff) do { _Pragma("unroll") for (int _i = 0; _i < 2; ++_i) \
        __builtin_amdgcn_global_load_lds((const unsigned*)((const char*)(gbase) + (voff)[_i]), (LAS unsigned*)(lds + (bufoff) + ldsw + _i * 8192), 16, 0, 0); } while (0)
#define PG8_LDA(dst, b, h) do { _Pragma("unroll") for (int m = 0; m < 4; ++m) _Pragma("unroll") for (int k = 0; k < 2; ++k) dst[m][k] = *(const LAS s16x8*)(lds + PG8_SA(b, h) + aoff + m * 2048 + k * 1024); } while (0)
#define PG8_LDB(dst, b, h) do { _Pragma("unroll") for (int n = 0; n < 2; ++n) _Pragma("unroll") for (int k = 0; k < 2; ++k) dst[n][k] = *(const LAS s16x8*)(lds + PG8_SB(b, h) + boff + n * 2048 + k * 1024); } while (0)
#define PG8_MMA(ai, bj, At, Bt) do { __builtin_amdgcn_s_setprio(1); _Pragma("unroll") for (int m = 0; m < 4; ++m) _Pragma("unroll") for (int n = 0; n < 2; ++n) _Pragma("unroll") for (int k = 0; k < 2; ++k) \
        acc[ai][bj][m][n] = __builtin_amdgcn_mfma_f32_16x16x32_f16(__builtin_bit_cast(h16x8, Bt[n][k]), __builtin_bit_cast(h16x8, At[m][k]), acc[ai][bj][m][n], 0, 0, 0); __builtin_amdgcn_s_setprio(0); } while (0)
#define PG8_WAIT_V(n) asm volatile("s_waitcnt vmcnt(" #n ")" ::: "memory")
#define PG8_WAIT_L(n) asm volatile("s_waitcnt lgkmcnt(" #n ")" ::: "memory")
#define PG8_BAR __builtin_amdgcn_s_barrier()
#define PG8_SCHED __builtin_amdgcn_sched_barrier(0)
    Unit cur, nxt; int ui = 0;
    if (!S.next(0, cur)) return;
    f32x4 acc[2][2][4][2];
#pragma unroll
    for (int a = 0; a < 2; ++a)
#pragma unroll
        for (int b = 0; b < 2; ++b)
#pragma unroll
            for (int m = 0; m < 4; ++m)
#pragma unroll
                for (int n = 0; n < 2; ++n) acc[a][b][m][n] = (f32x4){0.f, 0.f, 0.f, 0.f};
    s16x8 At[4][2], B0[2][2], B1[2][2];
    const char* cA = (const char*)g.A + (size_t)cur.pm * tstepA; const char* cB = (const char*)g.Bt + (size_t)cur.pn * tstepB;
    PG8_STAGE(PG8_SB(0, 0), cB, voffB); PG8_STAGE(PG8_SB(0, 1), cB + hstepB, voffB); PG8_STAGE(PG8_SA(0, 0), cA, voffA); PG8_STAGE(PG8_SA(0, 1), cA + hstepA, voffA);
    if (wr == 1) PG8_BAR;
    PG8_WAIT_V(2); PG8_BAR;
    PG8_STAGE(PG8_SB(1, 0), cB + kstep, voffB); PG8_STAGE(PG8_SA(1, 0), cA + kstep, voffA); PG8_STAGE(PG8_SB(1, 1), cB + hstepB + kstep, voffB);
    PG8_WAIT_V(6); PG8_BAR;
    for (;;) {
        const bool has_next = S.next(ui + 1, nxt);
        const char* nA = has_next ? (const char*)g.A + (size_t)nxt.pm * tstepA : cA; const char* nB = has_next ? (const char*)g.Bt + (size_t)nxt.pn * tstepB : cB;
        for (int t = 0; t < nt; t += 2) {
            const bool last = (t == nt - 2);
            const char* a1 = cA + (size_t)(t + 1) * kstep;
            const char* a2 = last ? nA : cA + (size_t)(t + 2) * kstep; const char* b2 = last ? nB : cB + (size_t)(t + 2) * kstep;
            const char* a3 = a2 + kstep; const char* b3 = b2 + kstep;
            PG8_LDB(B0, 0, 0); PG8_LDB(B1, 0, 1); PG8_SCHED; PG8_LDA(At, 0, 0); PG8_STAGE(PG8_SA(1, 1), a1 + hstepA, voffA);
            PG8_WAIT_V(8); PG8_WAIT_L(0); PG8_BAR; PG8_MMA(0, 0, At, B0); PG8_MMA(0, 1, At, B1); PG8_BAR; PG8_SCHED;
            PG8_LDA(At, 0, 1); PG8_STAGE(PG8_SB(0, 0), b2, voffB); PG8_STAGE(PG8_SB(0, 1), b2 + hstepB, voffB); PG8_STAGE(PG8_SA(0, 0), a2, voffA);
            PG8_WAIT_V(8); PG8_WAIT_L(0); PG8_BAR; PG8_MMA(1, 0, At, B0); PG8_MMA(1, 1, At, B1); PG8_BAR; PG8_SCHED;
            PG8_LDB(B0, 1, 0); PG8_LDB(B1, 1, 1); PG8_SCHED; PG8_LDA(At, 1, 0); PG8_STAGE(PG8_SA(0, 1), a2 + hstepA, voffA);
            PG8_WAIT_V(8); PG8_WAIT_L(0); PG8_BAR; PG8_MMA(0, 0, At, B0); PG8_MMA(0, 1, At, B1); PG8_BAR; PG8_SCHED;
            PG8_LDA(At, 1, 1); PG8_STAGE(PG8_SB(1, 0), b3, voffB); PG8_STAGE(PG8_SB(1, 1), b3 + hstepB, voffB); PG8_STAGE(PG8_SA(1, 0), a3, voffA);
            PG8_WAIT_V(8); PG8_WAIT_L(0); PG8_BAR; PG8_MMA(1, 0, At, B0); PG8_MMA(1, 1, At, B1); PG8_BAR; PG8_SCHED;
        }
        if (wr == 0) PG8_BAR;
        E(acc, cur, wr, wc, fr, fq);
        if (!has_next) break;
#pragma unroll
        for (int a = 0; a < 2; ++a)
#pragma unroll
            for (int b = 0; b < 2; ++b)
#pragma unroll
                for (int m = 0; m < 4; ++m)
#pragma unroll
                    for (int n = 0; n < 2; ++n) acc[a][b][m][n] = (f32x4){0.f, 0.f, 0.f, 0.f};
        cur = nxt; cA = nA; cB = nB; ++ui;
        if (wr == 1) PG8_BAR;
    }
    PG8_WAIT_V(0);
    PG8_BAR;
#undef PG8_SA
#undef PG8_SB
#undef PG8_STAGE
#undef PG8_LDA
#undef PG8_LDB
#undef PG8_MMA
#undef PG8_WAIT_V
#undef PG8_WAIT_L
#undef PG8_BAR
#undef PG8_SCHED
}
}


#define XB_TMO      128
#define XB_XCNT(j)  (256  + 64 * (j))
#define XB_XSUB(j)  (1280 + 64 * (j))
#define XB_XGEN(j)  (2304 + 64 * (j))
#define XB_TOP      3328
#define XB_TOPGEN   3392
#define XCD_BAR_WORDS 3456
#define XB_SPIN_CAP (1u << 18)
__device__ __forceinline__ unsigned xb_ld(unsigned* p)              { return __hip_atomic_load(p, __ATOMIC_RELAXED, __HIP_MEMORY_SCOPE_AGENT); }
__device__ __forceinline__ unsigned xb_add(unsigned* p, unsigned v) { return __hip_atomic_fetch_add(p, v, __ATOMIC_RELAXED, __HIP_MEMORY_SCOPE_AGENT); }
__device__ __forceinline__ unsigned xb_xcc_id() { return (unsigned)__builtin_amdgcn_s_getreg((3 << 11) | 20) & 0xFu; }
#define XB_SPIN(cond, bar) do { unsigned _sp = 0; while (cond) { __builtin_amdgcn_s_sleep(1); \
    if ((++_sp & 255u) == 0u) { if (xb_ld(&(bar)[XB_TMO])) break; if (_sp > XB_SPIN_CAP) { atomicAdd(&(bar)[XB_TMO], 1u); break; } } } } while (0)
struct XcdBarrier { unsigned* bar; unsigned x; volatile LAS unsigned* st; };
__device__ __forceinline__ XcdBarrier xcd_barrier_post(unsigned* bar, volatile LAS unsigned* st) {
    XcdBarrier b; b.bar = bar; b.x = xb_xcc_id(); b.st = st;
    if (threadIdx.x == 0) (void)xb_add(&bar[XB_XCNT(b.x)], 1u);
    return b;
}
__device__ __forceinline__ void xcd_barrier_complete(unsigned* bar, unsigned x, unsigned& nloc, unsigned& nx) {
    const unsigned G = gridDim.x * gridDim.y * gridDim.z;
    unsigned sum, cnt, mine, sp = 0u;
    for (;;) {
        sum = 0u; cnt = 0u; mine = 0u;
#pragma unroll
        for (unsigned j = 0; j < 16; ++j) { const unsigned c = xb_ld(&bar[XB_XCNT(j)]); sum += c; cnt += (c > 0u) ? 1u : 0u; mine = (j == x) ? c : mine; }
        if (sum == G) break;
        __builtin_amdgcn_s_sleep(1);
        if ((++sp & 255u) == 0u) { if (xb_ld(&bar[XB_TMO])) break; if (sp > XB_SPIN_CAP) { atomicAdd(&bar[XB_TMO], 1u); break; } }
    }
    nloc = mine > 0u ? mine : 1u; nx = cnt > 0u ? cnt : 1u;
}
__device__ __forceinline__ void xcd_barrier(const XcdBarrier& b) {
    asm volatile("s_waitcnt vmcnt(0)" ::: "memory");
    __syncthreads();
    if (threadIdx.x == 0) {
        unsigned* bar = b.bar;
        __builtin_amdgcn_s_waitcnt(0);
        unsigned nloc = b.st[0], nx = b.st[1];
        if (nloc == 0u) { xcd_barrier_complete(bar, b.x, nloc, nx); b.st[0] = nloc; b.st[1] = nx; }
        const unsigned old = xb_add(&bar[XB_XSUB(b.x)], 1u);
        const unsigned gen = old / nloc;
        if (old + 1u == (gen + 1u) * nloc) {
            __builtin_amdgcn_fence(__ATOMIC_RELEASE, "agent");
            asm volatile("s_waitcnt vmcnt(0)" ::: "memory");
            const unsigned og = xb_add(&bar[XB_TOP], 1u);
            const unsigned tg = og / nx;
            if (og + 1u == (tg + 1u) * nx) xb_add(&bar[XB_TOPGEN], 1u);
            else XB_SPIN(xb_ld(&bar[XB_TOPGEN]) == tg, bar);
            __builtin_amdgcn_fence(__ATOMIC_ACQUIRE, "agent");
            xb_add(&bar[XB_XGEN(b.x)], 1u);
            asm volatile("s_waitcnt vmcnt(0)" ::: "memory");
        } else {
            XB_SPIN(xb_ld(&bar[XB_XGEN(b.x)]) == gen, bar);
            __builtin_amdgcn_fence(__ATOMIC_ACQUIRE, "agent");
            asm volatile("s_waitcnt vmcnt(0)" ::: "memory");
        }
    }
    __syncthreads();
}

struct Args { const float* in[25]; float* out; unsigned char* ws; int ph_lo, ph_hi; };
enum { I_X = 0, I_P, I_F1PRE, I_F1POST, I_F1WIN, I_F1WOUT, I_MPRE, I_MPOST, I_MWIN, I_CONVW, I_ALOG, I_DTB, I_DNG, I_IDXG, I_WBA, I_WBB, I_MWOUT,
       I_F2PRE, I_F2POST, I_F2WIN, I_F2WOUT, I_PPRE, I_PPOST, I_PWG, I_PWP };

__device__ __forceinline__ int srccol(int map, int n) {
    if (map == 0) return n;
    if (map == 1) { const int pn = n >> 8, tc = n & 255; return tc < 128 ? pn * 128 + tc : FF + pn * 128 + (tc - 128); }
    if (n < 2048) return n;
    if (n < 4096) return 2064 + (n - 2048);
    if (n < 6144) return 4184 + (n - 4096);
    const int tc = n - 6144;
    if (tc < 64) return 4112 + tc;
    if (tc < 72) return 2048 + (tc - 64);
    if (tc < 80) return 2056 + (tc - 72);
    if (tc < 88) return 4176 + (tc - 80);
    return -1;
}
__device__ __forceinline__ void transpose_item(const float* W, int K, int N, h16* WT, int NP, int map, float* scr, int item, int lane) {
    const int nblk = NP / 32, kb = item / nblk, nb = item % nblk, k0 = 64 * kb, n0 = 32 * nb;
    const int sc = srccol(map, n0 + (lane & 31));
#pragma unroll 8
    for (int i = 0; i < 32; ++i) { const int kk = 2 * i + (lane >> 5); scr[kk * 33 + (lane & 31)] = sc >= 0 ? W[(size_t)(k0 + kk) * N + sc] : 0.f; }
    LDS_WAIT();
    const int c = lane & 7;
#pragma unroll
    for (int j = 0; j < 4; ++j) { const int n = (lane >> 3) + 8 * j; const float* s = scr + (8 * c) * 33 + n;
        f32x4 a = {s[0], s[33], s[66], s[99]}, b = {s[132], s[165], s[198], s[231]};
        *(u32x4*)(WT + (size_t)(n0 + n) * K + k0 + 8 * c) = pack8(a, b); }
    LDS_WAIT();
}

__device__ __forceinline__ void load_row_f32(const float* p, int lane, f32x4 (&v)[4]) {
#pragma unroll
    for (int j = 0; j < 4; ++j) v[j] = *(const f32x4*)(p + 4 * lane + 256 * j);
}
__device__ __forceinline__ void load_row_h16(const h16* p, int lane, f32x4 (&v)[4]) {
#pragma unroll
    for (int j = 0; j < 4; ++j) { const h16x4 h = *(const h16x4*)(p + 4 * lane + 256 * j); v[j] = (f32x4){(float)h[0], (float)h[1], (float)h[2], (float)h[3]}; }
}
__device__ __forceinline__ float row_rms_scale(const f32x4 (&v)[4]) {
    float s = 0.f;
#pragma unroll
    for (int j = 0; j < 4; ++j) s += (v[j][0] * v[j][0] + v[j][1] * v[j][1]) + (v[j][2] * v[j][2] + v[j][3] * v[j][3]);
    return rsqrtf(wave_sum_dpp(s) * (1.0f / D) + EPS);
}
template <bool BASE_F32, bool FINAL>
__device__ __forceinline__ void resid_norm_phase(const float* xbase, h16* H, const h16* Y, float coef, const float* g_post, const float* g_pre, h16* XN, float* outp, int gw, int ngw, int lane) {
    for (int row = gw; row < T; row += 2 * ngw) {
        f32x4 y[2][4], b[2][4];
#pragma unroll
        for (int u = 0; u < 2; ++u) {
            const size_t ro = (size_t)(row + u * ngw) * D;
            load_row_h16(Y + ro, lane, y[u]);
            if (BASE_F32) load_row_f32(xbase + ro, lane, b[u]); else load_row_h16(H + ro, lane, b[u]);
        }
        f32x4 gp[4]; load_row_f32(g_post, lane, gp);
#pragma unroll
        for (int u = 0; u < 2; ++u) {
            const float r = row_rms_scale(y[u]) * coef;
#pragma unroll
            for (int j = 0; j < 4; ++j) b[u][j] = b[u][j] + y[u][j] * r * gp[j];
        }
        if (FINAL) {
#pragma unroll
            for (int u = 0; u < 2; ++u)
#pragma unroll
                for (int j = 0; j < 4; ++j) *(f32x4*)(outp + (size_t)(row + u * ngw) * D + 4 * lane + 256 * j) = b[u][j];
        } else {
            f32x4 g2[4]; load_row_f32(g_pre, lane, g2);
#pragma unroll
            for (int u = 0; u < 2; ++u) {
                const float r2 = row_rms_scale(b[u]);
                const size_t ro = (size_t)(row + u * ngw) * D;
#pragma unroll
                for (int j = 0; j < 4; ++j) {
                    *(u32x2*)(H + ro + 4 * lane + 256 * j) = pack4(b[u][j]);
                    *(u32x2*)(XN + ro + 4 * lane + 256 * j) = pack4(b[u][j] * r2 * g2[j]);
                }
            }
        }
    }
}

__global__ void __launch_bounds__(NTHREADS, 2) fwd_kernel(Args args) {
    extern __shared__ __attribute__((aligned(16))) unsigned char lds[];
    cg::grid_group grid = cg::this_grid();
    const int G = gridDim.x, bid = blockIdx.x;
    volatile LAS unsigned* xb_st = (volatile LAS unsigned*)((LAS unsigned char*)lds + 153616);
    if (threadIdx.x == 0) { xb_st[0] = 0u; xb_st[1] = 0u; }
    __syncthreads();
    unsigned* xb_words = (unsigned*)(args.ws + 16384);
    XcdBarrier xbar = xcd_barrier_post(xb_words, xb_st);
#ifdef DUP_PHASE
    bool dup_done = false;
#endif
    for (int ph = args.ph_lo; ph < args.ph_hi; ++ph) {
#ifdef PROBE_MASK
    unsigned long long probe_t0 = __builtin_amdgcn_s_memrealtime();
#endif
    int tid = threadIdx.x; asm volatile("" : "+v"(tid));
    __attribute__((address_space(1))) unsigned char* wsg_ = (__attribute__((address_space(1))) unsigned char*)args.ws; asm volatile("" : "+s"(wsg_));
    __attribute__((address_space(1))) float* outg_ = (__attribute__((address_space(1))) float*)args.out; asm volatile("" : "+s"(outg_));
    unsigned char* ws = (unsigned char*)wsg_;
    float* outp_ = (float*)outg_;
    const int lane = tid & 63, wave = __builtin_amdgcn_readfirstlane(tid >> 6);
    const int gw = bid * NWAVES + wave, ngw = G * NWAVES;
    float* ROPE = (float*)(ws + WS_ROPE);
    h16 *W1 = (h16*)(ws + WS_W1), *W2 = (h16*)(ws + WS_W2), *WM = (h16*)(ws + WS_WM), *WBA = (h16*)(ws + WS_WBA), *WBB = (h16*)(ws + WS_WBB), *WO = (h16*)(ws + WS_WO);
    h16 *W3 = (h16*)(ws + WS_W3), *W4 = (h16*)(ws + WS_W4), *WG = (h16*)(ws + WS_WG), *WP = (h16*)(ws + WS_WP);
    h16 *P16 = (h16*)(ws + WS_P16), *XN = (h16*)(ws + WS_XN), *H16 = (h16*)(ws + WS_H16), *HID = (h16*)(ws + WS_HID), *TMP = (h16*)(ws + WS_TMP);
    h16 *QKVA = (h16*)(ws + WS_QKVA), *ZS = (h16*)(ws + WS_ZS), *QKVB = (h16*)(ws + WS_QKVB), *QI = (h16*)(ws + WS_QI), *HALO = (h16*)(ws + WS_HALO), *KI = (h16*)(ws + WS_KI);
    float* MISC = (float*)(ws + WS_MISC);
    unsigned long long* MASK = (unsigned long long*)(ws + WS_MASK);
    const h16* Y = (const h16*)outp_;
    h16* GATES = (h16*)outp_;

        pg8::Gemm g{nullptr, nullptr, T, 0, 0, 0};
        pg8::Epi E; E.mode = -1; E.ws = ws; E.outp = outp_;
        switch (ph) {
        case 0: {
            float* scr = (float*)lds + wave * (64 * 33);
            constexpr int I1 = 16 * (5632 / 32), I2 = 44 * 32, IM = 16 * (NMIX / 32), IB = 8 * 32, IO = 16 * 32, IP = 4 * 32;
            constexpr int NIT = 2 * I1 + 2 * I2 + IM + 2 * IB + 2 * IO + IP;
            for (int it = gw; it < NIT; it += ngw) {
                int r = it;
                if (r < I1) { transpose_item(args.in[I_F1WIN], D, 2 * FF, W1, 2 * FF, 1, scr, r, lane); continue; } r -= I1;
                if (r < I1) { transpose_item(args.in[I_F2WIN], D, 2 * FF, W3, 2 * FF, 1, scr, r, lane); continue; } r -= I1;
                if (r < I2) { transpose_item(args.in[I_F1WOUT], FF, D, W2, D, 0, scr, r, lane); continue; } r -= I2;
                if (r < I2) { transpose_item(args.in[I_F2WOUT], FF, D, W4, D, 0, scr, r, lane); continue; } r -= I2;
                if (r < IM) { transpose_item(args.in[I_MWIN], D, 6232, WM, NMIX, 2, scr, r, lane); continue; } r -= IM;
                if (r < IB) { transpose_item(args.in[I_WBA], 512, D, WBA, D, 0, scr, r, lane); continue; } r -= IB;
                if (r < IB) { transpose_item(args.in[I_WBB], 512, D, WBB, D, 0, scr, r, lane); continue; } r -= IB;
                if (r < IO) { transpose_item(args.in[I_MWOUT], D, D, WO, D, 0, scr, r, lane); continue; } r -= IO;
                if (r < IO) { transpose_item(args.in[I_PWG], D, D, WG, D, 0, scr, r, lane); continue; } r -= IO;
                transpose_item(args.in[I_PWP], PLE, D, WP, D, 0, scr, r, lane);
            }
            { const float* p = args.in[I_P]; const size_t n8 = (size_t)T * PLE / 8;
              for (size_t i = (size_t)bid * NTHREADS + tid; i < n8; i += (size_t)G * NTHREADS) { const f32x4 a = *(const f32x4*)(p + 8 * i), b = *(const f32x4*)(p + 8 * i + 4); *(u32x4*)(P16 + 8 * i) = pack8(a, b); } }
            for (int i = bid * NTHREADS + tid; i < SEQ * 8; i += G * NTHREADS) {
                const int pos = i >> 3, f = i & 7;
                const float invt[8] = {1.0f, 0.1939227432012558f, 0.03760603070259094f, 0.007292664609849453f, 0.0014142135623842478f, 0.00027424818836152554f, 5.3182957344688475e-05f, 1.0313385246263351e-05f};
                float inv = invt[0];
#pragma unroll
                for (int q = 1; q < 8; ++q) inv = (f == q) ? invt[q] : inv;
                const float ang = (float)pos * inv;
                ROPE[pos * 16 + f] = cosf(ang); ROPE[pos * 16 + 8 + f] = sinf(ang);
            }
            { const float* x = args.in[I_X]; const float* gp = args.in[I_F1PRE];
              for (int row = gw; row < T; row += ngw) { f32x4 v[4], gg[4]; load_row_f32(x + (size_t)row * D, lane, v); load_row_f32(gp, lane, gg); const float r = row_rms_scale(v);
#pragma unroll
                  for (int j = 0; j < 4; ++j) *(u32x2*)(XN + (size_t)row * D + 4 * lane + 256 * j) = pack4(v[j] * r * gg[j]); } }
        } break;
        case 1: g = pg8::Gemm{XN, W1, T, 2 * FF, D, D}; E.mode = pg8::EPI_SWIGLU; break;
        case 2: g = pg8::Gemm{HID, W2, T, D, FF, FF}; E.mode = pg8::EPI_F32; break;
        case 3: resid_norm_phase<true, false>(args.in[I_X], H16, Y, 0.5f, args.in[I_F1POST], args.in[I_MPRE], XN, nullptr, gw, ngw, lane); break;
        case 4: g = pg8::Gemm{XN, WM, T, NMIX, D, D}; E.mode = pg8::EPI_MIX; break;
        case 5: {
            const float* cw = args.in[I_CONVW];
            for (int unit = gw; unit < 512 * 3; unit += ngw) {
                const int c = unit / 3, sidx = unit % 3, ch0 = sidx * 512 + 8 * lane;
                float w[4][8];
#pragma unroll
                for (int k = 0; k < 4; ++k) { const f32x4 a = *(const f32x4*)(cw + k * 1536 + ch0), b2 = *(const f32x4*)(cw + k * 1536 + ch0 + 4);
#pragma unroll
                    for (int i = 0; i < 4; ++i) { w[k][i] = a[i]; w[k][4 + i] = b2[i]; } }
                float x3[8], x2[8], x1[8];
#pragma unroll
                for (int i = 0; i < 8; ++i) { x3[i] = 0.f; x2[i] = 0.f; x1[i] = 0.f; }
                if (c & 63) { const h16* hp = HALO + (size_t)(c - 1) * 3 * 1536 + ch0; unpack8(*(const u32x4*)hp, x3); unpack8(*(const u32x4*)(hp + 1536), x2); unpack8(*(const u32x4*)(hp + 2 * 1536), x1); }
                h16* base = QKVA + (size_t)c * 64 * 1536 + ch0;
#pragma unroll 1
                for (int r0 = 0; r0 < 64; r0 += 8) {
                    u32x4 raw[8];
#pragma unroll
                    for (int r = 0; r < 8; ++r) raw[r] = *(const u32x4*)(base + (size_t)(r0 + r) * 1536);
#pragma unroll
                    for (int r = 0; r < 8; ++r) {
                        float x0[8], y[8]; unpack8(raw[r], x0);
                        float ss = 0.f;
#pragma unroll
                        for (int i = 0; i < 8; ++i) { y[i] = siluf_(w[0][i] * x3[i] + w[1][i] * x2[i] + w[2][i] * x1[i] + w[3][i] * x0[i]); ss += y[i] * y[i]; x3[i] = x2[i]; x2[i] = x1[i]; x1[i] = x0[i]; }
                        if (sidx < 2) { ss += __shfl_xor(ss, 1); ss += __shfl_xor(ss, 2); ss += __shfl_xor(ss, 4); const float sc_ = rsqrtf(ss + EPS) * (sidx == 0 ? 0.125f : 1.0f);
#pragma unroll
                            for (int i = 0; i < 8; ++i) y[i] *= sc_; }
                        *(u32x4*)(base + (size_t)(r0 + r) * 1536) = pack8((f32x4){y[0], y[1], y[2], y[3]}, (f32x4){y[4], y[5], y[6], y[7]});
                    }
                }
            }
            { h16* VT = (h16*)(ws + WS_XN);
              h16* tl = (h16*)lds + wave * (64 * 66);
              for (int unit = gw; unit < 64 * 64; unit += ngw) {
                  const int bh = unit >> 6, tt = unit & 63, b = bh >> 3, h = bh & 7;
                  const h16* src = QKVB + ((size_t)b * SEQ + tt * 64 + (lane >> 3)) * 1536 + 1024 + h * 64 + 8 * (lane & 7);
#pragma unroll
                  for (int i = 0; i < 8; ++i) { const h16x8 v = *(const h16x8*)(src + (size_t)(8 * i) * 1536); h16* d = tl + ((lane >> 3) + 8 * i) * 66 + 8 * (lane & 7);
#pragma unroll
                      for (int j = 0; j < 8; j += 2) *(unsigned*)(d + j) = __builtin_bit_cast(unsigned, (__attribute__((ext_vector_type(2))) _Float16){v[j], v[j + 1]}); }
                  LDS_WAIT();
                  h16* dst = VT + ((size_t)bh * 64 + lane) * SEQ + tt * 64;
#pragma unroll
                  for (int c8 = 0; c8 < 8; ++c8) { h16x8 v;
#pragma unroll
                      for (int i = 0; i < 8; ++i) v[i] = tl[(8 * c8 + i) * 66 + lane];
                      *(h16x8*)(dst + 8 * c8) = v; }
                  LDS_WAIT();
              } }
            const float* ig = args.in[I_IDXG];
            for (int row = gw; row < T; row += ngw) {
                float v = MISC[(size_t)row * 96 + lane];
                const float ss = wave_sum(v * v);
                v = v * rsqrtf(ss * (1.0f / 64.0f) + EPS) * ig[lane];
                const float pr = __shfl_xor(v, 8);
                if (lane < 16) { const float* rp = ROPE + (size_t)(row & (SEQ - 1)) * 16; const float c = rp[lane & 7], s = rp[8 + (lane & 7)]; v = lane < 8 ? v * c - pr * s : v * c + pr * s; }
                KI[(size_t)(row >> 5) * 2048 + (lane >> 4) * 512 + ((((lane >> 3) & 1) * 32 + (row & 31)) * 8) + (lane & 7)] = (h16)v;
            }
        } break;
        case 6: {
            typedef float f32x16 __attribute__((ext_vector_type(16)));
            unsigned* sc = (unsigned*)lds;
            const int r32 = lane & 31, hi = lane >> 5;
            u32x4 qnext = {0u, 0u, 0u, 0u}; float wv[2][2][8];
#define IDX_FETCH(kk) do { const int b_ = (kk) & 7, row0_ = b_ * SEQ + (511 - ((kk) >> 3)) * 8; const int R_ = tid >> 3, cq_ = tid & 7; \
                qnext = *(const u32x4*)(QI + (size_t)(row0_ + (R_ >> 3)) * 512 + (R_ & 7) * 64 + 8 * cq_); \
                _Pragma("unroll") for (int mt = 0; mt < 2; ++mt) _Pragma("unroll") for (int qq = 0; qq < 2; ++qq) { const float* wp = MISC + (size_t)(row0_ + 4 * mt + 2 * hi + qq) * 96 + 80; const f32x4 a = *(const f32x4*)wp, c = *(const f32x4*)(wp + 4); \
                    wv[mt][qq][0] = a[0]; wv[mt][qq][1] = a[1]; wv[mt][qq][2] = a[2]; wv[mt][qq][3] = a[3]; wv[mt][qq][4] = c[0]; wv[mt][qq][5] = c[1]; wv[mt][qq][6] = c[2]; wv[mt][qq][7] = c[3]; } } while (0)
#define IDX_STAGE_Q() do { const int R = tid >> 3, cq = tid & 7; *(u32x4*)(lds + 131072 + R * 128 + ((cq ^ (R & 7)) * 16)) = qnext; } while (0)
            IDX_FETCH(bid);
            IDX_STAGE_Q();
            __syncthreads();
            for (int k = bid; k < T / 8; k += G) {
                const int b = k & 7, t0 = (511 - (k >> 3)) * 8, row0 = b * SEQ + t0;
                const int g_ = r32 >> 3, hi_ = (r32 >> 2) & 1, head_ = 4 * (g_ & 1) + (r32 & 3);
                const unsigned char* qrow0 = lds + 131072 + ((2 * hi_ + (g_ >> 1)) * 8 + head_) * 128;
                const int nkt = 2 * ((t0 + 8 + 63) >> 6);
                {
                    const h16* kp0 = KI + (size_t)b * SEQ * 64 + lane * 8;
                    h16x8 kb[4];
#pragma unroll
                    for (int ks = 0; ks < 4; ++ks) kb[ks] = (h16x8){0, 0, 0, 0, 0, 0, 0, 0};
                    if (wave < nkt) {
#pragma unroll
                        for (int ks = 0; ks < 4; ++ks) kb[ks] = *(const h16x8*)(kp0 + (size_t)wave * 2048 + 512 * ks);
                    }
                    h16x8 qa[2][4];
#pragma unroll
                    for (int mt = 0; mt < 2; ++mt)
#pragma unroll
                        for (int ks = 0; ks < 4; ++ks) qa[mt][ks] = *(const h16x8*)(qrow0 + mt * 4096 + (((2 * ks + hi) ^ head_) * 16));
                    for (int kt = wave; kt < nkt; kt += NWAVES) {
                        h16x8 kn[4];
#pragma unroll
                        for (int ks = 0; ks < 4; ++ks) kn[ks] = kb[ks];
                        if (kt + NWAVES < nkt) {
#pragma unroll
                            for (int ks = 0; ks < 4; ++ks) kn[ks] = *(const h16x8*)(kp0 + (size_t)(kt + NWAVES) * 2048 + 512 * ks);
                        }
                        const int key = 32 * kt + r32;
                        f32x16 acc[2];
                        acc[0] = (f32x16){0.f, 0.f, 0.f, 0.f, 0.f, 0.f, 0.f, 0.f, 0.f, 0.f, 0.f, 0.f, 0.f, 0.f, 0.f, 0.f}; acc[1] = acc[0];
#pragma unroll
                        for (int ks = 0; ks < 4; ++ks) {
                            acc[0] = __builtin_amdgcn_mfma_f32_32x32x16_f16(qa[0][ks], kb[ks], acc[0], 0, 0, 0);
                            acc[1] = __builtin_amdgcn_mfma_f32_32x32x16_f16(qa[1][ks], kb[ks], acc[1], 0, 0, 0);
                        }
#pragma unroll
                        for (int mt = 0; mt < 2; ++mt) {
#pragma unroll
                            for (int qq = 0; qq < 2; ++qq) {
                                float sv = 0.f;
#pragma unroll
                                for (int h = 0; h < 8; ++h) {
                                    const int ab = __float_as_int(acc[mt][8 * qq + h]);
                                    sv = fmaf(wv[mt][qq][h], __int_as_float(ab > 0 ? ab : 0), sv);
                                }
                                const int ql = 4 * mt + 2 * hi + qq;
                                unsigned u = __float_as_uint(sv); u = (u & 0x80000000u) ? ~u : (u | 0x80000000u);
                                sc[ql * 4096 + key] = (key <= t0 + ql) ? u : 0u;
                            }
                        }
#pragma unroll
                        for (int ks = 0; ks < 4; ++ks) kb[ks] = kn[ks];
                    }
                }
                {
                    const int nwmax = nkt >> 1, nw16 = (nwmax + 15) & ~15;
                    for (int r = nwmax; r < nw16; ++r) sc[wave * 4096 + r * 64 + lane] = 0u;
                }
                __syncthreads();
                if (k + G < T / 8) IDX_FETCH(k + G);
                {
                    const int wave_s = __builtin_amdgcn_readfirstlane(wave);
                    const int t = t0 + wave_s, n = t + 1, nw = (n + 63) >> 6;
                    const unsigned* scq = sc + wave_s * 4096;
                    const int nv = (nw + 15) >> 4;
                    unsigned uk[64];
#pragma unroll
                    for (int i = 0; i < 16; ++i) uk[i] = scq[i * 64 + lane];
                    if (nv > 1) {
#pragma unroll
                        for (int i = 16; i < 32; ++i) uk[i] = scq[i * 64 + lane];
                    } else {
#pragma unroll
                        for (int i = 16; i < 32; ++i) uk[i] = 0u;
                    }
                    if (nv > 2) {
#pragma unroll
                        for (int i = 32; i < 48; ++i) uk[i] = scq[i * 64 + lane];
                    } else {
#pragma unroll
                        for (int i = 32; i < 48; ++i) uk[i] = 0u;
                    }
                    if (nv > 3) {
#pragma unroll
                        for (int i = 48; i < 64; ++i) uk[i] = scq[i * 64 + lane];
                    } else {
#pragma unroll
                        for (int i = 48; i < 64; ++i) uk[i] = 0u;
                    }
                    unsigned thr = 1u; int need = 0; bool exact = true;
                    if (n > 256) {
                        unsigned prefix = 0u; exact = false;
                        int bit = 31, stage = 0;
#pragma unroll 1
                        for (;;) {
                            const unsigned cand = stage == 0 ? 0xBE000000u : stage == 1 ? 0xC0000000u : (prefix | (1u << bit));
                            const unsigned cm1 = cand - 1u;
                            unsigned c0_ = 0u, c1_ = 0u, c2_ = 0u, c3_ = 0u;
                            int nvl = nv; asm volatile("" : "+s"(nvl));
#define TK_CNT8(i) do { unsigned t0_, t1_, t2_, t3_, t4_, t5_, t6_, t7_; \
                                asm volatile("v_sub_u32_e64 %4, %12, %20 clamp\n\tv_sub_u32_e64 %5, %13, %20 clamp\n\tv_sub_u32_e64 %6, %14, %20 clamp\n\tv_sub_u32_e64 %7, %15, %20 clamp\n\t" \
                                             "v_sub_u32_e64 %8, %16, %20 clamp\n\tv_sub_u32_e64 %9, %17, %20 clamp\n\tv_sub_u32_e64 %10, %18, %20 clamp\n\tv_sub_u32_e64 %11, %19, %20 clamp\n\t" \
                                             "v_min_u32_e32 %4, 1, %4\n\tv_min_u32_e32 %5, 1, %5\n\tv_min_u32_e32 %6, 1, %6\n\tv_min_u32_e32 %7, 1, %7\n\t" \
                                             "v_min_u32_e32 %8, 1, %8\n\tv_min_u32_e32 %9, 1, %9\n\tv_min_u32_e32 %10, 1, %10\n\tv_min_u32_e32 %11, 1, %11\n\t" \
                                             "v_add3_u32 %0, %0, %4, %5\n\tv_add3_u32 %1, %1, %6, %7\n\tv_add3_u32 %2, %2, %8, %9\n\tv_add3_u32 %3, %3, %10, %11" \
                                             : "+v"(c0_), "+v"(c1_), "+v"(c2_), "+v"(c3_), "=&v"(t0_), "=&v"(t1_), "=&v"(t2_), "=&v"(t3_), "=&v"(t4_), "=&v"(t5_), "=&v"(t6_), "=&v"(t7_) \
                                             : "v"(uk[i]), "v"(uk[(i) + 1]), "v"(uk[(i) + 2]), "v"(uk[(i) + 3]), "v"(uk[(i) + 4]), "v"(uk[(i) + 5]), "v"(uk[(i) + 6]), "v"(uk[(i) + 7]), "s"(cm1)); } while (0)
                            TK_CNT8(0); TK_CNT8(8);
                            if (nvl > 1) { TK_CNT8(16); TK_CNT8(24);
                                if (nvl > 2) { TK_CNT8(32); TK_CNT8(40);
                                    if (nvl > 3) { TK_CNT8(48); TK_CNT8(56); } } }
#undef TK_CNT8
                            const unsigned cl = (c0_ + c1_) + (c2_ + c3_);
                            const int cnt = wave_sum_dpp_i((int)cl);
                            if (cnt == 256) { thr = cand; exact = true; break; }
                            const bool gt = cnt > 256, s2 = stage == 2, brk = stage == 1 && !gt;
                            prefix = s2 ? (gt ? cand : prefix) : (brk ? 0xBE000000u : prefix);
                            bit = s2 ? bit - 1 : (brk ? 24 : bit);
                            stage = stage == 0 ? (gt ? 1 : 2) : 2;
                            if (bit < 0) break;
                        }
                        if (!exact) {
                            thr = prefix;
                            int cg_ = 0;
#pragma unroll
                            for (int i = 0; i < 64; ++i) cg_ += __popcll(__ballot(uk[i] > thr));
                            need = 256 - cg_;
                        }
                    }
                    unsigned long long* mrow = MASK + (size_t)b * 64 * SEQ + (t0 + wave);
                    unsigned long long mine = 0ull;
                    if (exact) {
                        int mlo = 0, mhi = 0;
#define TK_EMIT4(i) do { unsigned long long m0_, m1_, m2_, m3_; \
                            asm volatile("v_cmp_le_u32_e64 %0, %4, %5\n\tv_cmp_le_u32_e64 %1, %4, %6\n\tv_cmp_le_u32_e64 %2, %4, %7\n\tv_cmp_le_u32_e64 %3, %4, %8" \
                                         : "=&s"(m0_), "=&s"(m1_), "=&s"(m2_), "=&s"(m3_) : "s"(thr), "v"(uk[i]), "v"(uk[(i) + 1]), "v"(uk[(i) + 2]), "v"(uk[(i) + 3])); \
                            asm volatile("s_nop 3\n\tv_writelane_b32 %0, %2, %10\n\tv_writelane_b32 %1, %3, %10\n\tv_writelane_b32 %0, %4, %11\n\tv_writelane_b32 %1, %5, %11\n\t" \
                                         "v_writelane_b32 %0, %6, %12\n\tv_writelane_b32 %1, %7, %12\n\tv_writelane_b32 %0, %8, %13\n\tv_writelane_b32 %1, %9, %13" \
                                         : "+v"(mlo), "+v"(mhi) \
                                         : "s"((unsigned)m0_), "s"((unsigned)(m0_ >> 32)), "s"((unsigned)m1_), "s"((unsigned)(m1_ >> 32)), "s"((unsigned)m2_), "s"((unsigned)(m2_ >> 32)), "s"((unsigned)m3_), "s"((unsigned)(m3_ >> 32)), \
                                           "i"(i), "i"((i) + 1), "i"((i) + 2), "i"((i) + 3)); } while (0)
#define TK_EMIT16(b) do { TK_EMIT4(b); TK_EMIT4((b) + 4); TK_EMIT4((b) + 8); TK_EMIT4((b) + 12); } while (0)
                        TK_EMIT16(0);
                        if (nv > 1) { TK_EMIT16(16);
                            if (nv > 2) { TK_EMIT16(32);
                                if (nv > 3) TK_EMIT16(48); } }
#undef TK_EMIT16
#undef TK_EMIT4
                        mine = ((unsigned long long)(unsigned)mhi << 32) | (unsigned)mlo;
                    } else {
                        int running = 0;
#pragma unroll
                        for (int i = 0; i < 64; ++i) {
                            const bool gt = uk[i] > thr, eq = uk[i] == thr;
                            const unsigned long long beq = __ballot(eq);
                            const int rank = running + __popcll(beq & ((1ull << lane) - 1ull));
                            const bool take = gt || (eq && rank < need);
                            running += __popcll(beq);
                            const unsigned long long mm = __ballot(take);
                            if (lane == i) mine = mm;
                        }
                    }
                    mrow[(size_t)lane * SEQ] = mine;
                }
                if (k + G < T / 8) IDX_STAGE_Q();
                __syncthreads();
            }
#undef IDX_STAGE_Q
        } break;
#undef IDX_FETCH
        case 7: {
            typedef float f32x16 __attribute__((ext_vector_type(16)));
            h16* Lw = (h16*)((float*)lds + wave * (2048 + 128));
            float* sg = (float*)lds + wave * (2048 + 128) + 2048; float* sb = sg + 64;
            h16* WB = (h16*)(ws + WS_XN + 32 * MiB); h16* KDT = (h16*)(ws + WS_QI);
            const int lane_p = lane;
            for (int unit = gw; unit < 4096; unit += ngw) {
                int lane = lane_p; asm volatile("" : "+v"(lane));
                const int r32 = lane & 31, hi = lane >> 5;
                const int c = unit >> 3, h = unit & 7; const size_t row0 = (size_t)c * 64;
                float* mg = MISC + (row0 + lane) * 96 + 64 + h;
                float gc, bt;
                {
                    const float xx_ = mg[0] + args.in[I_DTB][h];
                    const float sp = xx_ > 20.f ? xx_ : log1pf(expf(xx_));
                    gc = -expf(args.in[I_ALOG][h]) * sp;
                    bt = 1.0f / (1.0f + expf(-mg[8]));
                }
#pragma unroll
                for (int o = 1; o < 64; o <<= 1) { const float v = __shfl_up(gc, o); if (lane >= o) gc += v; }
                sg[lane] = gc; sb[lane] = bt;
                const float gc63 = __shfl(gc, 63);
                h16* qbase = QKVA + row0 * 1536 + h * 64;
                h16x8 ak[2][4], bq[2][4];
                { const h16* fp = qbase + (size_t)r32 * 1536 + 8 * hi;
#pragma unroll
                  for (int rt = 0; rt < 2; ++rt)
#pragma unroll
                      for (int ks = 0; ks < 4; ++ks) { ak[rt][ks] = *(const h16x8*)(fp + (size_t)rt * 32 * 1536 + 512 + 16 * ks); bq[rt][ks] = *(const h16x8*)(fp + (size_t)rt * 32 * 1536 + 16 * ks); } }
                LDS_WAIT();
#pragma unroll
                for (int tile = 0; tile < 3; ++tile) {
                    const int rt = tile == 0 ? 0 : 1, ct = tile == 2 ? 1 : 0;
                    f32x16 acc;
#pragma unroll
                    for (int i = 0; i < 16; ++i) acc[i] = 0.f;
#pragma unroll
                    for (int ks = 0; ks < 4; ++ks) acc = __builtin_amdgcn_mfma_f32_32x32x16_f16(ak[rt][ks], ak[ct][ks], acc, 0, 0, 0);
                    const int tp = 32 * ct + r32; const float gcol = sg[tp];
#pragma unroll
                    for (int i = 0; i < 16; ++i) { const int t = 32 * rt + (i & 3) + 8 * (i >> 2) + 4 * hi;
                        Lw[t * 64 + tp] = (h16)((t > tp) ? sb[t] * acc[i] * __expf(sg[t] - gcol) : 0.f); }
                }
                u32x2 xt[3][4];
#pragma unroll
                for (int tile = 0; tile < 3; ++tile) {
                    const int rt = tile == 2 ? 1 : 0, ct = tile == 0 ? 0 : 1;
                    f32x16 acc;
#pragma unroll
                    for (int i = 0; i < 16; ++i) acc[i] = 0.f;
#pragma unroll
                    for (int ks = 0; ks < 4; ++ks) acc = __builtin_amdgcn_mfma_f32_32x32x16_f16(ak[rt][ks], bq[ct][ks], acc, 0, 0, 0);
                    const int t = 32 * ct + r32; const float gcol = sg[t];
#pragma unroll
                    for (int g4 = 0; g4 < 4; ++g4) { f32x4 v4;
#pragma unroll
                        for (int i = 0; i < 4; ++i) { const int tp = 32 * rt + i + 8 * g4 + 4 * hi; v4[i] = (t >= tp) ? acc[4 * g4 + i] * __expf(gcol - sg[tp]) : 0.f; }
                        xt[tile][g4] = pack4(v4); }
                }
                {
                    h16* qw = qbase + (size_t)r32 * 1536 + 8 * hi;
#pragma unroll
                    for (int rt = 0; rt < 2; ++rt) { const float sc_ = __expf(sg[32 * rt + r32]);
#pragma unroll
                        for (int ks = 0; ks < 4; ++ks) { h16x8 v;
#pragma unroll
                            for (int i = 0; i < 8; ++i) v[i] = (h16)((float)bq[rt][ks][i] * sc_);
                            *(h16x8*)(qw + (size_t)rt * 32 * 1536 + 16 * ks) = v; } }
                }
                float xx[64];
                { const gh16* kp = (const gh16*)(qbase + 512 + lane);
#pragma unroll
                  for (int t = 0; t < 64; ++t) { xx[t] = (float)*kp; kp += 1536; asm volatile("" : "+v"(kp)); } }
                {
                    h16* kd = KDT + ((size_t)unit * 64 + lane) * 64;
#pragma unroll
                    for (int c8 = 0; c8 < 8; ++c8) { f32x4 a, b2;
#pragma unroll
                        for (int i = 0; i < 4; ++i) { a[i] = xx[8 * c8 + i] * __expf(gc63 - sg[8 * c8 + i]); b2[i] = xx[8 * c8 + 4 + i] * __expf(gc63 - sg[8 * c8 + 4 + i]); }
                        *(u32x4*)(kd + 8 * c8) = pack8(a, b2); }
                }
#pragma unroll
                for (int tile = 0; tile < 3; ++tile) {
                    const int rt = tile == 2 ? 1 : 0, ct = tile == 0 ? 0 : 1;
                    h16* xp = qbase + (size_t)(32 * ct + r32) * 1536 + 512 + 32 * rt + 4 * hi;
#pragma unroll
                    for (int g4 = 0; g4 < 4; ++g4) *(u32x2*)(xp + 8 * g4) = xt[tile][g4];
                }
#define FWD_SUBST(X) do { _Pragma("unroll") for (int i = 1; i < 64; ++i) { float a_ = X[i]; \
                    _Pragma("unroll") for (int j4 = 0; j4 < (i + 3) / 4; ++j4) { const h16x4 l4 = *(const h16x4*)(Lw + i * 64 + 4 * j4); \
                        _Pragma("unroll") for (int jj = 0; jj < 4; ++jj) if (4 * j4 + jj < i) a_ -= (float)l4[jj] * X[4 * j4 + jj]; } \
                    X[i] = a_; if ((i & 3) == 3) asm volatile("" ::: "memory"); } } while (0)
#pragma unroll
                for (int t = 0; t < 64; ++t) xx[t] *= sb[t] * __expf(sg[t]);
                FWD_SUBST(xx);
                { gh16* wp = (gh16*)(WB + (size_t)unit * 4096 + lane);
#pragma unroll
                  for (int t = 0; t < 64; ++t) { *wp = (h16)xx[t]; wp += 64; asm volatile("" : "+v"(wp)); } }
                { const gh16* vp = (const gh16*)(qbase + 1024 + lane);
#pragma unroll
                  for (int t = 0; t < 64; ++t) { xx[t] = (float)*vp * sb[t]; vp += 1536; asm volatile("" : "+v"(vp)); } }
                FWD_SUBST(xx);
#undef FWD_SUBST
                {
                    h16* up = qbase + (size_t)lane * 1536 + 1024;
#pragma unroll
                    for (int c8 = 0; c8 < 8; ++c8) { const f32x4 a = {xx[8 * c8], xx[8 * c8 + 1], xx[8 * c8 + 2], xx[8 * c8 + 3]}, b2 = {xx[8 * c8 + 4], xx[8 * c8 + 5], xx[8 * c8 + 6], xx[8 * c8 + 7]};
                        *(u32x4*)(up + 8 * c8) = pack8(a, b2); }
                }
                mg[0] = gc;
                LDS_WAIT();
            }
        } break;
        case 8: {
            typedef float f32x16 __attribute__((ext_vector_type(16)));
            const int r32 = lane & 31, hi = lane >> 5;
            const int srow = tid >> 3, sch = tid & 7;
            if (bid < 64) {
                constexpr int MB = 8704, BUFB = 5 * MB;
                const int b = bid >> 3, h = bid & 7;
                const h16* WB = (const h16*)(ws + WS_XN + 32 * MiB); const h16* KDT = (const h16*)(ws + WS_QI);
                if (wave < 2) {
                    __syncthreads();
                    f32x16 St[2];
#pragma unroll
                    for (int i = 0; i < 16; ++i) { St[0][i] = 0.f; St[1][i] = 0.f; }
#pragma unroll 1
                    for (int c = 0; c < 64; ++c) {
                        const int cur = c & 1;
                        const float e63 = __expf(MISC[((size_t)b * SEQ + c * 64 + 63) * 96 + 64 + h]);
                        const unsigned char* B_ = lds + cur * BUFB;
                        const int koff = 8 * hi;
                        h16x8 sf[2][2];
#pragma unroll
                        for (int rt = 0; rt < 2; ++rt)
#pragma unroll
                            for (int s2 = 0; s2 < 2; ++s2)
#pragma unroll
                                for (int j = 0; j < 8; ++j) sf[rt][s2][j] = (h16)St[rt][8 * s2 + j];
                        f32x16 P[2], O[2];
#pragma unroll
                        for (int i = 0; i < 16; ++i) { P[0][i] = 0.f; P[1][i] = 0.f; O[0][i] = 0.f; O[1][i] = 0.f; }
#define FRAG(mI, row, kel) ({ const unsigned char* fp_ = B_ + (mI) * MB + (row) * 136 + (kel) * 2 + koff; const h16x4 lo_ = *(const h16x4*)fp_, hi_ = *(const h16x4*)(fp_ + 16); \
                              (h16x8){lo_[0], lo_[1], lo_[2], lo_[3], hi_[0], hi_[1], hi_[2], hi_[3]}; })
#pragma unroll
                        for (int tt = 0; tt < 2; ++tt)
#pragma unroll
                            for (int rt = 0; rt < 2; ++rt)
#pragma unroll
                                for (int s2 = 0; s2 < 2; ++s2) {
                                    const h16x8 aw = FRAG(1, 32 * tt + r32, 32 * rt + 16 * s2), aq = FRAG(0, 32 * tt + r32, 32 * rt + 16 * s2);
                                    P[tt] = __builtin_amdgcn_mfma_f32_32x32x16_f16(aw, sf[rt][s2], P[tt], 0, 0, 0);
                                    O[tt] = __builtin_amdgcn_mfma_f32_32x32x16_f16(aq, sf[rt][s2], O[tt], 0, 0, 0);
                                }
                        f32x16 Vn[2];
#pragma unroll
                        for (int tt = 0; tt < 2; ++tt)
#pragma unroll
                            for (int g4 = 0; g4 < 4; ++g4) { const h16x4 u4 = *(const h16x4*)(B_ + 4 * MB + (32 * wave + r32) * 136 + (32 * tt + 8 * g4) * 2 + koff);
#pragma unroll
                                for (int i = 0; i < 4; ++i) Vn[tt][4 * g4 + i] = (float)u4[i] - P[tt][4 * g4 + i]; }
                        h16x8 vf[2][2];
#pragma unroll
                        for (int tt = 0; tt < 2; ++tt)
#pragma unroll
                            for (int s2 = 0; s2 < 2; ++s2)
#pragma unroll
                                for (int j = 0; j < 8; ++j) vf[tt][s2][j] = (h16)Vn[tt][8 * s2 + j];
#pragma unroll
                        for (int tt = 0; tt < 2; ++tt)
#pragma unroll
                            for (int t2 = 0; t2 <= tt; ++t2)
#pragma unroll
                                for (int s2 = 0; s2 < 2; ++s2) { const h16x8 ax = FRAG(2, 32 * tt + r32, 32 * t2 + 16 * s2); O[tt] = __builtin_amdgcn_mfma_f32_32x32x16_f16(ax, vf[t2][s2], O[tt], 0, 0, 0); }
#pragma unroll
                        for (int rt = 0; rt < 2; ++rt) {
#pragma unroll
                            for (int i = 0; i < 16; ++i) St[rt][i] *= e63;
#pragma unroll
                            for (int t2 = 0; t2 < 2; ++t2)
#pragma unroll
                                for (int s2 = 0; s2 < 2; ++s2) { const h16x8 akd = FRAG(3, 32 * rt + r32, 32 * t2 + 16 * s2); St[rt] = __builtin_amdgcn_mfma_f32_32x32x16_f16(akd, vf[t2][s2], St[rt], 0, 0, 0); }
                        }
#undef FRAG
                        h16* op = QKVA + ((size_t)b * SEQ + c * 64 + 4 * hi) * 1536 + 1024 + h * 64 + 32 * wave + r32;
#pragma unroll
                        for (int tt = 0; tt < 2; ++tt)
#pragma unroll
                            for (int i = 0; i < 16; ++i) op[(size_t)(32 * tt + (i & 3) + 8 * (i >> 2)) * 1536] = (h16)O[tt][i];
                                            __syncthreads();
                    }
                } else {
                    const int mI = wave - 2;
                    const bool slot = (mI & 1) == 0;
                    const h16* gb = slot ? QKVA + (size_t)b * SEQ * 1536 + h * 64 + (mI >> 1) * 512 : (mI == 1 ? WB : KDT) + ((size_t)(b * 64) * 8 + h) * 4096;
                    const size_t rstr = slot ? 1536 : 64, cstr = slot ? (size_t)64 * 1536 : (size_t)8 * 4096;
                    gb += (size_t)(lane >> 3) * rstr + 8 * (lane & 7);
                    unsigned char* lw = lds + (mI < 5 ? mI : 0) * MB + (lane >> 3) * 136 + (lane & 7) * 16;
                    u32x4 rA[8], rB[8], rC[8];
#define SCAN_LOAD(R, cc) do { const h16* p_ = gb + (size_t)(cc) * cstr; _Pragma("unroll") for (int i_ = 0; i_ < 8; ++i_) R[i_] = *(const u32x4*)(p_ + (size_t)(8 * i_) * rstr); } while (0)
#define SCAN_WRITE(R, bufi) do { _Pragma("unroll") for (int i_ = 0; i_ < 8; ++i_) { unsigned char* d_ = lw + (bufi) * BUFB + i_ * (8 * 136); *(u32x2*)d_ = (u32x2){R[i_][0], R[i_][1]}; *(u32x2*)(d_ + 8) = (u32x2){R[i_][2], R[i_][3]}; } } while (0)
#pragma unroll
                    for (int i_ = 0; i_ < 8; ++i_) { rA[i_] = (u32x4){0u, 0u, 0u, 0u}; rB[i_] = rA[i_]; rC[i_] = rA[i_]; }
                    if (mI < 5) { SCAN_LOAD(rA, 0); SCAN_LOAD(rB, 1); SCAN_LOAD(rC, 2); SCAN_WRITE(rA, 0); SCAN_LOAD(rA, 3); }
                    __syncthreads();
#pragma unroll 1
                    for (int c3 = 0; c3 < 66; c3 += 3) {
#pragma unroll
                        for (int cs = 0; cs < 3; ++cs) {
                            const int c = c3 + cs;
                            if (c < 64) {
                                if (mI < 5) {
                                    if (cs == 0) { if (c + 1 < 64) SCAN_WRITE(rB, (c + 1) & 1); if (c + 4 < 64) SCAN_LOAD(rB, c + 4); }
                                    else if (cs == 1) { if (c + 1 < 64) SCAN_WRITE(rC, (c + 1) & 1); if (c + 4 < 64) SCAN_LOAD(rC, c + 4); }
                                    else { if (c + 1 < 64) SCAN_WRITE(rA, (c + 1) & 1); if (c + 4 < 64) SCAN_LOAD(rA, c + 4); }
                                }
                                __syncthreads();
                            }
                        }
                    }
#undef SCAN_LOAD
#undef SCAN_WRITE
                }
                asm volatile("s_waitcnt vmcnt(0)" ::: "memory");
                __syncthreads();
                __builtin_amdgcn_fence(__ATOMIC_ACQUIRE, "agent");
                asm volatile("s_waitcnt vmcnt(0)" ::: "memory");
                {
                    const float* dg = args.in[I_DNG];
                    float gg[8];
#pragma unroll
                    for (int i = 0; i < 8; ++i) gg[i] = dg[(lane & 7) * 8 + i];
                    for (int t0 = wave * 8 + (lane >> 3); t0 < SEQ; t0 += 256) {
                        u32x4 ov[4], zv[4];
#pragma unroll
                        for (int u = 0; u < 4; ++u) { const size_t rw = (size_t)b * SEQ + t0 + 64 * u;
                            ov[u] = *(const u32x4*)(QKVA + rw * 1536 + 1024 + h * 64 + (lane & 7) * 8); zv[u] = *(const u32x4*)(ZS + rw * 512 + h * 64 + (lane & 7) * 8); }
#pragma unroll
                        for (int u = 0; u < 4; ++u) {
                            float o[8], z[8]; unpack8(ov[u], o); unpack8(zv[u], z);
                            float ss = 0.f;
#pragma unroll
                            for (int i = 0; i < 8; ++i) ss += o[i] * o[i];
                            ss = sum8_dpp(ss);
                            const float r = rsqrtf(ss * (1.0f / 64.0f) + EPS);
                            f32x4 a0, a1;
#pragma unroll
                            for (int i = 0; i < 4; ++i) { a0[i] = o[i] * r * gg[i] * z[i]; a1[i] = o[4 + i] * r * gg[4 + i] * z[4 + i]; }
                            *(u32x4*)(QKVA + ((size_t)b * SEQ + t0 + 64 * u) * 1536 + 1024 + h * 64 + (lane & 7) * 8) = pack8(a0, a1);
                        }
                    }
                }
            }
            {
                unsigned char* kbuf = lds;
                unsigned char* vbuf = lds + 32768;
                volatile int* qslot = (volatile int*)(lds + 153600);
                unsigned* qctr = (unsigned*)ws;
                const unsigned* MASK32 = (const unsigned*)MASK;
                const h16* VT = (const h16*)(ws + WS_XN);
                const int kws = srow * 128 + ((sch ^ (srow & 7)) * 16), vws = srow * 136 + sch * 16;
                for (;;) {
                    __syncthreads();
                    if (tid == 0) *qslot = (int)__hip_atomic_fetch_add(qctr, 1u, __ATOMIC_RELAXED, __HIP_MEMORY_SCOPE_AGENT);
                    __syncthreads();
                    const int u = __builtin_amdgcn_readfirstlane(*qslot);
                    if (u >= 1024) break;
                    {
                        const int qb = 15 - (u >> 6), bh = u & 63, b = bh >> 3, h = bh & 7, q0 = qb * 256;
                        const int qrow = b * SEQ + q0 + 32 * wave + r32;
                        h16x8 qf[4];
                        { const h16* qp = QKVB + (size_t)qrow * 1536 + h * 64 + 8 * hi;
#pragma unroll
                          for (int ks = 0; ks < 4; ++ks) { const h16x8 t8 = *(const h16x8*)(qp + 16 * ks);
#pragma unroll
                              for (int i = 0; i < 8; ++i) qf[ks][i] = (h16)((float)t8[i] * 1.4426950408889634f); } }
                        f32x16 o[2];
#pragma unroll
                        for (int i = 0; i < 16; ++i) { o[0][i] = 0.f; o[1][i] = 0.f; }
                        float mref = 0.f, l = 0.f; f32x16 negm;
#pragma unroll
                        for (int i = 0; i < 16; ++i) negm[i] = 0.f;
                        const int nkt = 4 * qb + 4;
                        const h16* kg = QKVB + ((size_t)b * SEQ + srow) * 1536 + 512 + h * 64 + 8 * sch;
                        const h16* vg = VT + ((size_t)bh * 64 + srow) * SEQ + 8 * sch;
                        const h16* kgs = QKVB + ((size_t)b * SEQ + srow) * 1536 + 512 + h * 64 + 8 * (sch ^ ((srow >> 1) & 7));
#define ATT_KDMA(tile, slot) __builtin_amdgcn_global_load_lds((const unsigned*)(kgs + (size_t)(tile) * 64 * 1536), (LAS unsigned*)((LAS unsigned char*)lds + (slot) * 8192 + wave * 1024), 16, 0, 0)
                        u32x4 vreg[2];
#pragma unroll
                        for (int j = 0; j < 2; ++j) vreg[j] = *(const u32x4*)(vg + j * 64);
                        __syncthreads();
                        ATT_KDMA(0, 0); ATT_KDMA(1, 1);
#pragma unroll
                        for (int j = 0; j < 2; ++j) { unsigned char* vd = vbuf + j * 8704 + vws; *(u32x2*)vd = (u32x2){vreg[j][0], vreg[j][1]}; *(u32x2*)(vd + 8) = (u32x2){vreg[j][2], vreg[j][3]}; }
                        asm volatile("s_waitcnt vmcnt(0)" ::: "memory");
                        __syncthreads();
                        const int wq_last = q0 + 32 * wave + 31;
                        const int npair = nkt >> 1;
                        const unsigned* mq = MASK32 + ((size_t)b * 64 * SEQ + (q0 + 32 * wave + r32)) * 2;
                        u32x4 mnext; { const u32x2 ta = *(const u32x2*)mq, tb = *(const u32x2*)(mq + 2 * SEQ); mnext = (u32x4){ta[0], ta[1], tb[0], tb[1]}; }
                        for (int kp = 0; kp < npair; ++kp) {
                            const int cur = kp & 1;
                            if (kp + 1 < npair) {
                                ATT_KDMA(2 * kp + 2, 2 * (cur ^ 1)); ATT_KDMA(2 * kp + 3, 2 * (cur ^ 1) + 1);
#pragma unroll
                                for (int j = 0; j < 2; ++j) vreg[j] = *(const u32x4*)(vg + (2 * kp + 2 + j) * 64);
                            }
                            if (128 * kp <= wq_last) {
                                const unsigned mw[4] = {mnext[0] >> (4 * hi), mnext[1] >> (4 * hi), mnext[2] >> (4 * hi), mnext[3] >> (4 * hi)};
                                if (128 * (kp + 1) <= wq_last) { const u32x2 ta = *(const u32x2*)(mq + (size_t)(2 * kp + 2) * 2 * SEQ), tb = *(const u32x2*)(mq + (size_t)(2 * kp + 3) * 2 * SEQ); mnext = (u32x4){ta[0], ta[1], tb[0], tb[1]}; }
                                f32x16 S[4];
#pragma unroll
                                for (int j = 0; j < 2; ++j) {
                                    const unsigned char* kb_ = kbuf + (2 * cur + j) * 8192 + r32 * 128;
#pragma unroll
                                    for (int ks = 0; ks < 4; ++ks) {
                                        const int off = ((2 * ks + hi) ^ ((r32 >> 1) & 7)) * 16;
                                        const h16x8 a0 = *(const h16x8*)(kb_ + off), a1 = *(const h16x8*)(kb_ + 4096 + off);
                                        S[2 * j] = __builtin_amdgcn_mfma_f32_32x32x16_f16(a0, qf[ks], ks == 0 ? negm : S[2 * j], 0, 0, 0);
                                        S[2 * j + 1] = __builtin_amdgcn_mfma_f32_32x32x16_f16(a1, qf[ks], ks == 0 ? negm : S[2 * j + 1], 0, 0, 0);
                                    }
                                    __builtin_amdgcn_sched_barrier(0);
                                }

                                float mx = S[0][0];
#pragma unroll
                                for (int i = 0; i < 16; ++i) { mx = fmaxf(mx, fmaxf(S[0][i], S[1][i])); mx = fmaxf(mx, fmaxf(S[2][i], S[3][i])); }
                                mx = fmaxf(mx, __shfl_xor(mx, 32));
                                if (kp == 0 || __any(mx > 8.0f)) {
                                    const float d = kp == 0 ? mx : fmaxf(mx, 0.f), alpha = __builtin_amdgcn_exp2f(-d);
                                    mref += d; l *= alpha;
#pragma unroll
                                    for (int i = 0; i < 16; ++i) { S[0][i] -= d; S[1][i] -= d; S[2][i] -= d; S[3][i] -= d; o[0][i] *= alpha; o[1][i] *= alpha; negm[i] = -mref; }
                                }
                                float ps = 0.f;
#pragma unroll
                                for (int rt = 0; rt < 4; ++rt)
#pragma unroll
                                    for (int i = 0; i < 16; ++i) {
                                        float e = __builtin_amdgcn_exp2f(S[rt][i]);
                                        int bm;
                                        asm("v_bfe_i32 %0, %1, %2, 1" : "=v"(bm) : "v"(mw[rt]), "i"((i & 3) + 8 * (i >> 2)));
                                        e = __uint_as_float(__float_as_uint(e) & (unsigned)bm);
                                        ps += e; S[rt][i] = e;
                                    }
                                l += ps;
#pragma unroll
                                for (int j = 0; j < 2; ++j) {
                                    const unsigned char* vb_ = vbuf + (2 * cur + j) * 8704 + r32 * 136 + 8 * hi;
#pragma unroll
                                    for (int rt = 0; rt < 2; ++rt)
#pragma unroll
                                        for (int s2 = 0; s2 < 2; ++s2) {
                                            h16x8 pb;
#pragma unroll
                                            for (int jj = 0; jj < 8; ++jj) pb[jj] = (h16)S[2 * j + rt][8 * s2 + jj];
#pragma unroll
                                            for (int dt = 0; dt < 2; ++dt) {
                                                const unsigned char* vp = vb_ + dt * (32 * 136) + (32 * rt + 16 * s2) * 2;
                                                const h16x4 lo = *(const h16x4*)vp, hi4 = *(const h16x4*)(vp + 16);
                                                const h16x8 va = {lo[0], lo[1], lo[2], lo[3], hi4[0], hi4[1], hi4[2], hi4[3]};
                                                o[dt] = __builtin_amdgcn_mfma_f32_32x32x16_f16(va, pb, o[dt], 0, 0, 0);
                                            }
                                        }
                                }
                            }
                            if (kp + 1 < npair) {
#pragma unroll
                                for (int j = 0; j < 2; ++j) { unsigned char* vd = vbuf + (2 * (cur ^ 1) + j) * 8704 + vws;
                                    *(u32x2*)vd = (u32x2){vreg[j][0], vreg[j][1]}; *(u32x2*)(vd + 8) = (u32x2){vreg[j][2], vreg[j][3]}; }
                            }
                            asm volatile("s_waitcnt vmcnt(0)" ::: "memory");
                            __syncthreads();
                        }
#undef ATT_KDMA
                        l += __shfl_xor(l, 32);
                        const float inv = 1.0f / l;
                        h16* op = QKVB + (size_t)qrow * 1536 + h * 64 + 4 * hi;
#pragma unroll
                        for (int dt = 0; dt < 2; ++dt)
#pragma unroll
                            for (int g4 = 0; g4 < 4; ++g4) {
                                const f32x4 v4 = {o[dt][4 * g4] * inv, o[dt][4 * g4 + 1] * inv, o[dt][4 * g4 + 2] * inv, o[dt][4 * g4 + 3] * inv};
                                *(u32x2*)(op + 32 * dt + 8 * g4) = pack4(v4);
                            }
                    }
                }
            }
        } break;
        case 9: g = pg8::Gemm{QKVA + 1024, WBA, T, D, 512, 1536}; E.mode = pg8::EPI_BRA; break;
        case 10: g = pg8::Gemm{QKVB, WBB, T, D, 512, 1536}; E.mode = pg8::EPI_BRB; break;
        case 11: g = pg8::Gemm{XN, WO, T, D, D, D}; E.mode = pg8::EPI_F32; break;
        case 12: resid_norm_phase<false, false>(nullptr, H16, Y, 1.0f, args.in[I_MPOST], args.in[I_F2PRE], XN, nullptr, gw, ngw, lane); break;
        case 13: g = pg8::Gemm{XN, W3, T, 2 * FF, D, D}; E.mode = pg8::EPI_SWIGLU; break;
        case 14: g = pg8::Gemm{HID, W4, T, D, FF, FF}; E.mode = pg8::EPI_F32; break;
        case 15: resid_norm_phase<false, false>(nullptr, H16, Y, 0.5f, args.in[I_F2POST], args.in[I_PPRE], XN, nullptr, gw, ngw, lane); break;
        case 16: g = pg8::Gemm{XN, WG, T, D, D, D}; E.mode = pg8::EPI_PLEG; break;
        case 17: g = pg8::Gemm{P16, WP, T, D, PLE, PLE}; E.mode = pg8::EPI_PLEP; break;
        case 18: resid_norm_phase<false, true>(nullptr, H16, (const h16*)(ws + WS_E16), 1.0f, args.in[I_PPOST], nullptr, nullptr, outp_, gw, ngw, lane); break;
        default: break;
        }
        if (E.mode >= 0) { pg8::StaticOrder S; S.init(T, g.N, G, bid); pg8::gemm_phase((LAS unsigned char*)lds, g, S, E, tid); }
#ifdef DUP_PHASE
        if (ph == DUP_PHASE && !dup_done) { dup_done = true; --ph; }
#endif
        if (ph + 1 < args.ph_hi) {
            if (args.ph_lo < 0) grid.sync();
            if (ph == 9 || ph == 16) { asm volatile("s_waitcnt vmcnt(0)" ::: "memory"); __syncthreads(); }
            else xcd_barrier(xbar);
        }
#ifdef PROBE_MASK
        if (((PROBE_MASK >> ph) & 1) && bid == 0) { __syncthreads(); if (tid == 0) { const unsigned long long t1 = __builtin_amdgcn_s_memrealtime(); const unsigned long long dt = (t1 - probe_t0) * PROBE_MULT;
            while (__builtin_amdgcn_s_memrealtime() - t1 < dt) __builtin_amdgcn_s_sleep(32); } __syncthreads(); }
#endif
    }
}

constexpr int NPHASES = 19;

extern "C" void kernel_launch(void* const* d_in, const int* in_sizes, int n_in, void* d_out, int out_size, void* d_ws, size_t ws_size, hipStream_t stream) {
    static int grid = 0;
    if (grid == 0) {
        if (n_in != 25 || in_sizes[0] != T * D || out_size != T * D || ws_size < WS_END || ws_size < WS_HID + (size_t)T * FF * 2) {
            fprintf(stderr, "kernel_launch: unexpected shapes / workspace (n_in %d, in0 %d, out %d, ws %zu); nothing launched\n", n_in, n_in > 0 ? in_sizes[0] : -1, out_size, ws_size); grid = -1; return; }
        int dev = 0, cus = 0, per_cu = 0;
        hipGetDevice(&dev);
        hipDeviceGetAttribute(&cus, hipDeviceAttributeMultiprocessorCount, dev);
        hipFuncSetAttribute((const void*)fwd_kernel, hipFuncAttributeMaxDynamicSharedMemorySize, LDS_BYTES);
        hipOccupancyMaxActiveBlocksPerMultiprocessor(&per_cu, (const void*)fwd_kernel, NTHREADS, LDS_BYTES);
        if (per_cu < 1) { fprintf(stderr, "kernel_launch: occupancy query says %d blocks per CU\n", per_cu); per_cu = 1; }
        if (per_cu > 1) per_cu = 1;
        grid = cus * per_cu;
        (void)hipGetLastError();
    }
    if (grid < 0) return;
    if (hipMemsetAsync(d_ws, 0, 65536, stream) != hipSuccess) { fprintf(stderr, "kernel_launch: hipMemsetAsync of the control words failed\n"); return; }
    Args a{};
    for (int i = 0; i < 25; ++i) a.in[i] = (const float*)d_in[i];
    a.out = (float*)d_out; a.ws = (unsigned char*)d_ws;
#if MK_PER_PHASE
    for (int ph = 0; ph < NPHASES; ++ph) {
        a.ph_lo = ph; a.ph_hi = ph + 1;
        void* kargs[] = {&a};
        hipError_t e = hipLaunchCooperativeKernel((const void*)fwd_kernel, dim3(grid), dim3(NTHREADS), kargs, LDS_BYTES, stream);
        if (e != hipSuccess) { fprintf(stderr, "launch failed: %s\n", hipGetErrorString(e)); break; }
    }
#else
    a.ph_lo = 0; a.ph_hi = NPHASES;
    void* kargs[] = {&a};
    hipError_t e = hipLaunchCooperativeKernel((const void*)fwd_kernel, dim3(grid), dim3(NTHREADS), kargs, LDS_BYTES, stream);
    if (e != hipSuccess) fprintf(stderr, "cooperative launch failed: %s (grid %d)\n", hipGetErrorString(e), grid);
#endif
}
```

```cpp
#include <hip/hip_runtime.h>
#include <hip/hip_cooperative_groups.h>
#include <cstdio>
#include <cstdint>
namespace cg = cooperative_groups;

#ifndef MK_PER_PHASE
#define MK_PER_PHASE 0
#endif

constexpr int T = 32768, D = 1024, FF = 2816, SEQ = 4096, NBATCH = 8, PLE = 256;
constexpr int NMIX = 6400;
constexpr float EPS = 1e-6f;
constexpr int NWAVES = 8, NTHREADS = 512;
constexpr int LDS_BYTES = 155648;

typedef _Float16 h16;
typedef _Float16 h16x8 __attribute__((ext_vector_type(8)));
typedef _Float16 h16x4 __attribute__((ext_vector_type(4)));
typedef short s16x8 __attribute__((ext_vector_type(8)));
typedef float f32x4 __attribute__((ext_vector_type(4)));
typedef unsigned u32x4 __attribute__((ext_vector_type(4)));
typedef unsigned u32x2 __attribute__((ext_vector_type(2)));
typedef __attribute__((address_space(1))) _Float16 gh16;
#define LAS __attribute__((address_space(3)))

constexpr size_t MiB = 1u << 20;
constexpr size_t WS_ROPE = 1 * MiB;
constexpr size_t WS_RS = 1 * MiB + 512 * 1024;
constexpr int RS_LDS = 139264;
constexpr size_t WS_W1 = 2 * MiB;
constexpr size_t WS_W2 = WS_W1 + 11 * MiB;
constexpr size_t WS_WM = WS_W2 + 11 * MiB / 2;
constexpr size_t WS_WBA = WS_WM + 25 * MiB / 2;
constexpr size_t WS_WBB = WS_WBA + 1 * MiB;
constexpr size_t WS_WO = WS_WBB + 1 * MiB;
constexpr size_t WS_W3 = WS_WO + 2 * MiB;
constexpr size_t WS_W4 = WS_W3 + 11 * MiB;
constexpr size_t WS_WG = WS_W4 + 11 * MiB / 2;
constexpr size_t WS_WP = WS_WG + 2 * MiB;
constexpr size_t WS_P16 = 54 * MiB;
constexpr size_t WS_XN = 70 * MiB;
constexpr size_t WS_H16 = 134 * MiB;
constexpr size_t WS_ARENA = 198 * MiB;
constexpr size_t WS_HID = WS_ARENA;
constexpr size_t WS_TMP = WS_ARENA;
constexpr size_t WS_E16 = WS_ARENA + 64 * MiB;
constexpr size_t WS_QKVA = WS_ARENA;
constexpr size_t WS_ZS = WS_QKVA + 96 * MiB;
constexpr size_t WS_QKVB = WS_ZS + 32 * MiB;
constexpr size_t WS_QI = WS_QKVB + 96 * MiB;
constexpr size_t WS_MISC = WS_QI + 32 * MiB;
constexpr size_t WS_MASK = WS_MISC + 12 * MiB;
constexpr size_t WS_HALO = WS_MASK + 16 * MiB;
constexpr size_t WS_KI = WS_HALO + 5 * MiB;
constexpr size_t WS_END = WS_KI + 4 * MiB;
static_assert(WS_WP + MiB / 2 <= WS_P16 && WS_END <= 512 * MiB && WS_HID + (size_t)T * FF * 2 <= 512 * MiB, "ws map");

__device__ __forceinline__ float sigmoidf_(float x) { return __builtin_amdgcn_rcpf(1.0f + __builtin_amdgcn_exp2f(-1.4426950408889634f * x)); }
__device__ __forceinline__ float siluf_(float x) { return x * __builtin_amdgcn_rcpf(1.0f + __builtin_amdgcn_exp2f(-1.4426950408889634f * x)); }
__device__ __forceinline__ u32x4 pack8(f32x4 a, f32x4 b) {
    h16x8 h = {(h16)a[0], (h16)a[1], (h16)a[2], (h16)a[3], (h16)b[0], (h16)b[1], (h16)b[2], (h16)b[3]};
    return __builtin_bit_cast(u32x4, h);
}
__device__ __forceinline__ u32x2 pack4(f32x4 a) {
    h16x4 h = {(h16)a[0], (h16)a[1], (h16)a[2], (h16)a[3]};
    return __builtin_bit_cast(u32x2, h);
}
__device__ __forceinline__ void unpack8(u32x4 w, float (&f)[8]) {
    h16x8 h = __builtin_bit_cast(h16x8, w);
#pragma unroll
    for (int i = 0; i < 8; ++i) f[i] = (float)h[i];
}
__device__ __forceinline__ float wave_sum(float v) {
#pragma unroll
    for (int o = 1; o < 64; o <<= 1) v += __shfl_xor(v, o);
    return v;
}
__device__ __forceinline__ float wave_sum_dpp(float v) {
#define DPP_ADD(ctrl, rmask) v += __builtin_bit_cast(float, __builtin_amdgcn_update_dpp(0, __builtin_bit_cast(int, v), ctrl, rmask, 0xF, false))
    DPP_ADD(0xB1, 0xF);
    DPP_ADD(0x4E, 0xF);
    DPP_ADD(0x141, 0xF);
    DPP_ADD(0x140, 0xF);
    DPP_ADD(0x142, 0xA);
    DPP_ADD(0x143, 0xC);
#undef DPP_ADD
    return __builtin_bit_cast(float, __builtin_amdgcn_readlane(__builtin_bit_cast(int, v), 63));
}
__device__ __forceinline__ int wave_sum_dpp_i(int v) {
#define DPP_ADDI(ctrl, rmask) v += __builtin_amdgcn_update_dpp(0, v, ctrl, rmask, 0xF, false)
    DPP_ADDI(0xB1, 0xF); DPP_ADDI(0x4E, 0xF); DPP_ADDI(0x141, 0xF); DPP_ADDI(0x140, 0xF); DPP_ADDI(0x142, 0xA); DPP_ADDI(0x143, 0xC);
#undef DPP_ADDI
    return __builtin_amdgcn_readlane(v, 63);
}
__device__ __forceinline__ float sum8_dpp(float v) {
    v += __builtin_bit_cast(float, __builtin_amdgcn_update_dpp(0, __builtin_bit_cast(int, v), 0xB1, 0xF, 0xF, false));
    v += __builtin_bit_cast(float, __builtin_amdgcn_update_dpp(0, __builtin_bit_cast(int, v), 0x4E, 0xF, 0xF, false));
    v += __builtin_bit_cast(float, __builtin_amdgcn_update_dpp(0, __builtin_bit_cast(int, v), 0x141, 0xF, 0xF, false));
    return v;
}
__device__ __forceinline__ int wave_sum_i(int v) {
#pragma unroll
    for (int o = 1; o < 64; o <<= 1) v += __shfl_xor(v, o);
    return v;
}
#define LDS_WAIT() asm volatile("s_waitcnt lgkmcnt(0)" ::: "memory")

namespace pg8 {
constexpr int BM = 256, BK = 64, HALF = 128, HTB = HALF * BK * 2, STAGE_BYTES = 8 * HTB, NXCD = 8, WGM = 4;
__host__ __device__ __forceinline__ int lds_byte(int r, int c) { const int st = (r >> 4) * 2 + (c >> 5), rr = r & 15, cc = c & 31, ob = rr * 64 + cc * 2; return st * 1024 + (ob ^ (((ob >> 9) & 1) << 5)); }
__host__ __device__ __forceinline__ void stage_rc(int b, int& R, int& C) { const int st = b / 1024, sb = b % 1024, swz = sb ^ (((sb >> 9) & 1) << 5); R = (st >> 1) * 16 + swz / 64; C = (st & 1) * 32 + (swz % 64) / 2; }
__host__ __device__ __forceinline__ int perm32(int rho) { const int n = rho >> 4, i = rho & 15; return 8 * (i >> 2) + 4 * n + (i & 3); }
struct Unit { int pm, pn; };
struct Gemm { const h16* A; const h16* Bt; int M, N, K, lda; };
struct StaticOrder {
    int nM, nN, nwg, G, c;
    __device__ void init(int M, int N, int G_, int c_) { nM = M / BM; nN = N / BM; nwg = nM * nN; G = G_; c = c_; }
    __device__ bool next(int i, Unit& u) const {
        const long L = (long)i * G + c; if (L >= nwg) return false;
        int wgid = (int)L; { const int q = nwg / NXCD, r = nwg % NXCD, xcd = wgid % NXCD, off = wgid / NXCD; wgid = (xcd < r ? xcd * (q + 1) : r * (q + 1) + (xcd - r) * q) + off; }
        const int nig = WGM * nN, gid = wgid / nig, fm = gid * WGM, gsz = (nM - fm) < WGM ? (nM - fm) : WGM;
        u.pm = fm + ((wgid % nig) % gsz); u.pn = (wgid % nig) / gsz; return true;
    }
};

enum { EPI_SWIGLU = 0, EPI_F32 = 1, EPI_MIX = 2, EPI_BRA = 3, EPI_BRB = 4, EPI_PLEG = 5, EPI_PLEP = 6 };
struct Epi {
    int mode; unsigned char* ws; float* outp;
    __device__ __forceinline__ void operator()(const f32x4 (&acc)[2][2][4][2], const Unit& u, int wr, int wc, int fr, int fq, const LAS float* rsl) const {
        const int cb = wc * 32 + 8 * fq;
        const int row0 = u.pm * BM + wr * 64 + fr;
        h16* const o16 = (h16*)(ws + (mode == EPI_SWIGLU ? WS_HID : mode == EPI_PLEG ? WS_TMP : WS_XN));
        const int ldo = mode == EPI_SWIGLU ? FF : D;
        const h16* const g16 = mode == EPI_PLEP ? (const h16*)(ws + WS_TMP) : (const h16*)outp;
        h16* const qkva = (h16*)(ws + WS_QKVA); h16* const zs = (h16*)(ws + WS_ZS); h16* const qkvb = (h16*)(ws + WS_QKVB); h16* const qi = (h16*)(ws + WS_QI);
        h16* const gates = (h16*)outp; h16* const halo = (h16*)(ws + WS_HALO); float* const misc = (float*)(ws + WS_MISC); const float* const rope = (const float*)(ws + WS_ROPE);
        if (mode == EPI_SWIGLU) {
#pragma unroll
            for (int ai = 0; ai < 2; ++ai)
#pragma unroll
                for (int m = 0; m < 4; ++m) {
                    const int row = row0 + ai * HALF + m * 16;
                    const float rs = rsl[wr * 64 + fr + ai * HALF + m * 16];
                    f32x4 r0, r1;
#pragma unroll
                    for (int i = 0; i < 4; ++i) { r0[i] = siluf_(acc[ai][0][m][0][i] * rs) * (acc[ai][1][m][0][i] * rs); r1[i] = siluf_(acc[ai][0][m][1][i] * rs) * (acc[ai][1][m][1][i] * rs); }
                    *(u32x4*)(o16 + (size_t)row * ldo + u.pn * 128 + cb) = pack8(r0, r1);
                }
        } else if (mode == EPI_F32) {
#pragma unroll
            for (int ai = 0; ai < 2; ++ai)
#pragma unroll
                for (int m = 0; m < 4; ++m) {
                    const int row = row0 + ai * HALF + m * 16;
#pragma unroll
                    for (int bj = 0; bj < 2; ++bj) *(u32x4*)((h16*)outp + (size_t)row * D + u.pn * BM + bj * HALF + cb) = pack8(acc[ai][bj][m][0], acc[ai][bj][m][1]);
                }
        } else if (mode == EPI_BRA || mode == EPI_BRB || mode == EPI_PLEP) {
#define EPI_GATED_LOOP(GSTRIDE, GOFF, RMW, ...) do { \
            _Pragma("unroll") for (int ab = 0; ab < 4; ++ab) { const int ai = ab >> 1, mb = 2 * (ab & 1); \
                u32x4 gv_[4], ov_[4]; \
                _Pragma("unroll") for (int mm = 0; mm < 2; ++mm) _Pragma("unroll") for (int bj = 0; bj < 2; ++bj) { const int m = mb + mm, row = row0 + ai * HALF + m * 16, col = u.pn * BM + bj * HALF + cb; \
                    gv_[2 * mm + bj] = *(const u32x4*)(g16 + (size_t)row * (GSTRIDE) + (GOFF) + col); \
                    ov_[2 * mm + bj] = (RMW) ? *(const u32x4*)(o16 + (size_t)row * ldo + col) : gv_[2 * mm + bj]; } \
                _Pragma("unroll") for (int mm = 0; mm < 2; ++mm) _Pragma("unroll") for (int bj = 0; bj < 2; ++bj) { const int m = mb + mm, row = row0 + ai * HALF + m * 16, col = u.pn * BM + bj * HALF + cb; \
                    float g[8]; unpack8(gv_[2 * mm + bj], g); \
                    f32x4 r0, r1; \
                    _Pragma("unroll") for (int i = 0; i < 4; ++i) { r0[i] = g[i] * acc[ai][bj][m][0][i]; r1[i] = g[4 + i] * acc[ai][bj][m][1][i]; } \
                    if (RMW) { float o[8]; unpack8(ov_[2 * mm + bj], o); _Pragma("unroll") for (int i = 0; i < 4; ++i) { r0[i] += o[i]; r1[i] += o[4 + i]; } } \
                    __VA_ARGS__ } } } while (0)
            if (mode == EPI_PLEP) EPI_GATED_LOOP(1024, 0, false, { *(u32x4*)((h16*)(ws + WS_E16) + (size_t)row * D + col) = pack8(r0, r1); });
            else if (mode == EPI_BRA) EPI_GATED_LOOP(2048, 0, false, { *(u32x4*)(o16 + (size_t)row * ldo + col) = pack8(r0, r1); });
            else EPI_GATED_LOOP(2048, 1024, true, { *(u32x4*)(o16 + (size_t)row * ldo + col) = pack8(r0, r1); });
#undef EPI_GATED_LOOP
        } else if (mode == EPI_PLEG) {
#pragma unroll
            for (int ai = 0; ai < 2; ++ai)
#pragma unroll
                for (int m = 0; m < 4; ++m) {
                    const int row = row0 + ai * HALF + m * 16;
                    const float rs = rsl[wr * 64 + fr + ai * HALF + m * 16];
#pragma unroll
                    for (int bj = 0; bj < 2; ++bj) {
                        f32x4 r0, r1;
#pragma unroll
                        for (int i = 0; i < 4; ++i) { r0[i] = sigmoidf_(acc[ai][bj][m][0][i] * rs); r1[i] = sigmoidf_(acc[ai][bj][m][1][i] * rs); }
                        *(u32x4*)(o16 + (size_t)row * ldo + u.pn * BM + bj * HALF + cb) = pack8(r0, r1);
                    }
                }
        } else {
            const int pn = u.pn;
#define MIX_LOOP(...) do { \
            _Pragma("unroll") for (int ai = 0; ai < 2; ++ai) _Pragma("unroll") for (int m = 0; m < 4; ++m) { const int row = row0 + ai * HALF + m * 16; \
                const float rs = rsl[wr * 64 + fr + ai * HALF + m * 16]; \
                _Pragma("unroll") for (int bj = 0; bj < 2; ++bj) { const int tc = bj * HALF + cb; \
                    f32x4 v0 = acc[ai][bj][m][0] * rs, v1 = acc[ai][bj][m][1] * rs; \
                    __VA_ARGS__ } } } while (0)
            if (pn < 6) {
                MIX_LOOP({ const u32x4 w = pack8(v0, v1);
                    *(u32x4*)(qkva + (size_t)row * 1536 + pn * 256 + tc) = w;
                    if ((row & 63) >= 61) *(u32x4*)(halo + ((size_t)(row >> 6) * 3 + ((row & 63) - 61)) * 1536 + pn * 256 + tc) = w; });
            } else if (pn < 8) {
                MIX_LOOP({
                    _Pragma("unroll") for (int i = 0; i < 4; ++i) { v0[i] = siluf_(v0[i]); v1[i] = siluf_(v1[i]); }
                    *(u32x4*)(zs + (size_t)row * 512 + (pn - 6) * 256 + tc) = pack8(v0, v1); });
            } else if (pn < 16) {
                const bool rope_tile = (pn < 12) || (pn >= 14);
                const float qsc = pn < 10 ? 0.125f : 1.0f;
                h16* const dbase = pn < 14 ? qkvb + (pn - 8) * 256 : qi + (pn - 14) * 256;
                const int dld = pn < 14 ? 1536 : 512;
                if (rope_tile && !(wc & 1)) {
#pragma unroll
                    for (int ab = 0; ab < 4; ++ab) { const int ai = ab >> 1, mb = 2 * (ab & 1);
                        f32x4 rc0[2], rc1[2], rs0[2], rs1[2];
#pragma unroll
                        for (int mm = 0; mm < 2; ++mm) { const int row = row0 + ai * HALF + (mb + mm) * 16; const float* rp = rope + (size_t)(row & (SEQ - 1)) * 16;
                            rc0[mm] = (f32x4){0.f, 0.f, 0.f, 0.f}; rc1[mm] = rc0[mm]; rs0[mm] = rc0[mm]; rs1[mm] = rc0[mm];
                            if (fq < 2) { rc0[mm] = *(const f32x4*)rp; rc1[mm] = *(const f32x4*)(rp + 4); rs0[mm] = *(const f32x4*)(rp + 8); rs1[mm] = *(const f32x4*)(rp + 12); } }
#pragma unroll
                        for (int mm = 0; mm < 2; ++mm) { const int m = mb + mm; const int row = row0 + ai * HALF + m * 16;
                            const float rs = rsl[wr * 64 + fr + ai * HALF + m * 16];
#pragma unroll
                            for (int bj = 0; bj < 2; ++bj) { const int tc = bj * HALF + cb;
                                f32x4 v0 = acc[ai][bj][m][0] * rs, v1 = acc[ai][bj][m][1] * rs;
                                f32x4 p0, p1;
#pragma unroll
                                for (int i = 0; i < 4; ++i) { p0[i] = __shfl_xor(v0[i], 16); p1[i] = __shfl_xor(v1[i], 16); }
                                if (fq < 2) {
                                    const float sg = fq == 0 ? -1.f : 1.f;
#pragma unroll
                                    for (int i = 0; i < 4; ++i) { v0[i] = v0[i] * rc0[mm][i] + sg * p0[i] * rs0[mm][i]; v1[i] = v1[i] * rc1[mm][i] + sg * p1[i] * rs1[mm][i]; }
                                }
                                v0 = v0 * qsc; v1 = v1 * qsc;
                                *(u32x4*)(dbase + (size_t)row * dld + tc) = pack8(v0, v1); } }
                    }
                } else if (rope_tile) {
                    MIX_LOOP({ v0 = v0 * qsc; v1 = v1 * qsc; *(u32x4*)(dbase + (size_t)row * dld + tc) = pack8(v0, v1); });
                } else {
                    MIX_LOOP({ *(u32x4*)(dbase + (size_t)row * dld + tc) = pack8(v0, v1); });
                }
            } else if (pn < 24) {
                MIX_LOOP({
                    _Pragma("unroll") for (int i = 0; i < 4; ++i) { v0[i] = sigmoidf_(v0[i]); v1[i] = sigmoidf_(v1[i]); }
                    *(u32x4*)(gates + (size_t)row * 2048 + (pn - 16) * 256 + tc) = pack8(v0, v1); });
            } else {
                MIX_LOOP({
                    if (bj == 0) {
                        float* mp = misc + (size_t)row * 96;
                        if (wc < 2) { *(f32x4*)(mp + tc) = v0; *(f32x4*)(mp + tc + 4) = v1; }
                        else if (wc == 2 && fq < 3) {
                            float r[8] = {v0[0], v0[1], v0[2], v0[3], v1[0], v1[1], v1[2], v1[3]};
                            if (fq == 2) {
                                _Pragma("unroll") for (int i = 0; i < 8; ++i) r[i] *= 0.04419417382415922f;
                            }
                            *(f32x4*)(mp + 64 + 8 * fq) = (f32x4){r[0], r[1], r[2], r[3]}; *(f32x4*)(mp + 68 + 8 * fq) = (f32x4){r[4], r[5], r[6], r[7]};
                        }
                    } });
            }
#undef MIX_LOOP
        }
    }
};

__device__ __forceinline__ void gemm_phase(LAS unsigned char* lds, const Gemm g, const StaticOrder& S, const Epi& E, const int tid) {
    const int wid = __builtin_amdgcn_readfirstlane(tid >> 6), lane = tid & 63, wr = wid >> 2, wc = wid & 3, fr = lane & 15, fq = lane >> 4;
    const int K = g.K, nt = K / BK, lda = g.lda;
    const bool need_rs = E.mode == EPI_SWIGLU || E.mode == EPI_MIX || E.mode == EPI_PLEG;
    unsigned voffA[2], voffB[2];
#pragma unroll
    for (int i = 0; i < 2; ++i) { int R, C; stage_rc(tid * 16 + i * 8192, R, C); const int Rb = (R & ~31) + perm32(R & 31);
        voffA[i] = (unsigned)(R * lda + C) * 2u; voffB[i] = (unsigned)(Rb * K + C) * 2u; }
    const size_t kstep = (size_t)(BK * 2);
    const size_t hstepA = (size_t)HALF * lda * 2, hstepB = (size_t)HALF * K * 2;
    const size_t tstepA = 2 * hstepA, tstepB = 2 * hstepB;
    const unsigned ldsw = (unsigned)wid * 1024u;
    const int aoff = lds_byte(wr * 64 + fr, fq * 8), boff = lds_byte(wc * 32 + fr, fq * 8);
#define PG8_SA(b, h) (((b) * 2 + (h)) * HTB)
#define PG8_SB(b, h) ((4 + (b) * 2 + (h)) * HTB)
#define PG8_STAGE(bufoff, gbase, voff) do { _Pragma("unroll") for (int _i = 0; _i < 2; ++_i) \
        __builtin_amdgcn_global_load_lds((const unsigned*)((const char*)(gbase) + (voff)[_i]), (LAS unsigned*)(lds + (bufoff) + ldsw + _i * 8192), 16, 0, 0); } while (0)
#define PG8_LDA(dst, b, h) do { _Pragma("unroll") for (int m = 0; m < 4; ++m) _Pragma("unroll") for (int k = 0; k < 2; ++k) dst[m][k] = *(const LAS s16x8*)(lds + PG8_SA(b, h) + aoff + m * 2048 + k * 1024); } while (0)
#define PG8_LDB(dst, b, h) do { _Pragma("unroll") for (int n = 0; n < 2; ++n) _Pragma("unroll") for (int k = 0; k < 2; ++k) dst[n][k] = *(const LAS s16x8*)(lds + PG8_SB(b, h) + boff + n * 2048 + k * 1024); } while (0)
#define PG8_MMA(ai, bj, At, Bt) do { __builtin_amdgcn_s_setprio(1); _Pragma("unroll") for (int m = 0; m < 4; ++m) _Pragma("unroll") for (int n = 0; n < 2; ++n) _Pragma("unroll") for (int k = 0; k < 2; ++k) \
        acc[ai][bj][m][n] = __builtin_amdgcn_mfma_f32_16x16x32_f16(__builtin_bit_cast(h16x8, Bt[n][k]), __builtin_bit_cast(h16x8, At[m][k]), acc[ai][bj][m][n], 0, 0, 0); __builtin_amdgcn_s_setprio(0); } while (0)
#define PG8_WAIT_V(n) asm volatile("s_waitcnt vmcnt(" #n ")" ::: "memory")
#define PG8_WAIT_L(n) asm volatile("s_waitcnt lgkmcnt(" #n ")" ::: "memory")
#define PG8_BAR __builtin_amdgcn_s_barrier()
#define PG8_SCHED __builtin_amdgcn_sched_barrier(0)
    Unit cur, nxt; int ui = 0;
    if (!S.next(0, cur)) return;
    f32x4 acc[2][2][4][2];
#pragma unroll
    for (int a = 0; a < 2; ++a)
#pragma unroll
        for (int b = 0; b < 2; ++b)
#pragma unroll
            for (int m = 0; m < 4; ++m)
#pragma unroll
                for (int n = 0; n < 2; ++n) acc[a][b][m][n] = (f32x4){0.f, 0.f, 0.f, 0.f};
    s16x8 At[4][2], B0[2][2], B1[2][2];
    const char* cA = (const char*)g.A + (size_t)cur.pm * tstepA; const char* cB = (const char*)g.Bt + (size_t)cur.pn * tstepB;
    PG8_STAGE(PG8_SB(0, 0), cB, voffB); PG8_STAGE(PG8_SB(0, 1), cB + hstepB, voffB); PG8_STAGE(PG8_SA(0, 0), cA, voffA); PG8_STAGE(PG8_SA(0, 1), cA + hstepA, voffA);
    if (wr == 1) PG8_BAR;
    PG8_WAIT_V(2); PG8_BAR;
    PG8_STAGE(PG8_SB(1, 0), cB + kstep, voffB); PG8_STAGE(PG8_SA(1, 0), cA + kstep, voffA); PG8_STAGE(PG8_SB(1, 1), cB + hstepB + kstep, voffB);
    PG8_WAIT_V(6); PG8_BAR;
    for (;;) {
        if (need_rs && wid < 4) __builtin_amdgcn_global_load_lds((const unsigned*)((const float*)(E.ws + WS_RS) + (size_t)cur.pm * BM + wid * 64 + lane), (LAS unsigned*)(lds + RS_LDS + (ui & 1) * 1024 + wid * 256), 4, 0, 0);
        const bool has_next = S.next(ui + 1, nxt);
        const char* nA = has_next ? (const char*)g.A + (size_t)nxt.pm * tstepA : cA; const char* nB = has_next ? (const char*)g.Bt + (size_t)nxt.pn * tstepB : cB;
        for (int t = 0; t < nt; t += 2) {
            const bool last = (t == nt - 2);
            const char* a1 = cA + (size_t)(t + 1) * kstep;
            const char* a2 = last ? nA : cA + (size_t)(t + 2) * kstep; const char* b2 = last ? nB : cB + (size_t)(t + 2) * kstep;
            const char* a3 = a2 + kstep; const char* b3 = b2 + kstep;
            PG8_LDB(B0, 0, 0); PG8_LDB(B1, 0, 1); PG8_SCHED; PG8_LDA(At, 0, 0); PG8_STAGE(PG8_SA(1, 1), a1 + hstepA, voffA);
            PG8_WAIT_V(8); PG8_WAIT_L(0); PG8_BAR; PG8_MMA(0, 0, At, B0); PG8_MMA(0, 1, At, B1); PG8_BAR; PG8_SCHED;
            PG8_LDA(At, 0, 1); PG8_STAGE(PG8_SB(0, 0), b2, voffB); PG8_STAGE(PG8_SB(0, 1), b2 + hstepB, voffB); PG8_STAGE(PG8_SA(0, 0), a2, voffA);
            PG8_WAIT_V(8); PG8_WAIT_L(0); PG8_BAR; PG8_MMA(1, 0, At, B0); PG8_MMA(1, 1, At, B1); PG8_BAR; PG8_SCHED;
            PG8_LDB(B0, 1, 0); PG8_LDB(B1, 1, 1); PG8_SCHED; PG8_LDA(At, 1, 0); PG8_STAGE(PG8_SA(0, 1), a2 + hstepA, voffA);
            PG8_WAIT_V(8); PG8_WAIT_L(0); PG8_BAR; PG8_MMA(0, 0, At, B0); PG8_MMA(0, 1, At, B1); PG8_BAR; PG8_SCHED;
            PG8_LDA(At, 1, 1); PG8_STAGE(PG8_SB(1, 0), b3, voffB); PG8_STAGE(PG8_SB(1, 1), b3 + hstepB, voffB); PG8_STAGE(PG8_SA(1, 0), a3, voffA);
            PG8_WAIT_V(8); PG8_WAIT_L(0); PG8_BAR; PG8_MMA(1, 0, At, B0); PG8_MMA(1, 1, At, B1); PG8_BAR; PG8_SCHED;
        }
        if (wr == 0) PG8_BAR;
        E(acc, cur, wr, wc, fr, fq, (const LAS float*)(lds + RS_LDS + (ui & 1) * 1024));
        if (!has_next) break;
#pragma unroll
        for (int a = 0; a < 2; ++a)
#pragma unroll
            for (int b = 0; b < 2; ++b)
#pragma unroll
                for (int m = 0; m < 4; ++m)
#pragma unroll
                    for (int n = 0; n < 2; ++n) acc[a][b][m][n] = (f32x4){0.f, 0.f, 0.f, 0.f};
        cur = nxt; cA = nA; cB = nB; ++ui;
        if (wr == 1) PG8_BAR;
    }
    PG8_WAIT_V(0);
    PG8_BAR;
#undef PG8_SA
#undef PG8_SB
#undef PG8_STAGE
#undef PG8_LDA
#undef PG8_LDB
#undef PG8_MMA
#undef PG8_WAIT_V
#undef PG8_WAIT_L
#undef PG8_BAR
#undef PG8_SCHED
}
}


#define XB_TMO      128
#define XB_XCNT(j)  (256  + 64 * (j))
#define XB_XSUB(j)  (1280 + 64 * (j))
#define XB_XGEN(j)  (2304 + 64 * (j))
#define XB_TOP      3328
#define XB_TOPGEN   3392
#define XCD_BAR_WORDS 3456
#define XB_SPIN_CAP (1u << 18)
__device__ __forceinline__ unsigned xb_ld(unsigned* p)              { return __hip_atomic_load(p, __ATOMIC_RELAXED, __HIP_MEMORY_SCOPE_AGENT); }
__device__ __forceinline__ unsigned xb_add(unsigned* p, unsigned v) { return __hip_atomic_fetch_add(p, v, __ATOMIC_RELAXED, __HIP_MEMORY_SCOPE_AGENT); }
__device__ __forceinline__ unsigned xb_xcc_id() { return (unsigned)__builtin_amdgcn_s_getreg((3 << 11) | 20) & 0xFu; }
#define XB_SPIN(cond, bar) do { unsigned _sp = 0; while (cond) { __builtin_amdgcn_s_sleep(1); \
    if ((++_sp & 255u) == 0u) { if (xb_ld(&(bar)[XB_TMO])) break; if (_sp > XB_SPIN_CAP) { atomicAdd(&(bar)[XB_TMO], 1u); break; } } } } while (0)
struct XcdBarrier { unsigned* bar; unsigned x; volatile LAS unsigned* st; };
__device__ __forceinline__ XcdBarrier xcd_barrier_post(unsigned* bar, volatile LAS unsigned* st) {
    XcdBarrier b; b.bar = bar; b.x = xb_xcc_id(); b.st = st;
    if (threadIdx.x == 0) (void)xb_add(&bar[XB_XCNT(b.x)], 1u);
    return b;
}
__device__ __forceinline__ void xcd_barrier_complete(unsigned* bar, unsigned x, unsigned& nloc, unsigned& nx) {
    const unsigned G = gridDim.x * gridDim.y * gridDim.z;
    unsigned sum, cnt, mine, sp = 0u;
    for (;;) {
        sum = 0u; cnt = 0u; mine = 0u;
#pragma unroll
        for (unsigned j = 0; j < 16; ++j) { const unsigned c = xb_ld(&bar[XB_XCNT(j)]); sum += c; cnt += (c > 0u) ? 1u : 0u; mine = (j == x) ? c : mine; }
        if (sum == G) break;
        __builtin_amdgcn_s_sleep(1);
        if ((++sp & 255u) == 0u) { if (xb_ld(&bar[XB_TMO])) break; if (sp > XB_SPIN_CAP) { atomicAdd(&bar[XB_TMO], 1u); break; } }
    }
    nloc = mine > 0u ? mine : 1u; nx = cnt > 0u ? cnt : 1u;
}
__device__ __forceinline__ void xcd_barrier(const XcdBarrier& b) {
    asm volatile("s_waitcnt vmcnt(0)" ::: "memory");
    __syncthreads();
    if (threadIdx.x == 0) {
        unsigned* bar = b.bar;
        __builtin_amdgcn_s_waitcnt(0);
        unsigned nloc = b.st[0], nx = b.st[1];
        if (nloc == 0u) { xcd_barrier_complete(bar, b.x, nloc, nx); b.st[0] = nloc; b.st[1] = nx; }
        const unsigned old = xb_add(&bar[XB_XSUB(b.x)], 1u);
        const unsigned gen = old / nloc;
        if (old + 1u == (gen + 1u) * nloc) {
            __builtin_amdgcn_fence(__ATOMIC_RELEASE, "agent");
            asm volatile("s_waitcnt vmcnt(0)" ::: "memory");
            const unsigned og = xb_add(&bar[XB_TOP], 1u);
            const unsigned tg = og / nx;
            if (og + 1u == (tg + 1u) * nx) xb_add(&bar[XB_TOPGEN], 1u);
            else XB_SPIN(xb_ld(&bar[XB_TOPGEN]) == tg, bar);
            __builtin_amdgcn_fence(__ATOMIC_ACQUIRE, "agent");
            xb_add(&bar[XB_XGEN(b.x)], 1u);
            asm volatile("s_waitcnt vmcnt(0)" ::: "memory");
        } else {
            XB_SPIN(xb_ld(&bar[XB_XGEN(b.x)]) == gen, bar);
            __builtin_amdgcn_fence(__ATOMIC_ACQUIRE, "agent");
            asm volatile("s_waitcnt vmcnt(0)" ::: "memory");
        }
    }
    __syncthreads();
}

struct Args { const float* in[25]; float* out; unsigned char* ws; int ph_lo, ph_hi; };
enum { I_X = 0, I_P, I_F1PRE, I_F1POST, I_F1WIN, I_F1WOUT, I_MPRE, I_MPOST, I_MWIN, I_CONVW, I_ALOG, I_DTB, I_DNG, I_IDXG, I_WBA, I_WBB, I_MWOUT,
       I_F2PRE, I_F2POST, I_F2WIN, I_F2WOUT, I_PPRE, I_PPOST, I_PWG, I_PWP };

__device__ __forceinline__ int srccol(int map, int n) {
    if (map == 0) return n;
    if (map == 1) { const int pn = n >> 8, tc = n & 255; return tc < 128 ? pn * 128 + tc : FF + pn * 128 + (tc - 128); }
    if (n < 2048) return n;
    if (n < 4096) return 2064 + (n - 2048);
    if (n < 6144) return 4184 + (n - 4096);
    const int tc = n - 6144;
    if (tc < 64) return 4112 + tc;
    if (tc < 72) return 2048 + (tc - 64);
    if (tc < 80) return 2056 + (tc - 72);
    if (tc < 88) return 4176 + (tc - 80);
    return -1;
}
__device__ __forceinline__ void transpose_item(const float* W, int K, int N, h16* WT, int NP, int map, float* scr, int item, int lane, const float* gk = nullptr) {
    const int nblk = NP / 32, kb = item / nblk, nb = item % nblk, k0 = 64 * kb, n0 = 32 * nb;
    const int sc = srccol(map, n0 + (lane & 31));
    float wv_[32], gv_[32];
#pragma unroll
    for (int i = 0; i < 32; ++i) { const int kk = 2 * i + (lane >> 5); wv_[i] = sc >= 0 ? W[(size_t)(k0 + kk) * N + sc] : 0.f; gv_[i] = gk ? gk[k0 + kk] : 1.0f; }
#pragma unroll
    for (int i = 0; i < 32; ++i) { const int kk = 2 * i + (lane >> 5); scr[kk * 33 + (lane & 31)] = wv_[i] * gv_[i]; }
    LDS_WAIT();
    const int c = lane & 7;
#pragma unroll
    for (int j = 0; j < 4; ++j) { const int n = (lane >> 3) + 8 * j; const float* s = scr + (8 * c) * 33 + n;
        f32x4 a = {s[0], s[33], s[66], s[99]}, b = {s[132], s[165], s[198], s[231]};
        *(u32x4*)(WT + (size_t)(n0 + n) * K + k0 + 8 * c) = pack8(a, b); }
    LDS_WAIT();
}

__device__ __forceinline__ void load_row_f32(const float* p, int lane, f32x4 (&v)[4]) {
#pragma unroll
    for (int j = 0; j < 4; ++j) v[j] = *(const f32x4*)(p + 4 * lane + 256 * j);
}
__device__ __forceinline__ void load_row_h16(const h16* p, int lane, f32x4 (&v)[4]) {
#pragma unroll
    for (int j = 0; j < 4; ++j) { const h16x4 h = *(const h16x4*)(p + 4 * lane + 256 * j); v[j] = (f32x4){(float)h[0], (float)h[1], (float)h[2], (float)h[3]}; }
}
__device__ __forceinline__ float row_rms_scale(const f32x4 (&v)[4]) {
    float s = 0.f;
#pragma unroll
    for (int j = 0; j < 4; ++j) s += (v[j][0] * v[j][0] + v[j][1] * v[j][1]) + (v[j][2] * v[j][2] + v[j][3] * v[j][3]);
    return rsqrtf(wave_sum_dpp(s) * (1.0f / D) + EPS);
}
template <bool BASE_F32, bool FINAL>
__device__ __forceinline__ void resid_norm_phase(const float* xbase, h16* H, const h16* Y, float coef, const float* g_post, float* RSo, float* outp, int gw, int ngw, int lane) {
    for (int row = gw; row < T; row += 2 * ngw) {
        f32x4 y[2][4], b[2][4];
#pragma unroll
        for (int u = 0; u < 2; ++u) {
            const size_t ro = (size_t)(row + u * ngw) * D;
            load_row_h16(Y + ro, lane, y[u]);
            if (BASE_F32) load_row_f32(xbase + ro, lane, b[u]); else load_row_h16(H + ro, lane, b[u]);
        }
        f32x4 gp[4]; load_row_f32(g_post, lane, gp);
#pragma unroll
        for (int u = 0; u < 2; ++u) {
            const float r = row_rms_scale(y[u]) * coef;
#pragma unroll
            for (int j = 0; j < 4; ++j) b[u][j] = b[u][j] + y[u][j] * r * gp[j];
        }
        if (FINAL) {
#pragma unroll
            for (int u = 0; u < 2; ++u)
#pragma unroll
                for (int j = 0; j < 4; ++j) *(f32x4*)(outp + (size_t)(row + u * ngw) * D + 4 * lane + 256 * j) = b[u][j];
        } else {
#pragma unroll
            for (int u = 0; u < 2; ++u) {
                const float r2 = row_rms_scale(b[u]);
                const size_t ro = (size_t)(row + u * ngw) * D;
#pragma unroll
                for (int j = 0; j < 4; ++j) *(u32x2*)(H + ro + 4 * lane + 256 * j) = pack4(b[u][j]);
                if (lane == 0) RSo[row + u * ngw] = r2;
            }
        }
    }
}

__global__ void __launch_bounds__(NTHREADS, 2) fwd_kernel(Args args) {
    extern __shared__ __attribute__((aligned(16))) unsigned char lds[];
    cg::grid_group grid = cg::this_grid();
    const int G = gridDim.x, bid = blockIdx.x;
    volatile LAS unsigned* xb_st = (volatile LAS unsigned*)((LAS unsigned char*)lds + 153616);
    if (threadIdx.x == 0) { xb_st[0] = 0u; xb_st[1] = 0u; }
    __syncthreads();
    unsigned* xb_words = (unsigned*)(args.ws + 16384);
    XcdBarrier xbar = xcd_barrier_post(xb_words, xb_st);
#ifdef DUP_PHASE
    bool dup_done = false;
#endif
    for (int ph = args.ph_lo; ph < args.ph_hi; ++ph) {
#ifdef PROBE_MASK
    unsigned long long probe_t0 = __builtin_amdgcn_s_memrealtime();
#endif
    int tid = threadIdx.x; asm volatile("" : "+v"(tid));
    __attribute__((address_space(1))) unsigned char* wsg_ = (__attribute__((address_space(1))) unsigned char*)args.ws; asm volatile("" : "+s"(wsg_));
    __attribute__((address_space(1))) float* outg_ = (__attribute__((address_space(1))) float*)args.out; asm volatile("" : "+s"(outg_));
    unsigned char* ws = (unsigned char*)wsg_;
    float* outp_ = (float*)outg_;
    const int lane = tid & 63, wave = __builtin_amdgcn_readfirstlane(tid >> 6);
    const int gw = bid * NWAVES + wave, ngw = G * NWAVES;
    float* ROPE = (float*)(ws + WS_ROPE);
    h16 *W1 = (h16*)(ws + WS_W1), *W2 = (h16*)(ws + WS_W2), *WM = (h16*)(ws + WS_WM), *WBA = (h16*)(ws + WS_WBA), *WBB = (h16*)(ws + WS_WBB), *WO = (h16*)(ws + WS_WO);
    h16 *W3 = (h16*)(ws + WS_W3), *W4 = (h16*)(ws + WS_W4), *WG = (h16*)(ws + WS_WG), *WP = (h16*)(ws + WS_WP);
    h16 *P16 = (h16*)(ws + WS_P16), *XN = (h16*)(ws + WS_XN), *H16 = (h16*)(ws + WS_H16), *HID = (h16*)(ws + WS_HID), *TMP = (h16*)(ws + WS_TMP);
    h16 *QKVA = (h16*)(ws + WS_QKVA), *ZS = (h16*)(ws + WS_ZS), *QKVB = (h16*)(ws + WS_QKVB), *QI = (h16*)(ws + WS_QI), *HALO = (h16*)(ws + WS_HALO), *KI = (h16*)(ws + WS_KI);
    float* MISC = (float*)(ws + WS_MISC);
    unsigned long long* MASK = (unsigned long long*)(ws + WS_MASK);
    const h16* Y = (const h16*)outp_;
    h16* GATES = (h16*)outp_;

        pg8::Gemm g{nullptr, nullptr, T, 0, 0, 0};
        pg8::Epi E; E.mode = -1; E.ws = ws; E.outp = outp_;
        switch (ph) {
        case 0: {
            float* scr = (float*)lds + wave * (64 * 33);
            constexpr int I1 = 16 * (5632 / 32), I2 = 44 * 32, IM = 16 * (NMIX / 32), IB = 8 * 32, IO = 16 * 32, IP = 4 * 32;
            constexpr int NIT = 2 * I1 + 2 * I2 + IM + 2 * IB + 2 * IO + IP;
            for (int it = gw; it < NIT; it += ngw) {
                int r = it;
                if (r < I1) { transpose_item(args.in[I_F1WIN], D, 2 * FF, W1, 2 * FF, 1, scr, r, lane, args.in[I_F1PRE]); continue; } r -= I1;
                if (r < I1) { transpose_item(args.in[I_F2WIN], D, 2 * FF, W3, 2 * FF, 1, scr, r, lane, args.in[I_F2PRE]); continue; } r -= I1;
                if (r < I2) { transpose_item(args.in[I_F1WOUT], FF, D, W2, D, 0, scr, r, lane); continue; } r -= I2;
                if (r < I2) { transpose_item(args.in[I_F2WOUT], FF, D, W4, D, 0, scr, r, lane); continue; } r -= I2;
                if (r < IM) { transpose_item(args.in[I_MWIN], D, 6232, WM, NMIX, 2, scr, r, lane, args.in[I_MPRE]); continue; } r -= IM;
                if (r < IB) { transpose_item(args.in[I_WBA], 512, D, WBA, D, 0, scr, r, lane); continue; } r -= IB;
                if (r < IB) { transpose_item(args.in[I_WBB], 512, D, WBB, D, 0, scr, r, lane); continue; } r -= IB;
                if (r < IO) { transpose_item(args.in[I_MWOUT], D, D, WO, D, 0, scr, r, lane); continue; } r -= IO;
                if (r < IO) { transpose_item(args.in[I_PWG], D, D, WG, D, 0, scr, r, lane, args.in[I_PPRE]); continue; } r -= IO;
                transpose_item(args.in[I_PWP], PLE, D, WP, D, 0, scr, r, lane);
            }
            { const float* p = args.in[I_P]; const size_t n8 = (size_t)T * PLE / 8;
              const size_t gs = (size_t)G * NTHREADS;
              for (size_t i = (size_t)bid * NTHREADS + tid; i < n8; i += 4 * gs) { f32x4 a[4], b[4];
#pragma unroll
                  for (int u = 0; u < 4; ++u) { a[u] = *(const f32x4*)(p + 8 * (i + u * gs)); b[u] = *(const f32x4*)(p + 8 * (i + u * gs) + 4); }
#pragma unroll
                  for (int u = 0; u < 4; ++u) *(u32x4*)(P16 + 8 * (i + u * gs)) = pack8(a[u], b[u]); } }
            for (int i = bid * NTHREADS + tid; i < SEQ * 8; i += G * NTHREADS) {
                const int pos = i >> 3, f = i & 7;
                const float invt[8] = {1.0f, 0.1939227432012558f, 0.03760603070259094f, 0.007292664609849453f, 0.0014142135623842478f, 0.00027424818836152554f, 5.3182957344688475e-05f, 1.0313385246263351e-05f};
                float inv = invt[0];
#pragma unroll
                for (int q = 1; q < 8; ++q) inv = (f == q) ? invt[q] : inv;
                const float ang = (float)pos * inv;
                ROPE[pos * 16 + f] = cosf(ang); ROPE[pos * 16 + 8 + f] = sinf(ang);
            }
            { const float* x = args.in[I_X]; float* RS = (float*)(ws + WS_RS);
              for (int row = gw; row < T; row += 8 * ngw) {
                  f32x4 v[8][4];
#pragma unroll
                  for (int u = 0; u < 8; ++u) load_row_f32(x + (size_t)(row + u * ngw) * D, lane, v[u]);
#pragma unroll
                  for (int u = 0; u < 8; ++u) { const float r = row_rms_scale(v[u]);
#pragma unroll
                      for (int j = 0; j < 4; ++j) *(u32x2*)(H16 + (size_t)(row + u * ngw) * D + 4 * lane + 256 * j) = pack4(v[u][j]);
                      if (lane == 0) RS[row + u * ngw] = r; } } }
        } break;
        case 1: g = pg8::Gemm{H16, W1, T, 2 * FF, D, D}; E.mode = pg8::EPI_SWIGLU; break;
        case 2: g = pg8::Gemm{HID, W2, T, D, FF, FF}; E.mode = pg8::EPI_F32; break;
        case 3: resid_norm_phase<false, false>(nullptr, H16, Y, 0.5f, args.in[I_F1POST], (float*)(ws + WS_RS), nullptr, gw, ngw, lane); break;
        case 4: g = pg8::Gemm{H16, WM, T, NMIX, D, D}; E.mode = pg8::EPI_MIX; break;
        case 5: {
            const float* cw = args.in[I_CONVW];
            for (int unit = gw; unit < 512 * 3; unit += ngw) {
                const int c = unit / 3, sidx = unit % 3, ch0 = sidx * 512 + 8 * lane;
                float w[4][8];
#pragma unroll
                for (int k = 0; k < 4; ++k) { const f32x4 a = *(const f32x4*)(cw + k * 1536 + ch0), b2 = *(const f32x4*)(cw + k * 1536 + ch0 + 4);
#pragma unroll
                    for (int i = 0; i < 4; ++i) { w[k][i] = a[i]; w[k][4 + i] = b2[i]; } }
                float x3[8], x2[8], x1[8];
#pragma unroll
                for (int i = 0; i < 8; ++i) { x3[i] = 0.f; x2[i] = 0.f; x1[i] = 0.f; }
                if (c & 63) { const h16* hp = HALO + (size_t)(c - 1) * 3 * 1536 + ch0; unpack8(*(const u32x4*)hp, x3); unpack8(*(const u32x4*)(hp + 1536), x2); unpack8(*(const u32x4*)(hp + 2 * 1536), x1); }
                h16* base = QKVA + (size_t)c * 64 * 1536 + ch0;
#pragma unroll 1
                for (int r0 = 0; r0 < 64; r0 += 32) {
                    u32x4 raw[32];
#pragma unroll
                    for (int r = 0; r < 32; ++r) raw[r] = *(const u32x4*)(base + (size_t)(r0 + r) * 1536);
#pragma unroll
                    for (int r = 0; r < 32; ++r) {
                        float x0[8], y[8]; unpack8(raw[r], x0);
                        float ss = 0.f;
#pragma unroll
                        for (int i = 0; i < 8; ++i) { y[i] = siluf_(w[0][i] * x3[i] + w[1][i] * x2[i] + w[2][i] * x1[i] + w[3][i] * x0[i]); ss += y[i] * y[i]; x3[i] = x2[i]; x2[i] = x1[i]; x1[i] = x0[i]; }
                        if (sidx < 2) { ss += __shfl_xor(ss, 1); ss += __shfl_xor(ss, 2); ss += __shfl_xor(ss, 4); const float sc_ = rsqrtf(ss + EPS) * (sidx == 0 ? 0.125f : 1.0f);
#pragma unroll
                            for (int i = 0; i < 8; ++i) y[i] *= sc_; }
                        *(u32x4*)(base + (size_t)(r0 + r) * 1536) = pack8((f32x4){y[0], y[1], y[2], y[3]}, (f32x4){y[4], y[5], y[6], y[7]});
                    }
                }
            }
            { h16* VT = (h16*)(ws + WS_XN);
              h16* tl = (h16*)lds + wave * (64 * 66);
              for (int unit = gw; unit < 64 * 64; unit += ngw) {
                  const int bh = unit >> 6, tt = unit & 63, b = bh >> 3, h = bh & 7;
                  const h16* src = QKVB + ((size_t)b * SEQ + tt * 64 + (lane >> 3)) * 1536 + 1024 + h * 64 + 8 * (lane & 7);
#pragma unroll
                  for (int i = 0; i < 8; ++i) { const h16x8 v = *(const h16x8*)(src + (size_t)(8 * i) * 1536); h16* d = tl + ((lane >> 3) + 8 * i) * 66 + 8 * (lane & 7);
#pragma unroll
                      for (int j = 0; j < 8; j += 2) *(unsigned*)(d + j) = __builtin_bit_cast(unsigned, (__attribute__((ext_vector_type(2))) _Float16){v[j], v[j + 1]}); }
                  LDS_WAIT();
                  h16* dst = VT + ((size_t)bh * 64 + lane) * SEQ + tt * 64;
#pragma unroll
                  for (int c8 = 0; c8 < 8; ++c8) { h16x8 v;
#pragma unroll
                      for (int i = 0; i < 8; ++i) v[i] = tl[(8 * c8 + i) * 66 + lane];
                      *(h16x8*)(dst + 8 * c8) = v; }
                  LDS_WAIT();
              } }
            const float* ig = args.in[I_IDXG];
            for (int row8 = gw; row8 < T; row8 += 8 * ngw) {
              float v8[8], c8_[8], s8_[8];
#pragma unroll
              for (int u = 0; u < 8; ++u) { const int row = row8 + u * ngw; v8[u] = MISC[(size_t)row * 96 + lane];
                  const float* rp = ROPE + (size_t)(row & (SEQ - 1)) * 16; c8_[u] = rp[lane & 7]; s8_[u] = rp[8 + (lane & 7)]; }
#pragma unroll
              for (int u = 0; u < 8; ++u) { const int row = row8 + u * ngw;
                float v = v8[u];
                const float ss = wave_sum(v * v);
                v = v * rsqrtf(ss * (1.0f / 64.0f) + EPS) * ig[lane];
                const float pr = __shfl_xor(v, 8);
                if (lane < 16) { const float c = c8_[u], s = s8_[u]; v = lane < 8 ? v * c - pr * s : v * c + pr * s; }
                KI[(size_t)(row >> 5) * 2048 + (lane >> 4) * 512 + ((((lane >> 3) & 1) * 32 + (row & 31)) * 8) + (lane & 7)] = (h16)v;
              }
            }
        } break;
        case 6: {
            typedef float f32x16 __attribute__((ext_vector_type(16)));
            unsigned* sc = (unsigned*)lds;
            const int r32 = lane & 31, hi = lane >> 5;
            u32x4 qnext = {0u, 0u, 0u, 0u}; float wv[2][2][8];
#define IDX_FETCH(kk) do { const int b_ = (kk) & 7, row0_ = b_ * SEQ + (511 - ((kk) >> 3)) * 8; const int R_ = tid >> 3, cq_ = tid & 7; \
                qnext = *(const u32x4*)(QI + (size_t)(row0_ + (R_ >> 3)) * 512 + (R_ & 7) * 64 + 8 * cq_); \
                _Pragma("unroll") for (int mt = 0; mt < 2; ++mt) _Pragma("unroll") for (int qq = 0; qq < 2; ++qq) { const float* wp = MISC + (size_t)(row0_ + 4 * mt + 2 * hi + qq) * 96 + 80; const f32x4 a = *(const f32x4*)wp, c = *(const f32x4*)(wp + 4); \
                    wv[mt][qq][0] = a[0]; wv[mt][qq][1] = a[1]; wv[mt][qq][2] = a[2]; wv[mt][qq][3] = a[3]; wv[mt][qq][4] = c[0]; wv[mt][qq][5] = c[1]; wv[mt][qq][6] = c[2]; wv[mt][qq][7] = c[3]; } } while (0)
#define IDX_STAGE_Q() do { const int R = tid >> 3, cq = tid & 7; *(u32x4*)(lds + 131072 + R * 128 + ((cq ^ (R & 7)) * 16)) = qnext; } while (0)
            IDX_FETCH(bid);
            IDX_STAGE_Q();
            __syncthreads();
            for (int k = bid; k < T / 8; k += G) {
                const int b = k & 7, t0 = (511 - (k >> 3)) * 8, row0 = b * SEQ + t0;
                const int g_ = r32 >> 3, hi_ = (r32 >> 2) & 1, head_ = 4 * (g_ & 1) + (r32 & 3);
                const unsigned char* qrow0 = lds + 131072 + ((2 * hi_ + (g_ >> 1)) * 8 + head_) * 128;
                const int nkt = 2 * ((t0 + 8 + 63) >> 6);
                {
                    const h16* kp0 = KI + (size_t)b * SEQ * 64 + lane * 8;
                    h16x8 kb[4];
#pragma unroll
                    for (int ks = 0; ks < 4; ++ks) kb[ks] = (h16x8){0, 0, 0, 0, 0, 0, 0, 0};
                    if (wave < nkt) {
#pragma unroll
                        for (int ks = 0; ks < 4; ++ks) kb[ks] = *(const h16x8*)(kp0 + (size_t)wave * 2048 + 512 * ks);
                    }
                    h16x8 qa[2][4];
#pragma unroll
                    for (int mt = 0; mt < 2; ++mt)
#pragma unroll
                        for (int ks = 0; ks < 4; ++ks) qa[mt][ks] = *(const h16x8*)(qrow0 + mt * 4096 + (((2 * ks + hi) ^ head_) * 16));
                    for (int kt = wave; kt < nkt; kt += NWAVES) {
                        h16x8 kn[4];
#pragma unroll
                        for (int ks = 0; ks < 4; ++ks) kn[ks] = kb[ks];
                        if (kt + NWAVES < nkt) {
#pragma unroll
                            for (int ks = 0; ks < 4; ++ks) kn[ks] = *(const h16x8*)(kp0 + (size_t)(kt + NWAVES) * 2048 + 512 * ks);
                        }
                        const int key = 32 * kt + r32;
                        f32x16 acc[2];
                        acc[0] = (f32x16){0.f, 0.f, 0.f, 0.f, 0.f, 0.f, 0.f, 0.f, 0.f, 0.f, 0.f, 0.f, 0.f, 0.f, 0.f, 0.f}; acc[1] = acc[0];
#pragma unroll
                        for (int ks = 0; ks < 4; ++ks) {
                            acc[0] = __builtin_amdgcn_mfma_f32_32x32x16_f16(qa[0][ks], kb[ks], acc[0], 0, 0, 0);
                            acc[1] = __builtin_amdgcn_mfma_f32_32x32x16_f16(qa[1][ks], kb[ks], acc[1], 0, 0, 0);
                        }
#pragma unroll
                        for (int mt = 0; mt < 2; ++mt) {
#pragma unroll
                            for (int qq = 0; qq < 2; ++qq) {
                                float sv = 0.f;
#pragma unroll
                                for (int h = 0; h < 8; ++h) {
                                    const int ab = __float_as_int(acc[mt][8 * qq + h]);
                                    sv = fmaf(wv[mt][qq][h], __int_as_float(ab > 0 ? ab : 0), sv);
                                }
                                const int ql = 4 * mt + 2 * hi + qq;
                                unsigned u = __float_as_uint(sv); u = (u & 0x80000000u) ? ~u : (u | 0x80000000u);
                                sc[ql * 4096 + key] = (key <= t0 + ql) ? u : 0u;
                            }
                        }
#pragma unroll
                        for (int ks = 0; ks < 4; ++ks) kb[ks] = kn[ks];
                    }
                }
                {
                    const int nwmax = nkt >> 1, nw16 = (nwmax + 15) & ~15;
                    for (int r = nwmax; r < nw16; ++r) sc[wave * 4096 + r * 64 + lane] = 0u;
                }
                __syncthreads();
                if (k + G < T / 8) IDX_FETCH(k + G);
                {
                    const int wave_s = __builtin_amdgcn_readfirstlane(wave);
                    const int t = t0 + wave_s, n = t + 1, nw = (n + 63) >> 6;
                    const unsigned* scq = sc + wave_s * 4096;
                    const int nv = (nw + 15) >> 4;
                    unsigned uk[64];
#pragma unroll
                    for (int i = 0; i < 16; ++i) uk[i] = scq[i * 64 + lane];
                    if (nv > 1) {
#pragma unroll
                        for (int i = 16; i < 32; ++i) uk[i] = scq[i * 64 + lane];
                    } else {
#pragma unroll
                        for (int i = 16; i < 32; ++i) uk[i] = 0u;
                    }
                    if (nv > 2) {
#pragma unroll
                        for (int i = 32; i < 48; ++i) uk[i] = scq[i * 64 + lane];
                    } else {
#pragma unroll
                        for (int i = 32; i < 48; ++i) uk[i] = 0u;
                    }
                    if (nv > 3) {
#pragma unroll
                        for (int i = 48; i < 64; ++i) uk[i] = scq[i * 64 + lane];
                    } else {
#pragma unroll
                        for (int i = 48; i < 64; ++i) uk[i] = 0u;
                    }
                    unsigned thr = 1u; int need = 0; bool exact = true;
                    if (n > 256) {
                        unsigned prefix = 0u; exact = false;
                        int bit = 31, stage = 0;
#pragma unroll 1
                        for (;;) {
                            const unsigned cand = stage == 0 ? 0xBE000000u : stage == 1 ? 0xC0000000u : (prefix | (1u << bit));
                            const unsigned cm1 = cand - 1u;
                            unsigned c0_ = 0u, c1_ = 0u, c2_ = 0u, c3_ = 0u;
                            int nvl = nv; asm volatile("" : "+s"(nvl));
#define TK_CNT8(i) do { unsigned t0_, t1_, t2_, t3_, t4_, t5_, t6_, t7_; \
                                asm volatile("v_sub_u32_e64 %4, %12, %20 clamp\n\tv_sub_u32_e64 %5, %13, %20 clamp\n\tv_sub_u32_e64 %6, %14, %20 clamp\n\tv_sub_u32_e64 %7, %15, %20 clamp\n\t" \
                                             "v_sub_u32_e64 %8, %16, %20 clamp\n\tv_sub_u32_e64 %9, %17, %20 clamp\n\tv_sub_u32_e64 %10, %18, %20 clamp\n\tv_sub_u32_e64 %11, %19, %20 clamp\n\t" \
                                             "v_min_u32_e32 %4, 1, %4\n\tv_min_u32_e32 %5, 1, %5\n\tv_min_u32_e32 %6, 1, %6\n\tv_min_u32_e32 %7, 1, %7\n\t" \
                                             "v_min_u32_e32 %8, 1, %8\n\tv_min_u32_e32 %9, 1, %9\n\tv_min_u32_e32 %10, 1, %10\n\tv_min_u32_e32 %11, 1, %11\n\t" \
                                             "v_add3_u32 %0, %0, %4, %5\n\tv_add3_u32 %1, %1, %6, %7\n\tv_add3_u32 %2, %2, %8, %9\n\tv_add3_u32 %3, %3, %10, %11" \
                                             : "+v"(c0_), "+v"(c1_), "+v"(c2_), "+v"(c3_), "=&v"(t0_), "=&v"(t1_), "=&v"(t2_), "=&v"(t3_), "=&v"(t4_), "=&v"(t5_), "=&v"(t6_), "=&v"(t7_) \
                                             : "v"(uk[i]), "v"(uk[(i) + 1]), "v"(uk[(i) + 2]), "v"(uk[(i) + 3]), "v"(uk[(i) + 4]), "v"(uk[(i) + 5]), "v"(uk[(i) + 6]), "v"(uk[(i) + 7]), "s"(cm1)); } while (0)
                            TK_CNT8(0); TK_CNT8(8);
                            if (nvl > 1) { TK_CNT8(16); TK_CNT8(24);
                                if (nvl > 2) { TK_CNT8(32); TK_CNT8(40);
                                    if (nvl > 3) { TK_CNT8(48); TK_CNT8(56); } } }
#undef TK_CNT8
                            const unsigned cl = (c0_ + c1_) + (c2_ + c3_);
                            const int cnt = wave_sum_dpp_i((int)cl);
                            if (cnt == 256) { thr = cand; exact = true; break; }
                            const bool gt = cnt > 256, s2 = stage == 2, brk = stage == 1 && !gt;
                            prefix = s2 ? (gt ? cand : prefix) : (brk ? 0xBE000000u : prefix);
                            bit = s2 ? bit - 1 : (brk ? 24 : bit);
                            stage = stage == 0 ? (gt ? 1 : 2) : 2;
                            if (bit < 0) break;
                        }
                        if (!exact) {
                            thr = prefix;
                            int cg_ = 0;
#pragma unroll
                            for (int i = 0; i < 64; ++i) cg_ += __popcll(__ballot(uk[i] > thr));
                            need = 256 - cg_;
                        }
                    }
                    unsigned long long* mrow = MASK + (size_t)b * 64 * SEQ + (t0 + wave);
                    unsigned long long mine = 0ull;
                    if (exact) {
                        int mlo = 0, mhi = 0;
#define TK_EMIT4(i) do { unsigned long long m0_, m1_, m2_, m3_; \
                            asm volatile("v_cmp_le_u32_e64 %0, %4, %5\n\tv_cmp_le_u32_e64 %1, %4, %6\n\tv_cmp_le_u32_e64 %2, %4, %7\n\tv_cmp_le_u32_e64 %3, %4, %8" \
                                         : "=&s"(m0_), "=&s"(m1_), "=&s"(m2_), "=&s"(m3_) : "s"(thr), "v"(uk[i]), "v"(uk[(i) + 1]), "v"(uk[(i) + 2]), "v"(uk[(i) + 3])); \
                            asm volatile("s_nop 3\n\tv_writelane_b32 %0, %2, %10\n\tv_writelane_b32 %1, %3, %10\n\tv_writelane_b32 %0, %4, %11\n\tv_writelane_b32 %1, %5, %11\n\t" \
                                         "v_writelane_b32 %0, %6, %12\n\tv_writelane_b32 %1, %7, %12\n\tv_writelane_b32 %0, %8, %13\n\tv_writelane_b32 %1, %9, %13" \
                                         : "+v"(mlo), "+v"(mhi) \
                                         : "s"((unsigned)m0_), "s"((unsigned)(m0_ >> 32)), "s"((unsigned)m1_), "s"((unsigned)(m1_ >> 32)), "s"((unsigned)m2_), "s"((unsigned)(m2_ >> 32)), "s"((unsigned)m3_), "s"((unsigned)(m3_ >> 32)), \
                                           "i"(i), "i"((i) + 1), "i"((i) + 2), "i"((i) + 3)); } while (0)
#define TK_EMIT16(b) do { TK_EMIT4(b); TK_EMIT4((b) + 4); TK_EMIT4((b) + 8); TK_EMIT4((b) + 12); } while (0)
                        TK_EMIT16(0);
                        if (nv > 1) { TK_EMIT16(16);
                            if (nv > 2) { TK_EMIT16(32);
                                if (nv > 3) TK_EMIT16(48); } }
#undef TK_EMIT16
#undef TK_EMIT4
                        mine = ((unsigned long long)(unsigned)mhi << 32) | (unsigned)mlo;
                    } else {
                        int running = 0;
#pragma unroll
                        for (int i = 0; i < 64; ++i) {
                            const bool gt = uk[i] > thr, eq = uk[i] == thr;
                            const unsigned long long beq = __ballot(eq);
                            const int rank = running + __popcll(beq & ((1ull << lane) - 1ull));
                            const bool take = gt || (eq && rank < need);
                            running += __popcll(beq);
                            const unsigned long long mm = __ballot(take);
                            if (lane == i) mine = mm;
                        }
                    }
                    mrow[(size_t)lane * SEQ] = mine;
                }
                if (k + G < T / 8) IDX_STAGE_Q();
                __syncthreads();
            }
#undef IDX_STAGE_Q
        } break;
#undef IDX_FETCH
        case 7: {
            typedef float f32x16 __attribute__((ext_vector_type(16)));
            typedef _Float16 h16x2 __attribute__((ext_vector_type(2)));
            h16* Lw = (h16*)((float*)lds + wave * (2048 + 128));
            float* sg = (float*)lds + wave * (2048 + 128) + 2048; float* sb = sg + 64;
            h16* WB = (h16*)(ws + WS_XN + 32 * MiB); h16* KDT = (h16*)(ws + WS_QI);
            const int lane_p = lane;
            for (int unit = gw; unit < 4096; unit += ngw) {
                int lane = lane_p; asm volatile("" : "+v"(lane));
                const int r32 = lane & 31, hi = lane >> 5;
                const int c = unit >> 3, h = unit & 7; const size_t row0 = (size_t)c * 64;
                float* mg = MISC + (row0 + lane) * 96 + 64 + h;
                float gc, bt;
                {
                    const float xx_ = mg[0] + args.in[I_DTB][h];
                    const float sp = xx_ > 20.f ? xx_ : log1pf(expf(xx_));
                    gc = -expf(args.in[I_ALOG][h]) * sp;
                    bt = 1.0f / (1.0f + expf(-mg[8]));
                }
#pragma unroll
                for (int o = 1; o < 64; o <<= 1) { const float v = __shfl_up(gc, o); if (lane >= o) gc += v; }
                sg[lane] = gc; sb[lane] = bt;
                const float gc63 = __shfl(gc, 63);
                h16* qbase = QKVA + row0 * 1536 + h * 64;
                h16x8 ak[2][4], bq[2][4];
                { const h16* fp = qbase + (size_t)r32 * 1536 + 8 * hi;
#pragma unroll
                  for (int rt = 0; rt < 2; ++rt)
#pragma unroll
                      for (int ks = 0; ks < 4; ++ks) { ak[rt][ks] = *(const h16x8*)(fp + (size_t)rt * 32 * 1536 + 512 + 16 * ks); bq[rt][ks] = *(const h16x8*)(fp + (size_t)rt * 32 * 1536 + 16 * ks); } }
                LDS_WAIT();
#pragma unroll
                for (int tile = 0; tile < 3; ++tile) {
                    const int rt = tile == 0 ? 0 : 1, ct = tile == 2 ? 1 : 0;
                    f32x16 acc;
#pragma unroll
                    for (int i = 0; i < 16; ++i) acc[i] = 0.f;
#pragma unroll
                    for (int ks = 0; ks < 4; ++ks) acc = __builtin_amdgcn_mfma_f32_32x32x16_f16(ak[rt][ks], ak[ct][ks], acc, 0, 0, 0);
                    const int tp = 32 * ct + r32; const float gcol = sg[tp];
#pragma unroll
                    for (int i = 0; i < 16; ++i) { const int t = 32 * rt + (i & 3) + 8 * (i >> 2) + 4 * hi;
                        Lw[t * 64 + tp] = (h16)((t > tp) ? sb[t] * acc[i] * __expf(sg[t] - gcol) : 0.f); }
                }
                u32x2 xt[3][4];
#pragma unroll
                for (int tile = 0; tile < 3; ++tile) {
                    const int rt = tile == 2 ? 1 : 0, ct = tile == 0 ? 0 : 1;
                    f32x16 acc;
#pragma unroll
                    for (int i = 0; i < 16; ++i) acc[i] = 0.f;
#pragma unroll
                    for (int ks = 0; ks < 4; ++ks) acc = __builtin_amdgcn_mfma_f32_32x32x16_f16(ak[rt][ks], bq[ct][ks], acc, 0, 0, 0);
                    const int t = 32 * ct + r32; const float gcol = sg[t];
#pragma unroll
                    for (int g4 = 0; g4 < 4; ++g4) { f32x4 v4;
#pragma unroll
                        for (int i = 0; i < 4; ++i) { const int tp = 32 * rt + i + 8 * g4 + 4 * hi; v4[i] = (t >= tp) ? acc[4 * g4 + i] * __expf(gcol - sg[tp]) : 0.f; }
                        xt[tile][g4] = pack4(v4); }
                }
                {
                    h16* qw = qbase + (size_t)r32 * 1536 + 8 * hi;
#pragma unroll
                    for (int rt = 0; rt < 2; ++rt) { const float sc_ = __expf(sg[32 * rt + r32]);
#pragma unroll
                        for (int ks = 0; ks < 4; ++ks) { h16x8 v;
#pragma unroll
                            for (int i = 0; i < 8; ++i) v[i] = (h16)((float)bq[rt][ks][i] * sc_);
                            *(h16x8*)(qw + (size_t)rt * 32 * 1536 + 16 * ks) = v; } }
                }
                float xx[64];
                { const gh16* kp = (const gh16*)(qbase + 512 + lane);
#pragma unroll
                  for (int t = 0; t < 64; ++t) { xx[t] = (float)*kp; kp += 1536; asm volatile("" : "+v"(kp)); } }
                {
                    h16* kd = KDT + ((size_t)unit * 64 + lane) * 64;
#pragma unroll
                    for (int c8 = 0; c8 < 8; ++c8) { f32x4 a, b2;
#pragma unroll
                        for (int i = 0; i < 4; ++i) { a[i] = xx[8 * c8 + i] * __expf(gc63 - sg[8 * c8 + i]); b2[i] = xx[8 * c8 + 4 + i] * __expf(gc63 - sg[8 * c8 + 4 + i]); }
                        *(u32x4*)(kd + 8 * c8) = pack8(a, b2); }
                }
#pragma unroll
                for (int tile = 0; tile < 3; ++tile) {
                    const int rt = tile == 2 ? 1 : 0, ct = tile == 0 ? 0 : 1;
                    h16* xp = qbase + (size_t)(32 * ct + r32) * 1536 + 512 + 32 * rt + 4 * hi;
#pragma unroll
                    for (int g4 = 0; g4 < 4; ++g4) *(u32x2*)(xp + 8 * g4) = xt[tile][g4];
                }
#define FWD_SUBST(X) do { h16x2 xh_[32]; \
                    _Pragma("unroll") for (int i = 1; i < 64; ++i) { float acc0_ = 0.f, acc1_ = 0.f; \
                    _Pragma("unroll") for (int j4 = 0; j4 < (i + 3) / 4; ++j4) { const h16x4 l4 = *(const h16x4*)(Lw + i * 64 + 4 * j4); \
                        if (4 * j4 + 1 < i) acc0_ = __builtin_amdgcn_fdot2((h16x2){l4[0], l4[1]}, xh_[2 * j4], acc0_, false); \
                        else if (4 * j4 < i) acc0_ = fmaf((float)l4[0], X[4 * j4], acc0_); \
                        if (4 * j4 + 3 < i) acc1_ = __builtin_amdgcn_fdot2((h16x2){l4[2], l4[3]}, xh_[2 * j4 + 1], acc1_, false); \
                        else if (4 * j4 + 2 < i) acc1_ = fmaf((float)l4[2], X[4 * j4 + 2], acc1_); } \
                    X[i] -= acc0_ + acc1_; \
                    if (i & 1) xh_[i >> 1] = (h16x2){(h16)X[i - 1], (h16)X[i]}; \
                    if ((i & 3) == 3) asm volatile("" ::: "memory"); } } while (0)
#pragma unroll
                for (int t = 0; t < 64; ++t) xx[t] *= sb[t] * __expf(sg[t]);
                FWD_SUBST(xx);
                { gh16* wp = (gh16*)(WB + (size_t)unit * 4096 + lane);
#pragma unroll
                  for (int t = 0; t < 64; ++t) { *wp = (h16)xx[t]; wp += 64; asm volatile("" : "+v"(wp)); } }
                { const gh16* vp = (const gh16*)(qbase + 1024 + lane);
#pragma unroll
                  for (int t = 0; t < 64; ++t) { xx[t] = (float)*vp * sb[t]; vp += 1536; asm volatile("" : "+v"(vp)); } }
                FWD_SUBST(xx);
#undef FWD_SUBST
                {
                    h16* up = qbase + (size_t)lane * 1536 + 1024;
#pragma unroll
                    for (int c8 = 0; c8 < 8; ++c8) { const f32x4 a = {xx[8 * c8], xx[8 * c8 + 1], xx[8 * c8 + 2], xx[8 * c8 + 3]}, b2 = {xx[8 * c8 + 4], xx[8 * c8 + 5], xx[8 * c8 + 6], xx[8 * c8 + 7]};
                        *(u32x4*)(up + 8 * c8) = pack8(a, b2); }
                }
                mg[0] = gc;
                LDS_WAIT();
            }
        } break;
        case 8: {
            typedef float f32x16 __attribute__((ext_vector_type(16)));
            const int r32 = lane & 31, hi = lane >> 5;
            const int srow = tid >> 3, sch = tid & 7;
            if (bid < 64) {
                constexpr int MB = 8704, BUFB = 5 * MB;
                const int b = bid >> 3, h = bid & 7;
                const h16* WB = (const h16*)(ws + WS_XN + 32 * MiB); const h16* KDT = (const h16*)(ws + WS_QI);
                if (wave < 2) {
                    __syncthreads();
                    f32x16 St[2];
#pragma unroll
                    for (int i = 0; i < 16; ++i) { St[0][i] = 0.f; St[1][i] = 0.f; }
#pragma unroll 1
                    for (int c = 0; c < 64; ++c) {
                        const int cur = c & 1;
                        const float e63 = __expf(MISC[((size_t)b * SEQ + c * 64 + 63) * 96 + 64 + h]);
                        const unsigned char* B_ = lds + cur * BUFB;
                        const int koff = 8 * hi;
                        h16x8 sf[2][2];
#pragma unroll
                        for (int rt = 0; rt < 2; ++rt)
#pragma unroll
                            for (int s2 = 0; s2 < 2; ++s2)
#pragma unroll
                                for (int j = 0; j < 8; ++j) sf[rt][s2][j] = (h16)St[rt][8 * s2 + j];
                        f32x16 P[2], O[2];
#pragma unroll
                        for (int i = 0; i < 16; ++i) { P[0][i] = 0.f; P[1][i] = 0.f; O[0][i] = 0.f; O[1][i] = 0.f; }
#define FRAG(mI, row, kel) ({ const unsigned char* fp_ = B_ + (mI) * MB + (row) * 136 + (kel) * 2 + koff; const h16x4 lo_ = *(const h16x4*)fp_, hi_ = *(const h16x4*)(fp_ + 16); \
                              (h16x8){lo_[0], lo_[1], lo_[2], lo_[3], hi_[0], hi_[1], hi_[2], hi_[3]}; })
#pragma unroll
                        for (int tt = 0; tt < 2; ++tt)
#pragma unroll
                            for (int rt = 0; rt < 2; ++rt)
#pragma unroll
                                for (int s2 = 0; s2 < 2; ++s2) {
                                    const h16x8 aw = FRAG(1, 32 * tt + r32, 32 * rt + 16 * s2), aq = FRAG(0, 32 * tt + r32, 32 * rt + 16 * s2);
                                    P[tt] = __builtin_amdgcn_mfma_f32_32x32x16_f16(aw, sf[rt][s2], P[tt], 0, 0, 0);
                                    O[tt] = __builtin_amdgcn_mfma_f32_32x32x16_f16(aq, sf[rt][s2], O[tt], 0, 0, 0);
                                }
                        f32x16 Vn[2];
#pragma unroll
                        for (int tt = 0; tt < 2; ++tt)
#pragma unroll
                            for (int g4 = 0; g4 < 4; ++g4) { const h16x4 u4 = *(const h16x4*)(B_ + 4 * MB + (32 * wave + r32) * 136 + (32 * tt + 8 * g4) * 2 + koff);
#pragma unroll
                                for (int i = 0; i < 4; ++i) Vn[tt][4 * g4 + i] = (float)u4[i] - P[tt][4 * g4 + i]; }
                        h16x8 vf[2][2];
#pragma unroll
                        for (int tt = 0; tt < 2; ++tt)
#pragma unroll
                            for (int s2 = 0; s2 < 2; ++s2)
#pragma unroll
                                for (int j = 0; j < 8; ++j) vf[tt][s2][j] = (h16)Vn[tt][8 * s2 + j];
#pragma unroll
                        for (int tt = 0; tt < 2; ++tt)
#pragma unroll
                            for (int t2 = 0; t2 <= tt; ++t2)
#pragma unroll
                                for (int s2 = 0; s2 < 2; ++s2) { const h16x8 ax = FRAG(2, 32 * tt + r32, 32 * t2 + 16 * s2); O[tt] = __builtin_amdgcn_mfma_f32_32x32x16_f16(ax, vf[t2][s2], O[tt], 0, 0, 0); }
#pragma unroll
                        for (int rt = 0; rt < 2; ++rt) {
#pragma unroll
                            for (int i = 0; i < 16; ++i) St[rt][i] *= e63;
#pragma unroll
                            for (int t2 = 0; t2 < 2; ++t2)
#pragma unroll
                                for (int s2 = 0; s2 < 2; ++s2) { const h16x8 akd = FRAG(3, 32 * rt + r32, 32 * t2 + 16 * s2); St[rt] = __builtin_amdgcn_mfma_f32_32x32x16_f16(akd, vf[t2][s2], St[rt], 0, 0, 0); }
                        }
#undef FRAG
                        h16* op = QKVA + ((size_t)b * SEQ + c * 64 + 4 * hi) * 1536 + 1024 + h * 64 + 32 * wave + r32;
#pragma unroll
                        for (int tt = 0; tt < 2; ++tt)
#pragma unroll
                            for (int i = 0; i < 16; ++i) op[(size_t)(32 * tt + (i & 3) + 8 * (i >> 2)) * 1536] = (h16)O[tt][i];
                                            __syncthreads();
                    }
                } else {
                    const int mI = wave - 2;
                    const bool slot = (mI & 1) == 0;
                    const h16* gb = slot ? QKVA + (size_t)b * SEQ * 1536 + h * 64 + (mI >> 1) * 512 : (mI == 1 ? WB : KDT) + ((size_t)(b * 64) * 8 + h) * 4096;
                    const size_t rstr = slot ? 1536 : 64, cstr = slot ? (size_t)64 * 1536 : (size_t)8 * 4096;
                    gb += (size_t)(lane >> 3) * rstr + 8 * (lane & 7);
                    unsigned char* lw = lds + (mI < 5 ? mI : 0) * MB + (lane >> 3) * 136 + (lane & 7) * 16;
                    u32x4 rA[8], rB[8], rC[8];
#define SCAN_LOAD(R, cc) do { const h16* p_ = gb + (size_t)(cc) * cstr; _Pragma("unroll") for (int i_ = 0; i_ < 8; ++i_) R[i_] = *(const u32x4*)(p_ + (size_t)(8 * i_) * rstr); } while (0)
#define SCAN_WRITE(R, bufi) do { _Pragma("unroll") for (int i_ = 0; i_ < 8; ++i_) { unsigned char* d_ = lw + (bufi) * BUFB + i_ * (8 * 136); *(u32x2*)d_ = (u32x2){R[i_][0], R[i_][1]}; *(u32x2*)(d_ + 8) = (u32x2){R[i_][2], R[i_][3]}; } } while (0)
#pragma unroll
                    for (int i_ = 0; i_ < 8; ++i_) { rA[i_] = (u32x4){0u, 0u, 0u, 0u}; rB[i_] = rA[i_]; rC[i_] = rA[i_]; }
                    if (mI < 5) { SCAN_LOAD(rA, 0); SCAN_LOAD(rB, 1); SCAN_LOAD(rC, 2); SCAN_WRITE(rA, 0); SCAN_LOAD(rA, 3); }
                    __syncthreads();
#pragma unroll 1
                    for (int c3 = 0; c3 < 66; c3 += 3) {
#pragma unroll
                        for (int cs = 0; cs < 3; ++cs) {
                            const int c = c3 + cs;
                            if (c < 64) {
                                if (mI < 5) {
                                    if (cs == 0) { if (c + 1 < 64) SCAN_WRITE(rB, (c + 1) & 1); if (c + 4 < 64) SCAN_LOAD(rB, c + 4); }
                                    else if (cs == 1) { if (c + 1 < 64) SCAN_WRITE(rC, (c + 1) & 1); if (c + 4 < 64) SCAN_LOAD(rC, c + 4); }
                                    else { if (c + 1 < 64) SCAN_WRITE(rA, (c + 1) & 1); if (c + 4 < 64) SCAN_LOAD(rA, c + 4); }
                                }
                                __syncthreads();
                            }
                        }
                    }
#undef SCAN_LOAD
#undef SCAN_WRITE
                }
                asm volatile("s_waitcnt vmcnt(0)" ::: "memory");
                __syncthreads();
                __builtin_amdgcn_fence(__ATOMIC_ACQUIRE, "agent");
                asm volatile("s_waitcnt vmcnt(0)" ::: "memory");
                {
                    const float* dg = args.in[I_DNG];
                    float gg[8];
#pragma unroll
                    for (int i = 0; i < 8; ++i) gg[i] = dg[(lane & 7) * 8 + i];
                    for (int t0 = wave * 8 + (lane >> 3); t0 < SEQ; t0 += 256) {
                        u32x4 ov[4], zv[4];
#pragma unroll
                        for (int u = 0; u < 4; ++u) { const size_t rw = (size_t)b * SEQ + t0 + 64 * u;
                            ov[u] = *(const u32x4*)(QKVA + rw * 1536 + 1024 + h * 64 + (lane & 7) * 8); zv[u] = *(const u32x4*)(ZS + rw * 512 + h * 64 + (lane & 7) * 8); }
#pragma unroll
                        for (int u = 0; u < 4; ++u) {
                            float o[8], z[8]; unpack8(ov[u], o); unpack8(zv[u], z);
                            float ss = 0.f;
#pragma unroll
                            for (int i = 0; i < 8; ++i) ss += o[i] * o[i];
                            ss = sum8_dpp(ss);
                            const float r = rsqrtf(ss * (1.0f / 64.0f) + EPS);
                            f32x4 a0, a1;
#pragma unroll
                            for (int i = 0; i < 4; ++i) { a0[i] = o[i] * r * gg[i] * z[i]; a1[i] = o[4 + i] * r * gg[4 + i] * z[4 + i]; }
                            *(u32x4*)(QKVA + ((size_t)b * SEQ + t0 + 64 * u) * 1536 + 1024 + h * 64 + (lane & 7) * 8) = pack8(a0, a1);
                        }
                    }
                }
            }
            {
                unsigned char* kbuf = lds;
                unsigned char* vbuf = lds + 32768;
                volatile int* qslot = (volatile int*)(lds + 153600);
                unsigned* qctr = (unsigned*)ws;
                const unsigned* MASK32 = (const unsigned*)MASK;
                const h16* VT = (const h16*)(ws + WS_XN);
                const int kws = srow * 128 + ((sch ^ (srow & 7)) * 16), vws = srow * 136 + sch * 16;
                for (;;) {
                    __syncthreads();
                    if (tid == 0) *qslot = (int)__hip_atomic_fetch_add(qctr, 1u, __ATOMIC_RELAXED, __HIP_MEMORY_SCOPE_AGENT);
                    __syncthreads();
                    const int u = __builtin_amdgcn_readfirstlane(*qslot);
                    if (u >= 1024) break;
                    {
                        const int qb = 15 - (u >> 6), bh = u & 63, b = bh >> 3, h = bh & 7, q0 = qb * 256;
                        const int qrow = b * SEQ + q0 + 32 * wave + r32;
                        h16x8 qf[4];
                        { const h16* qp = QKVB + (size_t)qrow * 1536 + h * 64 + 8 * hi;
#pragma unroll
                          for (int ks = 0; ks < 4; ++ks) { const h16x8 t8 = *(const h16x8*)(qp + 16 * ks);
#pragma unroll
                              for (int i = 0; i < 8; ++i) qf[ks][i] = (h16)((float)t8[i] * 1.4426950408889634f); } }
                        f32x16 o[2];
#pragma unroll
                        for (int i = 0; i < 16; ++i) { o[0][i] = 0.f; o[1][i] = 0.f; }
                        float mref = 0.f, l = 0.f; f32x16 negm;
#pragma unroll
                        for (int i = 0; i < 16; ++i) negm[i] = 0.f;
                        const int nkt = 4 * qb + 4;
                        const h16* kg = QKVB + ((size_t)b * SEQ + srow) * 1536 + 512 + h * 64 + 8 * sch;
                        const h16* vg = VT + ((size_t)bh * 64 + srow) * SEQ + 8 * sch;
                        const h16* kgs = QKVB + ((size_t)b * SEQ + srow) * 1536 + 512 + h * 64 + 8 * (sch ^ ((srow >> 1) & 7));
#define ATT_KDMA(tile, slot) __builtin_amdgcn_global_load_lds((const unsigned*)(kgs + (size_t)(tile) * 64 * 1536), (LAS unsigned*)((LAS unsigned char*)lds + (slot) * 8192 + wave * 1024), 16, 0, 0)
                        u32x4 vreg[2];
#pragma unroll
                        for (int j = 0; j < 2; ++j) vreg[j] = *(const u32x4*)(vg + j * 64);
                        __syncthreads();
                        ATT_KDMA(0, 0); ATT_KDMA(1, 1);
#pragma unroll
                        for (int j = 0; j < 2; ++j) { unsigned char* vd = vbuf + j * 8704 + vws; *(u32x2*)vd = (u32x2){vreg[j][0], vreg[j][1]}; *(u32x2*)(vd + 8) = (u32x2){vreg[j][2], vreg[j][3]}; }
                        asm volatile("s_waitcnt vmcnt(0)" ::: "memory");
                        __syncthreads();
                        const int wq_last = q0 + 32 * wave + 31;
                        const int npair = nkt >> 1;
                        const unsigned* mq = MASK32 + ((size_t)b * 64 * SEQ + (q0 + 32 * wave + r32)) * 2;
                        u32x4 mnext; { const u32x2 ta = *(const u32x2*)mq, tb = *(const u32x2*)(mq + 2 * SEQ); mnext = (u32x4){ta[0], ta[1], tb[0], tb[1]}; }
                        for (int kp = 0; kp < npair; ++kp) {
                            const int cur = kp & 1;
                            if (kp + 1 < npair) {
                                ATT_KDMA(2 * kp + 2, 2 * (cur ^ 1)); ATT_KDMA(2 * kp + 3, 2 * (cur ^ 1) + 1);
#pragma unroll
                                for (int j = 0; j < 2; ++j) vreg[j] = *(const u32x4*)(vg + (2 * kp + 2 + j) * 64);
                            }
                            if (128 * kp <= wq_last) {
                                const unsigned mw[4] = {mnext[0] >> (4 * hi), mnext[1] >> (4 * hi), mnext[2] >> (4 * hi), mnext[3] >> (4 * hi)};
                                if (128 * (kp + 1) <= wq_last) { const u32x2 ta = *(const u32x2*)(mq + (size_t)(2 * kp + 2) * 2 * SEQ), tb = *(const u32x2*)(mq + (size_t)(2 * kp + 3) * 2 * SEQ); mnext = (u32x4){ta[0], ta[1], tb[0], tb[1]}; }
                                f32x16 S[4];
#pragma unroll
                                for (int j = 0; j < 2; ++j) {
                                    const unsigned char* kb_ = kbuf + (2 * cur + j) * 8192 + r32 * 128;
#pragma unroll
                                    for (int ks = 0; ks < 4; ++ks) {
                                        const int off = ((2 * ks + hi) ^ ((r32 >> 1) & 7)) * 16;
                                        const h16x8 a0 = *(const h16x8*)(kb_ + off), a1 = *(const h16x8*)(kb_ + 4096 + off);
                                        S[2 * j] = __builtin_amdgcn_mfma_f32_32x32x16_f16(a0, qf[ks], ks == 0 ? negm : S[2 * j], 0, 0, 0);
                                        S[2 * j + 1] = __builtin_amdgcn_mfma_f32_32x32x16_f16(a1, qf[ks], ks == 0 ? negm : S[2 * j + 1], 0, 0, 0);
                                    }
                                    __builtin_amdgcn_sched_barrier(0);
                                }

                                float mx = S[0][0];
#pragma unroll
                                for (int i = 0; i < 16; ++i) { mx = fmaxf(mx, fmaxf(S[0][i], S[1][i])); mx = fmaxf(mx, fmaxf(S[2][i], S[3][i])); }
                                mx = fmaxf(mx, __shfl_xor(mx, 32));
                                if (kp == 0 || __any(mx > 8.0f)) {
                                    const float d = kp == 0 ? mx : fmaxf(mx, 0.f), alpha = __builtin_amdgcn_exp2f(-d);
                                    mref += d; l *= alpha;
#pragma unroll
                                    for (int i = 0; i < 16; ++i) { S[0][i] -= d; S[1][i] -= d; S[2][i] -= d; S[3][i] -= d; o[0][i] *= alpha; o[1][i] *= alpha; negm[i] = -mref; }
                                }
                                float ps = 0.f;
#pragma unroll
                                for (int rt = 0; rt < 4; ++rt)
#pragma unroll
                                    for (int i = 0; i < 16; ++i) {
                                        float e = __builtin_amdgcn_exp2f(S[rt][i]);
                                        int bm;
                                        asm("v_bfe_i32 %0, %1, %2, 1" : "=v"(bm) : "v"(mw[rt]), "i"((i & 3) + 8 * (i >> 2)));
                                        e = __uint_as_float(__float_as_uint(e) & (unsigned)bm);
                                        ps += e; S[rt][i] = e;
                                    }
                                l += ps;
#pragma unroll
                                for (int j = 0; j < 2; ++j) {
                                    const unsigned char* vb_ = vbuf + (2 * cur + j) * 8704 + r32 * 136 + 8 * hi;
#pragma unroll
                                    for (int rt = 0; rt < 2; ++rt)
#pragma unroll
                                        for (int s2 = 0; s2 < 2; ++s2) {
                                            h16x8 pb;
#pragma unroll
                                            for (int jj = 0; jj < 8; ++jj) pb[jj] = (h16)S[2 * j + rt][8 * s2 + jj];
#pragma unroll
                                            for (int dt = 0; dt < 2; ++dt) {
                                                const unsigned char* vp = vb_ + dt * (32 * 136) + (32 * rt + 16 * s2) * 2;
                                                const h16x4 lo = *(const h16x4*)vp, hi4 = *(const h16x4*)(vp + 16);
                                                const h16x8 va = {lo[0], lo[1], lo[2], lo[3], hi4[0], hi4[1], hi4[2], hi4[3]};
                                                o[dt] = __builtin_amdgcn_mfma_f32_32x32x16_f16(va, pb, o[dt], 0, 0, 0);
                                            }
                                        }
                                }
                            }
                            if (kp + 1 < npair) {
#pragma unroll
                                for (int j = 0; j < 2; ++j) { unsigned char* vd = vbuf + (2 * (cur ^ 1) + j) * 8704 + vws;
                                    *(u32x2*)vd = (u32x2){vreg[j][0], vreg[j][1]}; *(u32x2*)(vd + 8) = (u32x2){vreg[j][2], vreg[j][3]}; }
                            }
                            asm volatile("s_waitcnt vmcnt(0)" ::: "memory");
                            __syncthreads();
                        }
#undef ATT_KDMA
                        l += __shfl_xor(l, 32);
                        const float inv = 1.0f / l;
                        h16* op = QKVB + (size_t)qrow * 1536 + h * 64 + 4 * hi;
#pragma unroll
                        for (int dt = 0; dt < 2; ++dt)
#pragma unroll
                            for (int g4 = 0; g4 < 4; ++g4) {
                                const f32x4 v4 = {o[dt][4 * g4] * inv, o[dt][4 * g4 + 1] * inv, o[dt][4 * g4 + 2] * inv, o[dt][4 * g4 + 3] * inv};
                                *(u32x2*)(op + 32 * dt + 8 * g4) = pack4(v4);
                            }
                    }
                }
            }
        } break;
        case 9: g = pg8::Gemm{QKVA + 1024, WBA, T, D, 512, 1536}; E.mode = pg8::EPI_BRA; break;
        case 10: g = pg8::Gemm{QKVB, WBB, T, D, 512, 1536}; E.mode = pg8::EPI_BRB; break;
        case 11: g = pg8::Gemm{XN, WO, T, D, D, D}; E.mode = pg8::EPI_F32; break;
        case 12: resid_norm_phase<false, false>(nullptr, H16, Y, 1.0f, args.in[I_MPOST], (float*)(ws + WS_RS), nullptr, gw, ngw, lane); break;
        case 13: g = pg8::Gemm{H16, W3, T, 2 * FF, D, D}; E.mode = pg8::EPI_SWIGLU; break;
        case 14: g = pg8::Gemm{HID, W4, T, D, FF, FF}; E.mode = pg8::EPI_F32; break;
        case 15: resid_norm_phase<false, false>(nullptr, H16, Y, 0.5f, args.in[I_F2POST], (float*)(ws + WS_RS), nullptr, gw, ngw, lane); break;
        case 16: g = pg8::Gemm{H16, WG, T, D, D, D}; E.mode = pg8::EPI_PLEG; break;
        case 17: g = pg8::Gemm{P16, WP, T, D, PLE, PLE}; E.mode = pg8::EPI_PLEP; break;
        case 18: resid_norm_phase<false, true>(nullptr, H16, (const h16*)(ws + WS_E16), 1.0f, args.in[I_PPOST], nullptr, outp_, gw, ngw, lane); break;
        default: break;
        }
        if (E.mode >= 0) { pg8::StaticOrder S; S.init(T, g.N, G, bid); pg8::gemm_phase((LAS unsigned char*)lds, g, S, E, tid); }
#ifdef DUP_PHASE
        if (ph == DUP_PHASE && !dup_done) { dup_done = true; --ph; }
#endif
        if (ph + 1 < args.ph_hi) {
            if (args.ph_lo < 0) grid.sync();
            if (ph == 9 || ph == 16) { asm volatile("s_waitcnt vmcnt(0)" ::: "memory"); __syncthreads(); }
            else xcd_barrier(xbar);
        }
#ifdef PROBE_MASK
        if (((PROBE_MASK >> ph) & 1) && bid == 0) { __syncthreads(); if (tid == 0) { const unsigned long long t1 = __builtin_amdgcn_s_memrealtime(); const unsigned long long dt = (t1 - probe_t0) * PROBE_MULT;
            while (__builtin_amdgcn_s_memrealtime() - t1 < dt) __builtin_amdgcn_s_sleep(32); } __syncthreads(); }
#endif
    }
}

constexpr int NPHASES = 19;

extern "C" void kernel_launch(void* const* d_in, const int* in_sizes, int n_in, void* d_out, int out_size, void* d_ws, size_t ws_size, hipStream_t stream) {
    static int grid = 0;
    if (grid == 0) {
        if (n_in != 25 || in_sizes[0] != T * D || out_size != T * D || ws_size < WS_END || ws_size < WS_HID + (size_t)T * FF * 2) {
            fprintf(stderr, "kernel_launch: unexpected shapes / workspace (n_in %d, in0 %d, out %d, ws %zu); nothing launched\n", n_in, n_in > 0 ? in_sizes[0] : -1, out_size, ws_size); grid = -1; return; }
        int dev = 0, cus = 0, per_cu = 0;
        hipGetDevice(&dev);
        hipDeviceGetAttribute(&cus, hipDeviceAttributeMultiprocessorCount, dev);
        hipFuncSetAttribute((const void*)fwd_kernel, hipFuncAttributeMaxDynamicSharedMemorySize, LDS_BYTES);
        hipOccupancyMaxActiveBlocksPerMultiprocessor(&per_cu, (const void*)fwd_kernel, NTHREADS, LDS_BYTES);
        if (per_cu < 1) { fprintf(stderr, "kernel_launch: occupancy query says %d blocks per CU\n", per_cu); per_cu = 1; }
        if (per_cu > 1) per_cu = 1;
        grid = cus * per_cu;
        (void)hipGetLastError();
    }
    if (grid < 0) return;
    if (hipMemsetAsync(d_ws, 0, 65536, stream) != hipSuccess) { fprintf(stderr, "kernel_launch: hipMemsetAsync of the control words failed\n"); return; }
    Args a{};
    for (int i = 0; i < 25; ++i) a.in[i] = (const float*)d_in[i];
    a.out = (float*)d_out; a.ws = (unsigned char*)d_ws;
#if MK_PER_PHASE
    for (int ph = 0; ph < NPHASES; ++ph) {
        a.ph_lo = ph; a.ph_hi = ph + 1;
        void* kargs[] = {&a};
        hipError_t e = hipLaunchCooperativeKernel((const void*)fwd_kernel, dim3(grid), dim3(NTHREADS), kargs, LDS_BYTES, stream);
        if (e != hipSuccess) { fprintf(stderr, "launch failed: %s\n", hipGetErrorString(e)); break; }
    }
#else
    a.ph_lo = 0; a.ph_hi = NPHASES;
    void* kargs[] = {&a};
    hipError_t e = hipLaunchCooperativeKernel((const void*)fwd_kernel, dim3(grid), dim3(NTHREADS), kargs, LDS_BYTES, stream);
    if (e != hipSuccess) fprintf(stderr, "cooperative launch failed: %s (grid %d)\n", hipGetErrorString(e), grid);
#endif
}
```
